# Optimizing an MI355X kernel written in HIP

```python
import math
import jax, jax.numpy as jnp
from jax import lax
import numpy as np

D_MODEL = 1024
BATCH = 4
SEQ = 4096
DEPTH = 1

PLE_DIM = 256
RET_HEADS = 8
RET_HEAD_DIM = 64
RET_WIDTH = RET_HEADS * RET_HEAD_DIM
RET_CHUNK = 128
ROPE_BASE = 10000.0
GN_EPS = 1e-6
NA_HEADS = 8
NA_HEAD_DIM = 64
NA_WIDTH = NA_HEADS * NA_HEAD_DIM
GRID_W = 64
NA_WIN_ROWS_MAX = 8
NA_WIN_COLS = 16
MIX_WIDTH = RET_WIDTH + NA_WIDTH
IN_PROJ_WIDTH = 4 * RET_WIDTH + 3 * NA_WIDTH
N_EXPERTS = 64
TOP_K = 8
N_GROUPS = 8
TOPK_GROUPS = 4
EXPERT_DIM = 256
SHARED_DIM = 256
ROUTED_SCALE = 2.5
MOE_BLOCK = 128
LN_EPS = 1e-5

kernel_name = "hybrid_retention_natten_moe_deepnorm"


def _layer_norm(x, g, b):
    xf = x.astype(jnp.float32)
    mu = jnp.mean(xf, -1, keepdims=True)
    var = jnp.mean(jnp.square(xf - mu), -1, keepdims=True)
    return ((xf - mu) * lax.rsqrt(var + LN_EPS) * g.astype(jnp.float32)
            + b.astype(jnp.float32)).astype(x.dtype)


def _rotary(t, pos):
    half = t.shape[-1] // 2
    inv = ROPE_BASE ** (-jnp.arange(half, dtype=jnp.float32) / half)
    ang = pos.astype(jnp.float32)[:, None] * inv[None, :]
    cos = jnp.cos(ang)[None, :, None, :].astype(t.dtype)
    sin = jnp.sin(ang)[None, :, None, :].astype(t.dtype)
    t1, t2 = t[..., :half], t[..., half:]
    return jnp.concatenate([t1 * cos - t2 * sin, t1 * sin + t2 * cos], -1)


def _retention_dir(q, k, v, log_gamma, strict):
    B, H, S, d = q.shape
    C = RET_CHUNK
    NC = S // C
    qc = q.reshape(B, H, NC, C, d)
    kc = k.reshape(B, H, NC, C, d)
    vc = v.reshape(B, H, NC, C, d)
    i = jnp.arange(C, dtype=jnp.float32)
    diff = i[:, None] - i[None, :]
    mask = (diff > 0) if strict else (diff >= 0)
    lg = log_gamma[:, None, None]
    d_intra = jnp.where(mask[None], jnp.exp(jnp.where(mask, diff, 0.0)[None] * lg), 0.0)
    scores = jnp.einsum('bhncd,bhnjd->bhncj', qc, kc) * d_intra[None, :, None]
    inner = jnp.einsum('bhncj,bhnje->bhnce', scores, vc)
    k_decay = jnp.exp((C - 1.0 - i)[None, :] * log_gamma[:, None])
    q_decay = jnp.exp((i + 1.0)[None, :] * log_gamma[:, None])
    chunk_decay = jnp.exp(C * log_gamma)[None, :, None, None]
    s_chunk = jnp.einsum('bhncd,hc,bhnce->nbhde', kc, k_decay, vc)

    def step(state, s_c):
        return chunk_decay * state + s_c, state

    _, prev = lax.scan(step, jnp.zeros_like(s_chunk[0]), s_chunk)
    cross = jnp.einsum('bhncd,hc,nbhde->bhnce', qc, q_decay, prev)
    return (inner + cross).reshape(B, H, S, d)


def _retention_group(rq, rk, rv, rg, pos, dec_f, dec_b, gn_gain):
    B, S, _ = rq.shape
    dt = rq.dtype
    q = _rotary(rq.reshape(B, S, RET_HEADS, RET_HEAD_DIM), pos)
    k = _rotary(rk.reshape(B, S, RET_HEADS, RET_HEAD_DIM), pos) * (RET_HEAD_DIM ** -0.5)
    v = rv.reshape(B, S, RET_HEADS, RET_HEAD_DIM)
    q, k, v = (t.transpose(0, 2, 1, 3).astype(jnp.float32) for t in (q, k, v))
    lg_f = jax.nn.log_sigmoid(dec_f.astype(jnp.float32))
    lg_b = jax.nn.log_sigmoid(dec_b.astype(jnp.float32))
    y_f = _retention_dir(q, k, v, lg_f, False)
    y_b = _retention_dir(q[:, :, ::-1], k[:, :, ::-1], v[:, :, ::-1], lg_b, True)[:, :, ::-1]
    y = y_f + y_b
    mu = jnp.mean(y, -1, keepdims=True)
    var = jnp.mean(jnp.square(y - mu), -1, keepdims=True)
    y = (y - mu) * lax.rsqrt(var + GN_EPS)
    y = y.transpose(0, 2, 1, 3).reshape(B, S, RET_WIDTH) * gn_gain.astype(jnp.float32)
    return jax.nn.silu(rg) * y.astype(dt)


def _neighbour_index(rows):
    wr = min(NA_WIN_ROWS_MAX, rows)
    wc = NA_WIN_COLS
    r = np.arange(rows)
    c = np.arange(GRID_W)
    rs = np.clip(r - wr // 2, 0, rows - wr)
    cs = np.clip(c - wc // 2, 0, GRID_W - wc)
    key_r = rs[:, None] + np.arange(wr)[None, :]
    key_c = cs[:, None] + np.arange(wc)[None, :]
    idx = key_r[:, None, :, None] * GRID_W + key_c[None, :, None, :]
    br = key_r - r[:, None] + (NA_WIN_ROWS_MAX - 1)
    bc = key_c - c[:, None] + (NA_WIN_COLS - 1)
    return (jnp.asarray(idx.reshape(rows, GRID_W, wr * wc), jnp.int32),
            jnp.asarray(br, jnp.int32), bc)


def _neighbourhood_attention(nq, nk, nv, rpb):
    B, S, _ = nq.shape
    H, d = NA_HEADS, NA_HEAD_DIM
    rows = S // GRID_W
    idx, br, bc = _neighbour_index(rows)
    qg = nq.reshape(B, rows, GRID_W, H, d).transpose(1, 0, 3, 2, 4)
    kh = nk.reshape(B, S, H, d).transpose(0, 2, 1, 3)
    vh = nv.reshape(B, S, H, d).transpose(0, 2, 1, 3)
    scale = d ** -0.5

    def row_block(args):
        q_r, idx_r, br_r = args
        k_r = kh[:, :, idx_r]
        v_r = vh[:, :, idx_r]
        bias = rpb[:, br_r][:, :, bc]
        bias = bias.transpose(0, 2, 1, 3).reshape(H, GRID_W, -1)
        s = (jnp.einsum('bhqd,bhqnd->bhqn', q_r, k_r).astype(jnp.float32) * scale
             + bias.astype(jnp.float32)[None])
        a = jax.nn.softmax(s, axis=-1).astype(v_r.dtype)
        return jnp.einsum('bhqn,bhqnd->bhqd', a, v_r)

    out = lax.map(row_block, (qg, idx, br))
    return out.transpose(1, 0, 3, 2, 4).reshape(B, S, NA_WIDTH)


def _hybrid_mixer(x, pos, w_in, dec_f, dec_b, gn_gain, rpb, w_out):
    proj = x @ w_in
    cuts = list(np.cumsum([RET_WIDTH] * 4 + [NA_WIDTH] * 2))
    rq, rk, rv, rg, nq, nk, nv = jnp.split(proj, cuts, axis=-1)
    ret_out = _retention_group(rq, rk, rv, rg, pos, dec_f, dec_b, gn_gain)
    na_out = _neighbourhood_attention(nq, nk, nv, rpb)
    return jnp.concatenate([ret_out, na_out], axis=-1) @ w_out


def _swiglu(h, w_gu, w_down):
    g, u = jnp.split(h @ w_gu, 2, axis=-1)
    return (jax.nn.silu(g) * u) @ w_down


def _route(xt, w_router, router_bias):
    T = xt.shape[0]
    scores = jax.nn.sigmoid(xt.astype(jnp.float32) @ w_router.astype(jnp.float32))
    biased = scores + router_bias.astype(jnp.float32)[None]
    grp = biased.reshape(T, N_GROUPS, N_EXPERTS // N_GROUPS)
    grp_score = lax.top_k(grp, 2)[0].sum(-1)
    _, top_g = lax.top_k(grp_score, TOPK_GROUPS)
    gmask = jnp.any(top_g[..., None] == jnp.arange(N_GROUPS)[None, None, :], axis=1)
    emask = jnp.repeat(gmask, N_EXPERTS // N_GROUPS, axis=-1)
    _, idx = lax.top_k(jnp.where(emask, biased, -jnp.inf), TOP_K)
    w = jnp.take_along_axis(scores, idx, axis=-1)
    w = w / jnp.sum(w, -1, keepdims=True) * ROUTED_SCALE
    return idx, w


def _routed_experts(xt, idx, w, w_gu, w_down):
    T, D = xt.shape
    A = T * TOP_K
    nb = -(-A // MOE_BLOCK) + N_EXPERTS
    n_slots = nb * MOE_BLOCK
    flat_e = idx.reshape(-1).astype(jnp.int32)
    flat_t = jnp.repeat(jnp.arange(T, dtype=jnp.int32), TOP_K)
    flat_w = w.reshape(-1)
    order = jnp.argsort(flat_e)
    e_sorted = flat_e[order]
    counts = jnp.bincount(flat_e, length=N_EXPERTS).astype(jnp.int32)
    start = jnp.cumsum(counts) - counts
    padded = (counts + MOE_BLOCK - 1) // MOE_BLOCK * MOE_BLOCK
    padded_end = jnp.cumsum(padded)
    padded_start = padded_end - padded
    dest = padded_start[e_sorted] + jnp.arange(A, dtype=jnp.int32) - start[e_sorted]
    slot_t = jnp.full((n_slots,), T, jnp.int32).at[dest].set(flat_t[order])
    slot_w = jnp.zeros((n_slots,), jnp.float32).at[dest].set(flat_w[order])
    block_e = jnp.minimum(
        jnp.searchsorted(padded_end, jnp.arange(nb, dtype=jnp.int32) * MOE_BLOCK, side='right'),
        N_EXPERTS - 1)
    x_pad = jnp.concatenate([xt, jnp.zeros((1, D), xt.dtype)], axis=0)

    def run_block(args):
        t_b, e_b = args
        return _swiglu(x_pad[t_b], w_gu[e_b], w_down[e_b])

    y = lax.map(run_block, (slot_t.reshape(nb, MOE_BLOCK), block_e)).reshape(n_slots, D)
    y = y * slot_w[:, None].astype(y.dtype)
    return jax.ops.segment_sum(y, slot_t, num_segments=T + 1)[:T]


def _moe(x, w_router, router_bias, w_e_gu, w_e_down, w_s_gu, w_s_down):
    B, S, D = x.shape
    xt = x.reshape(B * S, D)
    idx, w = _route(xt, w_router, router_bias)
    y = _routed_experts(xt, idx, w, w_e_gu, w_e_down) + _swiglu(xt, w_s_gu, w_s_down)
    return y.reshape(B, S, D)


def setup_inputs(seed: int = 0) -> dict:
    key = jax.random.key(seed)
    ks = jax.random.split(key, 20)
    f32 = jnp.float32
    beta = (8.0 * DEPTH) ** -0.25
    nrm = lambda k, s: jax.random.normal(k, s, f32)
    x = nrm(ks[0], (BATCH, SEQ, D_MODEL))
    p = nrm(ks[1], (DEPTH, BATCH, SEQ, PLE_DIM))
    col_scale = jnp.concatenate([
        jnp.ones((2 * RET_WIDTH,), f32), jnp.full((RET_WIDTH,), beta, f32),
        jnp.ones((RET_WIDTH,), f32), jnp.ones((2 * NA_WIDTH,), f32),
        jnp.full((NA_WIDTH,), beta, f32)])
    w_in = nrm(ks[2], (DEPTH, D_MODEL, IN_PROJ_WIDTH)) * (D_MODEL ** -0.5) * col_scale
    gamma0 = 1.0 - 2.0 ** (-5.0 - np.arange(RET_HEADS))
    logit0 = jnp.asarray(np.log(gamma0 / (1.0 - gamma0)), f32)
    ret_decay_fwd = logit0[None] + 0.01 * nrm(ks[3], (DEPTH, RET_HEADS))
    ret_decay_bwd = logit0[None] + 0.01 * nrm(ks[4], (DEPTH, RET_HEADS))
    ret_gn_gain = 1.0 + 0.02 * nrm(ks[5], (DEPTH, RET_WIDTH))
    na_rpb = 0.02 * nrm(ks[6], (DEPTH, NA_HEADS, 2 * NA_WIN_ROWS_MAX - 1, 2 * NA_WIN_COLS - 1))
    w_out = nrm(ks[7], (DEPTH, MIX_WIDTH, D_MODEL)) * (MIX_WIDTH ** -0.5) * beta
    ln1_gain = 1.0 + 0.02 * nrm(ks[8], (DEPTH, D_MODEL))
    ln1_bias = 0.02 * nrm(ks[9], (DEPTH, D_MODEL))
    w_router = nrm(ks[10], (DEPTH, D_MODEL, N_EXPERTS)) * (D_MODEL ** -0.5)
    router_bias = 0.01 * nrm(ks[11], (DEPTH, N_EXPERTS))
    w_expert_gu = nrm(ks[12], (DEPTH, N_EXPERTS, D_MODEL, 2 * EXPERT_DIM)) * (D_MODEL ** -0.5)
    w_expert_down = nrm(ks[13], (DEPTH, N_EXPERTS, EXPERT_DIM, D_MODEL)) * (EXPERT_DIM ** -0.5) * beta
    w_shared_gu = nrm(ks[14], (DEPTH, D_MODEL, 2 * SHARED_DIM)) * (D_MODEL ** -0.5)
    w_shared_down = nrm(ks[15], (DEPTH, SHARED_DIM, D_MODEL)) * (SHARED_DIM ** -0.5) * beta
    w_ple_proj = nrm(ks[16], (DEPTH, PLE_DIM, D_MODEL)) * (PLE_DIM ** -0.5) * beta
    w_ple_gate = nrm(ks[17], (DEPTH, D_MODEL, D_MODEL)) * (D_MODEL ** -0.5)
    ln2_gain = 1.0 + 0.02 * nrm(ks[18], (DEPTH, D_MODEL))
    ln2_bias = 0.02 * nrm(ks[19], (DEPTH, D_MODEL))
    return {"x": x, "p": p, "w_in": w_in, "ret_decay_fwd": ret_decay_fwd,
            "ret_decay_bwd": ret_decay_bwd, "ret_gn_gain": ret_gn_gain, "na_rpb": na_rpb,
            "w_out": w_out, "ln1_gain": ln1_gain, "ln1_bias": ln1_bias,
            "w_router": w_router, "router_bias": router_bias,
            "w_expert_gu": w_expert_gu, "w_expert_down": w_expert_down,
            "w_shared_gu": w_shared_gu, "w_shared_down": w_shared_down,
            "w_ple_proj": w_ple_proj, "w_ple_gate": w_ple_gate,
            "ln2_gain": ln2_gain, "ln2_bias": ln2_bias}


def reference(x, p, w_in, ret_decay_fwd, ret_decay_bwd, ret_gn_gain, na_rpb, w_out,
              ln1_gain, ln1_bias, w_router, router_bias, w_expert_gu, w_expert_down,
              w_shared_gu, w_shared_down, w_ple_proj, w_ple_gate, ln2_gain, ln2_bias):
    S = x.shape[1]
    alpha = (2.0 * DEPTH) ** 0.25
    pos = jnp.arange(S, dtype=jnp.int32)
    for i in range(DEPTH):
        mix = _hybrid_mixer(x, pos, w_in[i], ret_decay_fwd[i], ret_decay_bwd[i],
                            ret_gn_gain[i], na_rpb[i], w_out[i])
        x = _layer_norm(alpha * x + mix, ln1_gain[i], ln1_bias[i])
        ffn = _moe(x, w_router[i], router_bias[i], w_expert_gu[i], w_expert_down[i],
                   w_shared_gu[i], w_shared_down[i])
        ple = (p[i].astype(x.dtype) @ w_ple_proj[i]) * jax.nn.sigmoid(x @ w_ple_gate[i])
        x = _layer_norm(alpha * x + ffn + ple, ln2_gain[i], ln2_bias[i])
    return x
```

```cpp
#include <hip/hip_runtime.h>
#include <hip/hip_cooperative_groups.h>
#include <cstdio>
#include <cstdint>
#include <cmath>
namespace cg = cooperative_groups;

#ifndef MK_SINGLE
#define MK_SINGLE 0
#endif

typedef unsigned short bf16_t;
typedef short bf16x8 __attribute__((ext_vector_type(8)));
typedef short bf16x4 __attribute__((ext_vector_type(4)));
typedef float f32x4 __attribute__((ext_vector_type(4)));
typedef unsigned u32x4 __attribute__((ext_vector_type(4)));
typedef unsigned u32x2 __attribute__((ext_vector_type(2)));

constexpr int T_TOK = 16384, DM = 1024, SEQ = 4096, NB_ = 4, PLE = 256;
constexpr int NPROJ = 3584, NEXP = 64, EDIM = 256, TOPK = 8;
constexpr int NTHREADS = 512;
constexpr float ALPHA = 1.189207115002721f;
constexpr float LOG2E = 1.4426950408889634f;
constexpr int MAXBLK_R = 1088;
constexpr int NBLK_S = 128;

constexpr size_t MiB = 1024ull * 1024ull;
constexpr size_t WS_WDT   = 0;
constexpr size_t WS_CTRL  = 33 * MiB;
constexpr size_t WS_LTOK  = 34 * MiB;
constexpr size_t WS_LKW   = 38 * MiB;
constexpr size_t WS_ROPE  = 46 * MiB;
constexpr size_t WS_X1B   = 48 * MiB;
constexpr size_t WS_PLE   = 80 * MiB;
constexpr size_t WS_HBUF  = 112 * MiB;
constexpr size_t WS_H1    = 112 * MiB;
constexpr size_t WS_PART  = 188 * MiB;
constexpr size_t WS_WGUT  = 188 * MiB;
constexpr size_t WS_WGATE = 253 * MiB;
constexpr size_t WS_WPT   = 255 * MiB;
constexpr size_t WS_PB    = 256 * MiB;
constexpr size_t WS_WINT  = 264 * MiB;
constexpr size_t WS_WOUTT = 271 * MiB;
constexpr size_t WS_XB    = 273 * MiB;
constexpr size_t WS_Q     = 305 * MiB;
constexpr size_t WS_K     = 321 * MiB;
constexpr size_t WS_KT    = 337 * MiB;
constexpr size_t WS_VT    = 353 * MiB;
constexpr size_t WS_G     = 369 * MiB;
constexpr size_t WS_NQ    = 385 * MiB;
constexpr size_t WS_NK    = 401 * MiB;
constexpr size_t WS_NVT   = 417 * MiB;
constexpr size_t WS_SST   = 433 * MiB;
constexpr size_t WS_MIX   = 465 * MiB;
constexpr size_t WS_END   = 497 * MiB;

struct Params {
    const float* in[20];
    float* out;
    unsigned char* ws;
    int ph_lo, ph_hi, sync, pad;
    float inv_freq[32];
};

__device__ __forceinline__ unsigned cvt_pk_bf16(float lo, float hi) { unsigned r; asm volatile("v_cvt_pk_bf16_f32 %0, %1, %2" : "=v"(r) : "v"(lo), "v"(hi)); return r; }
__device__ __forceinline__ float bf2f(unsigned short v) { return __uint_as_float(((unsigned)v) << 16); }
__device__ __forceinline__ float bflo(unsigned v) { return __uint_as_float(v << 16); }
__device__ __forceinline__ float bfhi(unsigned v) { return __uint_as_float(v & 0xffff0000u); }
__device__ __forceinline__ unsigned short f2bf(float f) { return (unsigned short)(cvt_pk_bf16(f, 0.f) & 0xffffu); }
__device__ __forceinline__ float fast_exp2(float x) { return __builtin_amdgcn_exp2f(x); }
__device__ __forceinline__ float sigmoidf_(float x) { return 1.0f / (1.0f + __expf(-x)); }
__device__ __forceinline__ float siluf_(float x) { return x / (1.0f + __expf(-x)); }
__device__ __forceinline__ float wave_sum(float v) {
#pragma unroll
    for (int o = 32; o >= 1; o >>= 1) v += __shfl_xor(v, o);
    return v;
}
#define MFMA16(a, b, c) __builtin_amdgcn_mfma_f32_16x16x32_bf16((a), (b), (c), 0, 0, 0)

template <int BM, int BN, int WGM, int WGN>
struct GemmT {
    static constexpr int WM = BM / WGM, WN = BN / WGN, MT = WM / 16, NT = WN / 16;
    static constexpr int AL = BM / 64, BL = BN / 64;
    static constexpr int A_BYTES = BM * 128, B_BYTES = BN * 128, STAGE = A_BYTES + B_BYTES;
    static constexpr int LDS_BYTES = 2 * STAGE;

    __device__ static __forceinline__ void mainloop(f32x4 (&acc)[MT][NT], const bf16_t* (&aptr)[AL], const bf16_t* (&bptr)[BL], int K, unsigned char* lds) {
        const int tid = threadIdx.x, lane = tid & 63, wid = tid >> 6, wm = wid / WGN, wn = wid % WGN;
        const int srow = tid >> 3, sch = tid & 7;
        const unsigned wofs = (unsigned)srow * 128u + (unsigned)((sch ^ (srow & 7)) << 4);
        const unsigned rA = (unsigned)(wm * WM + (lane & 15)) * 128u, rB = (unsigned)A_BYTES + (unsigned)(wn * WN + (lane & 15)) * 128u;
        const unsigned c0 = (unsigned)((((lane >> 4)) ^ (lane & 7)) << 4), c1 = (unsigned)(((4 + (lane >> 4)) ^ (lane & 7)) << 4);
        const int nk = K >> 6;
        u32x4 ra[AL], rb[BL];
#pragma unroll
        for (int i = 0; i < AL; ++i) ra[i] = *(const u32x4*)(aptr[i]);
#pragma unroll
        for (int i = 0; i < BL; ++i) rb[i] = *(const u32x4*)(bptr[i]);
#pragma unroll
        for (int i = 0; i < AL; ++i) *(u32x4*)(lds + wofs + i * 8192) = ra[i];
#pragma unroll
        for (int i = 0; i < BL; ++i) *(u32x4*)(lds + A_BYTES + wofs + i * 8192) = rb[i];
        __syncthreads();
        for (int kt = 0; kt < nk; ++kt) {
            unsigned char* cur = lds + (kt & 1) * STAGE;
            unsigned char* nxt = lds + ((kt + 1) & 1) * STAGE;
            const bool more = (kt + 1) < nk;
            if (more) {
#pragma unroll
                for (int i = 0; i < AL; ++i) ra[i] = *(const u32x4*)(aptr[i] + (size_t)(kt + 1) * 64);
#pragma unroll
                for (int i = 0; i < BL; ++i) rb[i] = *(const u32x4*)(bptr[i] + (size_t)(kt + 1) * 64);
            }
#pragma unroll
            for (int ks = 0; ks < 2; ++ks) {
                const unsigned cc = ks ? c1 : c0;
                bf16x8 af[MT], bfr[NT];
#pragma unroll
                for (int m = 0; m < MT; ++m) af[m] = *(const bf16x8*)(cur + rA + m * 2048 + cc);
#pragma unroll
                for (int n = 0; n < NT; ++n) bfr[n] = *(const bf16x8*)(cur + rB + n * 2048 + cc);
#pragma unroll
                for (int m = 0; m < MT; ++m)
#pragma unroll
                    for (int n = 0; n < NT; ++n) acc[m][n] = MFMA16(bfr[n], af[m], acc[m][n]);
            }
            if (more) {
#pragma unroll
                for (int i = 0; i < AL; ++i) *(u32x4*)(nxt + wofs + i * 8192) = ra[i];
#pragma unroll
                for (int i = 0; i < BL; ++i) *(u32x4*)(nxt + A_BYTES + wofs + i * 8192) = rb[i];
            }
            __syncthreads();
        }
    }
    __device__ static __forceinline__ void zero(f32x4 (&acc)[MT][NT]) {
#pragma unroll
        for (int m = 0; m < MT; ++m)
#pragma unroll
            for (int n = 0; n < NT; ++n) acc[m][n] = (f32x4){0.f, 0.f, 0.f, 0.f};
    }
};

__device__ void transpose_tile(const float* __restrict__ src, bf16_t* __restrict__ dst, int R, int C, int r0, int c0, float* tile  ) {
    const int tid = threadIdx.x;
#pragma unroll
    for (int i = 0; i < 2; ++i) {
        const int r = (tid >> 4) + 32 * i, c4 = (tid & 15) * 4;
        const f32x4 v = *(const f32x4*)(src + (size_t)(r0 + r) * C + c0 + c4);
        tile[r * 65 + c4 + 0] = v[0]; tile[r * 65 + c4 + 1] = v[1]; tile[r * 65 + c4 + 2] = v[2]; tile[r * 65 + c4 + 3] = v[3];
    }
    __syncthreads();
    {
        const int c = tid >> 3, rr = (tid & 7) * 8;
        float v[8];
#pragma unroll
        for (int j = 0; j < 8; ++j) v[j] = tile[(rr + j) * 65 + c];
        u32x4 w; w.x = cvt_pk_bf16(v[0], v[1]); w.y = cvt_pk_bf16(v[2], v[3]); w.z = cvt_pk_bf16(v[4], v[5]); w.w = cvt_pk_bf16(v[6], v[7]);
        *(u32x4*)(dst + (size_t)(c0 + c) * R + r0 + rr) = w;
    }
    __syncthreads();
}

__device__ __forceinline__ int transpose_job(const float* src, bf16_t* dst, int batch, int R, int C, int base, float* tile) {
    const int nb = gridDim.x, bid = blockIdx.x;
    const int tr = R / 64, tc = C / 64, per = tr * tc, tot = per * batch;
    const int first = (bid - (base % nb) + nb) % nb;
    for (int t = first; t < tot; t += nb) {
        const int e = t / per, r = t % per, ti = r / tc, tj = r % tc;
        transpose_tile(src + (size_t)e * R * C, dst + (size_t)e * R * C, R, C, ti * 64, tj * 64, tile);
    }
    return base + tot;
}

__device__ void phase0(const Params& p, unsigned char* lds) {
    unsigned char* ws = p.ws;
    const int tid = threadIdx.x, nb = gridDim.x, bid = blockIdx.x;
    if (bid == 0 && tid < 256) ((unsigned*)(ws + WS_CTRL))[tid] = 0u;
    for (int idx = bid * NTHREADS + tid; idx < SEQ * 32; idx += nb * NTHREADS) {
        const int s = idx >> 5, i = idx & 31;
        const double ang = (double)s * (double)p.inv_freq[i];
        const double rev = ang * 0.15915494309189535;
        const double fr = rev - floor(rev);
        const float ff = (float)fr;
        float2 cs; cs.x = __builtin_amdgcn_cosf(ff); cs.y = __builtin_amdgcn_sinf(ff);
        ((float2*)(ws + WS_ROPE))[idx] = cs;
    }
    {
        const float* x = p.in[0]; bf16_t* xb = (bf16_t*)(ws + WS_XB);
        const size_t n8 = (size_t)T_TOK * DM / 8;
        for (size_t i = (size_t)bid * NTHREADS + tid; i < n8; i += (size_t)nb * NTHREADS) {
            const f32x4 a = *(const f32x4*)(x + i * 8), b = *(const f32x4*)(x + i * 8 + 4);
            u32x4 w; w.x = cvt_pk_bf16(a[0], a[1]); w.y = cvt_pk_bf16(a[2], a[3]); w.z = cvt_pk_bf16(b[0], b[1]); w.w = cvt_pk_bf16(b[2], b[3]);
            *(u32x4*)(xb + i * 8) = w;
        }
        const float* pp = p.in[1]; bf16_t* pb = (bf16_t*)(ws + WS_PB);
        const size_t m8 = (size_t)T_TOK * PLE / 8;
        for (size_t i = (size_t)bid * NTHREADS + tid; i < m8; i += (size_t)nb * NTHREADS) {
            const f32x4 a = *(const f32x4*)(pp + i * 8), b = *(const f32x4*)(pp + i * 8 + 4);
            u32x4 w; w.x = cvt_pk_bf16(a[0], a[1]); w.y = cvt_pk_bf16(a[2], a[3]); w.z = cvt_pk_bf16(b[0], b[1]); w.w = cvt_pk_bf16(b[2], b[3]);
            *(u32x4*)(pb + i * 8) = w;
        }
    }
    float* tile = (float*)lds;
    int base = 0;
    base = transpose_job(p.in[2],  (bf16_t*)(ws + WS_WINT), 1, 1024, 3584, base, tile);
    base = transpose_job(p.in[7],  (bf16_t*)(ws + WS_WOUTT), 1, 1024, 1024, base, tile);
    base = transpose_job(p.in[12], (bf16_t*)(ws + WS_WGUT), 64, 1024, 512, base, tile);
    base = transpose_job(p.in[14], (bf16_t*)(ws + WS_WGUT) + (size_t)64 * 512 * 1024, 1, 1024, 512, base, tile);
    base = transpose_job(p.in[13], (bf16_t*)(ws + WS_WDT), 64, 256, 1024, base, tile);
    base = transpose_job(p.in[15], (bf16_t*)(ws + WS_WDT) + (size_t)64 * 1024 * 256, 1, 256, 1024, base, tile);
    base = transpose_job(p.in[17], (bf16_t*)(ws + WS_WGATE), 1, 1024, 1024, base, tile);
    base = transpose_job(p.in[16], (bf16_t*)(ws + WS_WPT), 1, 256, 1024, base, tile);
}

__device__ void phase1(const Params& p, unsigned char* lds) {
    typedef GemmT<256, 256, 2, 4> G;
    unsigned char* ws = p.ws;
    const bf16_t* xb = (const bf16_t*)(ws + WS_XB);
    const bf16_t* wt = (const bf16_t*)(ws + WS_WINT);
    const float2* rope = (const float2*)(ws + WS_ROPE);
    const int tid = threadIdx.x, lane = tid & 63, wid = tid >> 6, wm = wid / 4, wn = wid % 4, q4 = (lane >> 4) * 4, li = lane & 15;
    const int ntn = NPROJ / 256, ntiles = (T_TOK / 256) * ntn;
    for (int tile = blockIdx.x; tile < ntiles; tile += gridDim.x) {
        const int pm = tile / ntn, pn = tile % ntn, m0 = pm * 256, n0 = pn * 256;
        const bf16_t* aptr[G::AL]; const bf16_t* bptr[G::BL];
#pragma unroll
        for (int i = 0; i < G::AL; ++i) aptr[i] = xb + (size_t)(m0 + (tid >> 3) + 64 * i) * DM + (tid & 7) * 8;
#pragma unroll
        for (int i = 0; i < G::BL; ++i) bptr[i] = wt + (size_t)(n0 + (tid >> 3) + 64 * i) * DM + (tid & 7) * 8;
        f32x4 acc[G::MT][G::NT];
        G::zero(acc);
        G::mainloop(acc, aptr, bptr, DM, lds);
        const int region = n0 >> 9, head = ((n0 & 511) + 64 * wn) >> 6;
#pragma unroll
        for (int mt = 0; mt < G::MT; ++mt) {
            const int t = m0 + wm * 128 + 16 * mt + li, b = t >> 12, s = t & 4095, bh = b * 8 + head;
            if (region <= 1) {
                const float sc = region == 1 ? 0.125f : 1.0f;
                bf16_t* dst = (bf16_t*)(ws + (region == 0 ? WS_Q : WS_K)) + ((size_t)bh * SEQ + s) * 64;
                bf16_t* dstT = (bf16_t*)(ws + WS_KT) + (size_t)bh * 64 * SEQ + s;
#pragma unroll
                for (int nt = 0; nt < 2; ++nt) {
                    const int i0 = 16 * nt + q4;
                    const f32x4 cs0 = *(const f32x4*)(rope + (size_t)s * 32 + i0), cs1 = *(const f32x4*)(rope + (size_t)s * 32 + i0 + 2);
                    const float co[4] = {cs0[0], cs0[2], cs1[0], cs1[2]}, si[4] = {cs0[1], cs0[3], cs1[1], cs1[3]};
                    float o1[4], o2[4];
#pragma unroll
                    for (int r = 0; r < 4; ++r) { const float t1 = acc[mt][nt][r], t2 = acc[mt][nt + 2][r]; o1[r] = (t1 * co[r] - t2 * si[r]) * sc; o2[r] = (t1 * si[r] + t2 * co[r]) * sc; }
                    u32x2 w1, w2; w1.x = cvt_pk_bf16(o1[0], o1[1]); w1.y = cvt_pk_bf16(o1[2], o1[3]); w2.x = cvt_pk_bf16(o2[0], o2[1]); w2.y = cvt_pk_bf16(o2[2], o2[3]);
                    *(u32x2*)(dst + i0) = w1; *(u32x2*)(dst + i0 + 32) = w2;
                    if (region == 1) {
                        dstT[(size_t)(i0 + 0) * SEQ] = (bf16_t)(w1.x & 0xffff); dstT[(size_t)(i0 + 1) * SEQ] = (bf16_t)(w1.x >> 16);
                        dstT[(size_t)(i0 + 2) * SEQ] = (bf16_t)(w1.y & 0xffff); dstT[(size_t)(i0 + 3) * SEQ] = (bf16_t)(w1.y >> 16);
                        dstT[(size_t)(i0 + 32) * SEQ] = (bf16_t)(w2.x & 0xffff); dstT[(size_t)(i0 + 33) * SEQ] = (bf16_t)(w2.x >> 16);
                        dstT[(size_t)(i0 + 34) * SEQ] = (bf16_t)(w2.y & 0xffff); dstT[(size_t)(i0 + 35) * SEQ] = (bf16_t)(w2.y >> 16);
                    }
                }
            } else if (region == 2 || region == 6) {
                bf16_t* dstT = (bf16_t*)(ws + (region == 2 ? WS_VT : WS_NVT)) + (size_t)bh * 64 * SEQ + s;
#pragma unroll
                for (int nt = 0; nt < 4; ++nt)
#pragma unroll
                    for (int r = 0; r < 4; ++r) dstT[(size_t)(16 * nt + q4 + r) * SEQ] = f2bf(acc[mt][nt][r]);
            } else if (region == 3) {
                bf16_t* dst = (bf16_t*)(ws + WS_G) + (size_t)t * 512 + head * 64;
#pragma unroll
                for (int nt = 0; nt < 4; ++nt) {
                    u32x2 w; w.x = cvt_pk_bf16(siluf_(acc[mt][nt][0]), siluf_(acc[mt][nt][1])); w.y = cvt_pk_bf16(siluf_(acc[mt][nt][2]), siluf_(acc[mt][nt][3]));
                    *(u32x2*)(dst + 16 * nt + q4) = w;
                }
            } else {
                const float sc = region == 4 ? 0.125f : 1.0f;
                bf16_t* dst = (bf16_t*)(ws + (region == 4 ? WS_NQ : WS_NK)) + ((size_t)bh * SEQ + s) * 64;
#pragma unroll
                for (int nt = 0; nt < 4; ++nt) {
                    u32x2 w; w.x = cvt_pk_bf16(acc[mt][nt][0] * sc, acc[mt][nt][1] * sc); w.y = cvt_pk_bf16(acc[mt][nt][2] * sc, acc[mt][nt][3] * sc);
                    *(u32x2*)(dst + 16 * nt + q4) = w;
                }
            }
        }
    }
}

__device__ __forceinline__ float log2_sigmoid(float x) {
    const float ax = fabsf(x);
    const float sp = fmaxf(-x, 0.f) + log1pf(__expf(-ax));
    return -sp * LOG2E;
}

__device__ void phase2(const Params& p, unsigned char* lds) {
    unsigned char* ws = p.ws;
    const int tid = threadIdx.x, lane = tid & 63, wid = tid >> 6, q = lane >> 4, li = lane & 15;
    float* rpbL = (float*)lds;
    for (int i = tid; i < 8 * 15 * 31; i += NTHREADS) rpbL[i] = p.in[6][i];
    __syncthreads();
    const bf16_t* KT = (const bf16_t*)(ws + WS_KT); const bf16_t* VT = (const bf16_t*)(ws + WS_VT);
    const bf16_t* NQ = (const bf16_t*)(ws + WS_NQ); const bf16_t* NK = (const bf16_t*)(ws + WS_NK); const bf16_t* NVT = (const bf16_t*)(ws + WS_NVT);
    float* SST = (float*)(ws + WS_SST);
    bf16_t* mix = (bf16_t*)(ws + WS_MIX);
    const int nunits = 1024 + 1024;
    for (int u = blockIdx.x; u < nunits; u += gridDim.x) {
        if (u < 1024) {
            const int bh = u >> 5, c = u & 31, h = bh & 7;
            const int dir = wid >> 2, dvt = wid & 3;
            const float lg = log2_sigmoid(dir == 0 ? p.in[3][h] : p.in[4][h]);
            f32x4 acc[4];
#pragma unroll
            for (int n = 0; n < 4; ++n) acc[n] = (f32x4){0.f, 0.f, 0.f, 0.f};
#pragma unroll
            for (int ks = 0; ks < 4; ++ks) {
                const int tok0 = c * 128 + 32 * ks + 8 * q;
                const bf16x8 va = *(const bf16x8*)(VT + ((size_t)bh * 64 + 16 * dvt + li) * SEQ + tok0);
                float wg[8];
#pragma unroll
                for (int j = 0; j < 8; ++j) { const int jl = 32 * ks + 8 * q + j; wg[j] = fast_exp2(lg * (float)(dir == 0 ? (127 - jl) : jl)); }
#pragma unroll
                for (int n = 0; n < 4; ++n) {
                    const u32x4 kr = *(const u32x4*)(KT + ((size_t)bh * 64 + 16 * n + li) * SEQ + tok0);
                    u32x4 kw;
                    kw.x = cvt_pk_bf16(bflo(kr.x) * wg[0], bfhi(kr.x) * wg[1]); kw.y = cvt_pk_bf16(bflo(kr.y) * wg[2], bfhi(kr.y) * wg[3]);
                    kw.z = cvt_pk_bf16(bflo(kr.z) * wg[4], bfhi(kr.z) * wg[5]); kw.w = cvt_pk_bf16(bflo(kr.w) * wg[6], bfhi(kr.w) * wg[7]);
                    acc[n] = MFMA16(va, __builtin_bit_cast(bf16x8, kw), acc[n]);
                }
            }
            float* dst = SST + ((size_t)(bh * 32 + c) * 2 + dir) * 4096;
#pragma unroll
            for (int n = 0; n < 4; ++n)
#pragma unroll
                for (int r = 0; r < 4; ++r) dst[(16 * dvt + 4 * q + r) * 64 + 16 * n + li] = acc[n][r];
        } else {
            const int wu = (u - 1024) * 8 + wid;
            const int cblk = wu & 3, r = (wu >> 2) & 63, h = (wu >> 8) & 7, b = wu >> 11, bh = b * 8 + h;
            const int rs = min(max(r - 4, 0), 56);
            const int cw = cblk == 0 ? 0 : (cblk == 1 ? 8 : (cblk == 2 ? 24 : 32));
            const int c = 16 * cblk + li, cs = min(max(c - 8, 0), 48);
            const size_t qtok = (size_t)bh * SEQ + r * 64 + c;
            bf16x8 qf[2];
            qf[0] = *(const bf16x8*)(NQ + qtok * 64 + 8 * q); qf[1] = *(const bf16x8*)(NQ + qtok * 64 + 32 + 8 * q);
            f32x4 sT[16];
#pragma unroll
            for (int kt = 0; kt < 16; ++kt) {
                const int kr = kt >> 1, kc = cw + 16 * (kt & 1) + li;
                const size_t ktok = (size_t)bh * SEQ + (rs + kr) * 64 + kc;
                const bf16x8 k0 = *(const bf16x8*)(NK + ktok * 64 + 8 * q), k1 = *(const bf16x8*)(NK + ktok * 64 + 32 + 8 * q);
                f32x4 a = (f32x4){0.f, 0.f, 0.f, 0.f};
                a = MFMA16(k0, qf[0], a); a = MFMA16(k1, qf[1], a);
                sT[kt] = a;
            }
            const float* bias_h = rpbL + h * 15 * 31;
            float mx = -3.0e38f;
#pragma unroll
            for (int kt = 0; kt < 16; ++kt) {
                const int kr = kt >> 1;
                const float* brow = bias_h + (rs + kr - r + 7) * 31;
#pragma unroll
                for (int rr = 0; rr < 4; ++rr) {
                    const int kc = cw + 16 * (kt & 1) + 4 * q + rr;
                    const bool valid = (kc >= cs) && (kc <= cs + 15);
                    const int bi = min(max(kc - c + 15, 0), 30);
                    const float sv = valid ? (sT[kt][rr] + brow[bi]) : -3.0e38f;
                    sT[kt][rr] = sv; mx = fmaxf(mx, sv);
                }
            }
            mx = fmaxf(mx, __shfl_xor(mx, 16)); mx = fmaxf(mx, __shfl_xor(mx, 32));
            float sum = 0.f;
#pragma unroll
            for (int kt = 0; kt < 16; ++kt)
#pragma unroll
                for (int rr = 0; rr < 4; ++rr) { const float e = fast_exp2((sT[kt][rr] - mx) * LOG2E); sT[kt][rr] = e; sum += e; }
            sum += __shfl_xor(sum, 16); sum += __shfl_xor(sum, 32);
            const float inv = 1.0f / sum;
            f32x4 oT[4];
#pragma unroll
            for (int d = 0; d < 4; ++d) oT[d] = (f32x4){0.f, 0.f, 0.f, 0.f};
#pragma unroll
            for (int ks = 0; ks < 8; ++ks) {
                u32x4 pw; pw.x = cvt_pk_bf16(sT[2 * ks][0], sT[2 * ks][1]); pw.y = cvt_pk_bf16(sT[2 * ks][2], sT[2 * ks][3]);
                pw.z = cvt_pk_bf16(sT[2 * ks + 1][0], sT[2 * ks + 1][1]); pw.w = cvt_pk_bf16(sT[2 * ks + 1][2], sT[2 * ks + 1][3]);
                const bf16x8 pf = __builtin_bit_cast(bf16x8, pw);
                const size_t vtok = (size_t)(rs + ks) * 64 + cw + 4 * q;
#pragma unroll
                for (int d = 0; d < 4; ++d) {
                    const bf16_t* vp = NVT + ((size_t)bh * 64 + 16 * d + li) * SEQ + vtok;
                    const u32x2 v0 = *(const u32x2*)vp, v1 = *(const u32x2*)(vp + 16);
                    u32x4 vw; vw.x = v0.x; vw.y = v0.y; vw.z = v1.x; vw.w = v1.y;
                    oT[d] = MFMA16(__builtin_bit_cast(bf16x8, vw), pf, oT[d]);
                }
            }
            bf16_t* dst = mix + ((size_t)b * SEQ + r * 64 + c) * DM + 512 + h * 64 + 4 * q;
#pragma unroll
            for (int d = 0; d < 4; ++d) {
                u32x2 w; w.x = cvt_pk_bf16(oT[d][0] * inv, oT[d][1] * inv); w.y = cvt_pk_bf16(oT[d][2] * inv, oT[d][3] * inv);
                *(u32x2*)(dst + 16 * d) = w;
            }
        }
    }
}

__device__ void phase3(const Params& p, unsigned char* lds) {
    unsigned char* ws = p.ws;
    const int tid = threadIdx.x, lane = tid & 63, wid = tid >> 6, q = lane >> 4, li = lane & 15;
    const bf16_t* Q = (const bf16_t*)(ws + WS_Q); const bf16_t* Kp = (const bf16_t*)(ws + WS_K); const bf16_t* VT = (const bf16_t*)(ws + WS_VT);
    const bf16_t* Gt = (const bf16_t*)(ws + WS_G);
    const float* SST = (const float*)(ws + WS_SST);
    bf16_t* mix = (bf16_t*)(ws + WS_MIX);
    constexpr int PROW = 144;
    for (int u = blockIdx.x; u < 1024; u += gridDim.x) {
        const int bh = u >> 5, c = u & 31, h = bh & 7, b = bh >> 3;
        const float lf = log2_sigmoid(p.in[3][h]), lb = log2_sigmoid(p.in[4][h]);
        __syncthreads();
#pragma unroll
        for (int rep = 0; rep < 2; ++rep) {
            const int id = tid + 512 * rep, dir = id >> 9, dv = (id >> 3) & 63, ch = id & 7;
            float a[8];
#pragma unroll
            for (int j = 0; j < 8; ++j) a[j] = 0.f;
            if (dir == 0) {
                for (int c2 = 0; c2 < c; ++c2) {
                    const float cf = fast_exp2(lf * 128.f * (float)(c - 1 - c2));
                    const float* sp = SST + ((size_t)(bh * 32 + c2) * 2 + 0) * 4096 + dv * 64 + ch * 8;
                    const f32x4 v0 = *(const f32x4*)sp, v1 = *(const f32x4*)(sp + 4);
#pragma unroll
                    for (int j = 0; j < 4; ++j) { a[j] += cf * v0[j]; a[4 + j] += cf * v1[j]; }
                }
            } else {
                for (int c2 = c + 1; c2 < 32; ++c2) {
                    const float cf = fast_exp2(lb * 128.f * (float)(c2 - c - 1));
                    const float* sp = SST + ((size_t)(bh * 32 + c2) * 2 + 1) * 4096 + dv * 64 + ch * 8;
                    const f32x4 v0 = *(const f32x4*)sp, v1 = *(const f32x4*)(sp + 4);
#pragma unroll
                    for (int j = 0; j < 4; ++j) { a[j] += cf * v0[j]; a[4 + j] += cf * v1[j]; }
                }
            }
            u32x4 w; w.x = cvt_pk_bf16(a[0], a[1]); w.y = cvt_pk_bf16(a[2], a[3]); w.z = cvt_pk_bf16(a[4], a[5]); w.w = cvt_pk_bf16(a[6], a[7]);
            *(u32x4*)(lds + dir * (64 * PROW) + dv * PROW + ch * 16) = w;
        }
        __syncthreads();
        const int ii = 16 * wid + li;
        const size_t qrow = (size_t)bh * SEQ + c * 128 + ii;
        bf16x8 qf[2];
        qf[0] = *(const bf16x8*)(Q + qrow * 64 + 8 * q); qf[1] = *(const bf16x8*)(Q + qrow * 64 + 32 + 8 * q);
        f32x4 sT[8];
#pragma unroll
        for (int jt = 0; jt < 8; ++jt) {
            const size_t krow = (size_t)bh * SEQ + c * 128 + 16 * jt + li;
            const bf16x8 k0 = *(const bf16x8*)(Kp + krow * 64 + 8 * q), k1 = *(const bf16x8*)(Kp + krow * 64 + 32 + 8 * q);
            f32x4 a = (f32x4){0.f, 0.f, 0.f, 0.f};
            a = MFMA16(k0, qf[0], a); a = MFMA16(k1, qf[1], a);
#pragma unroll
            for (int rr = 0; rr < 4; ++rr) {
                const int j = 16 * jt + 4 * q + rr, diff = ii - j;
                const float d = diff >= 0 ? fast_exp2(lf * (float)diff) : fast_exp2(lb * (float)(-diff));
                a[rr] *= d;
            }
            sT[jt] = a;
        }
        f32x4 yT[4], uf[4], ub[4];
#pragma unroll
        for (int d = 0; d < 4; ++d) { yT[d] = (f32x4){0.f, 0.f, 0.f, 0.f}; uf[d] = yT[d]; ub[d] = yT[d]; }
#pragma unroll
        for (int ks = 0; ks < 4; ++ks) {
            u32x4 pw; pw.x = cvt_pk_bf16(sT[2 * ks][0], sT[2 * ks][1]); pw.y = cvt_pk_bf16(sT[2 * ks][2], sT[2 * ks][3]);
            pw.z = cvt_pk_bf16(sT[2 * ks + 1][0], sT[2 * ks + 1][1]); pw.w = cvt_pk_bf16(sT[2 * ks + 1][2], sT[2 * ks + 1][3]);
            const bf16x8 pf = __builtin_bit_cast(bf16x8, pw);
#pragma unroll
            for (int d = 0; d < 4; ++d) {
                const bf16_t* vp = VT + ((size_t)bh * 64 + 16 * d + li) * SEQ + c * 128 + 32 * ks + 4 * q;
                const u32x2 v0 = *(const u32x2*)vp, v1 = *(const u32x2*)(vp + 16);
                u32x4 vw; vw.x = v0.x; vw.y = v0.y; vw.z = v1.x; vw.w = v1.y;
                yT[d] = MFMA16(__builtin_bit_cast(bf16x8, vw), pf, yT[d]);
            }
        }
#pragma unroll
        for (int d = 0; d < 4; ++d)
#pragma unroll
            for (int ks = 0; ks < 2; ++ks) {
                const bf16x8 pfw = *(const bf16x8*)(lds + (16 * d + li) * PROW + ks * 64 + q * 16);
                const bf16x8 pbw = *(const bf16x8*)(lds + 64 * PROW + (16 * d + li) * PROW + ks * 64 + q * 16);
                uf[d] = MFMA16(pfw, qf[ks], uf[d]); ub[d] = MFMA16(pbw, qf[ks], ub[d]);
            }
        const float df = fast_exp2(lf * (float)(ii + 1)), db = fast_exp2(lb * (float)(128 - ii));
        float sum = 0.f;
#pragma unroll
        for (int d = 0; d < 4; ++d)
#pragma unroll
            for (int rr = 0; rr < 4; ++rr) { const float y = yT[d][rr] + df * uf[d][rr] + db * ub[d][rr]; yT[d][rr] = y; sum += y; }
        sum += __shfl_xor(sum, 16); sum += __shfl_xor(sum, 32);
        const float mu = sum * (1.0f / 64.0f);
        float var = 0.f;
#pragma unroll
        for (int d = 0; d < 4; ++d)
#pragma unroll
            for (int rr = 0; rr < 4; ++rr) { const float t = yT[d][rr] - mu; var += t * t; }
        var += __shfl_xor(var, 16); var += __shfl_xor(var, 32);
        const float rstd = rsqrtf(var * (1.0f / 64.0f) + 1e-6f);
        const size_t tg = (size_t)b * SEQ + c * 128 + ii;
#pragma unroll
        for (int d = 0; d < 4; ++d) {
            const int dv = 16 * d + 4 * q;
            const f32x4 gn = *(const f32x4*)(p.in[5] + h * 64 + dv);
            const u32x2 gw = *(const u32x2*)(Gt + tg * 512 + h * 64 + dv);
            const float o0 = (yT[d][0] - mu) * rstd * gn[0] * bflo(gw.x), o1 = (yT[d][1] - mu) * rstd * gn[1] * bfhi(gw.x);
            const float o2 = (yT[d][2] - mu) * rstd * gn[2] * bflo(gw.y), o3 = (yT[d][3] - mu) * rstd * gn[3] * bfhi(gw.y);
            u32x2 w; w.x = cvt_pk_bf16(o0, o1); w.y = cvt_pk_bf16(o2, o3);
            *(u32x2*)(mix + tg * DM + h * 64 + dv) = w;
        }
    }
}

__device__ void phase4(const Params& p, unsigned char* lds) {
    typedef GemmT<256, 256, 2, 4> G;
    unsigned char* ws = p.ws;
    const bf16_t* A = (const bf16_t*)(ws + WS_MIX); const bf16_t* Bt = (const bf16_t*)(ws + WS_WOUTT);
    const float* x = p.in[0]; float* h1 = (float*)(ws + WS_H1);
    const int tid = threadIdx.x, lane = tid & 63, wid = tid >> 6, wm = wid / 4, wn = wid % 4, q4 = (lane >> 4) * 4, li = lane & 15;
    for (int tile = blockIdx.x; tile < 256; tile += gridDim.x) {
        const int m0 = (tile >> 2) * 256, n0 = (tile & 3) * 256;
        const bf16_t* aptr[G::AL]; const bf16_t* bptr[G::BL];
#pragma unroll
        for (int i = 0; i < G::AL; ++i) aptr[i] = A + (size_t)(m0 + (tid >> 3) + 64 * i) * DM + (tid & 7) * 8;
#pragma unroll
        for (int i = 0; i < G::BL; ++i) bptr[i] = Bt + (size_t)(n0 + (tid >> 3) + 64 * i) * DM + (tid & 7) * 8;
        f32x4 acc[G::MT][G::NT];
        G::zero(acc);
        G::mainloop(acc, aptr, bptr, DM, lds);
#pragma unroll
        for (int mt = 0; mt < G::MT; ++mt) {
            const size_t t = m0 + wm * 128 + 16 * mt + li;
#pragma unroll
            for (int nt = 0; nt < G::NT; ++nt) {
                const int n = n0 + wn * 64 + 16 * nt + q4;
                const f32x4 xv = *(const f32x4*)(x + t * DM + n);
                *(f32x4*)(h1 + t * DM + n) = xv * ALPHA + acc[mt][nt];
            }
        }
    }
}

__device__ void phase5(const Params& p, unsigned char* lds) {
    unsigned char* ws = p.ws;
    const int tid = threadIdx.x, lane = tid & 63, wid = tid >> 6;
    const float* h1 = (const float*)(ws + WS_H1);
    bf16_t* x1b = (bf16_t*)(ws + WS_X1B);
    const float* g1 = p.in[8]; const float* b1 = p.in[9]; const float* Wr = p.in[10]; const float* rb = p.in[11];
    unsigned* counts = (unsigned*)(ws + WS_CTRL);
    int* ltok = (int*)(ws + WS_LTOK); float2* lkw = (float2*)(ws + WS_LKW);
    float* xs = (float*)lds;
    float* pl = (float*)lds;
    for (int it = blockIdx.x; it < T_TOK / 32; it += gridDim.x) {
        const int t0 = it * 32;
#pragma unroll 1
        for (int k = 0; k < 4; ++k) {
            const int tk = wid * 4 + k; const size_t t = t0 + tk;
            f32x4 v[4]; float s = 0.f;
#pragma unroll
            for (int i = 0; i < 4; ++i) { v[i] = *(const f32x4*)(h1 + t * DM + 256 * i + 4 * lane); s += (v[i][0] + v[i][1]) + (v[i][2] + v[i][3]); }
            const float mu = wave_sum(s) * (1.0f / 1024.0f);
            float qv = 0.f;
#pragma unroll
            for (int i = 0; i < 4; ++i)
#pragma unroll
                for (int j = 0; j < 4; ++j) { const float d = v[i][j] - mu; qv += d * d; }
            const float rstd = rsqrtf(wave_sum(qv) * (1.0f / 1024.0f) + 1e-5f);
#pragma unroll
            for (int i = 0; i < 4; ++i) {
                const int cidx = 256 * i + 4 * lane;
                const f32x4 gg = *(const f32x4*)(g1 + cidx), bb = *(const f32x4*)(b1 + cidx);
                f32x4 o;
#pragma unroll
                for (int j = 0; j < 4; ++j) o[j] = (v[i][j] - mu) * rstd * gg[j] + bb[j];
                *(f32x4*)(xs + tk * 1024 + cidx) = o;
                u32x2 w; w.x = cvt_pk_bf16(o[0], o[1]); w.y = cvt_pk_bf16(o[2], o[3]);
                *(u32x2*)(x1b + t * DM + cidx) = w;
            }
        }
        __syncthreads();
        float acc[32];
#pragma unroll
        for (int i = 0; i < 32; ++i) acc[i] = 0.f;
#pragma unroll 1
        for (int k4 = 0; k4 < 32; ++k4) {
            const int kb = 128 * wid + 4 * k4;
            const float w0 = Wr[(size_t)(kb + 0) * 64 + lane], w1 = Wr[(size_t)(kb + 1) * 64 + lane], w2 = Wr[(size_t)(kb + 2) * 64 + lane], w3 = Wr[(size_t)(kb + 3) * 64 + lane];
#pragma unroll
            for (int tk = 0; tk < 32; ++tk) {
                const f32x4 xv = *(const f32x4*)(xs + tk * 1024 + kb);
                acc[tk] = fmaf(xv[0], w0, acc[tk]); acc[tk] = fmaf(xv[1], w1, acc[tk]); acc[tk] = fmaf(xv[2], w2, acc[tk]); acc[tk] = fmaf(xv[3], w3, acc[tk]);
            }
        }
        __syncthreads();
#pragma unroll
        for (int tk = 0; tk < 32; ++tk) pl[(wid * 32 + tk) * 64 + lane] = acc[tk];
        __syncthreads();
        const float rbias = rb[lane];
#pragma unroll 1
        for (int k = 0; k < 4; ++k) {
            const int tk = wid * 4 + k; const int t = t0 + tk;
            float logit = 0.f;
#pragma unroll
            for (int w = 0; w < 8; ++w) logit += pl[(w * 32 + tk) * 64 + lane];
            const float score = 1.0f / (1.0f + expf(-logit));
            const float biased = score + rbias;
            float m1 = biased;
            m1 = fmaxf(m1, __shfl_xor(m1, 1)); m1 = fmaxf(m1, __shfl_xor(m1, 2)); m1 = fmaxf(m1, __shfl_xor(m1, 4));
            const unsigned long long eqm = __ballot(biased == m1);
            const int g = lane >> 3;
            const unsigned gbits = (unsigned)((eqm >> (8 * g)) & 0xffull);
            const int first = __builtin_ctz(gbits);
            float m2 = ((lane & 7) == first) ? -3.0e38f : biased;
            m2 = fmaxf(m2, __shfl_xor(m2, 1)); m2 = fmaxf(m2, __shfl_xor(m2, 2)); m2 = fmaxf(m2, __shfl_xor(m2, 4));
            const float gs = m1 + m2;
            int grank = 0;
#pragma unroll
            for (int g2 = 0; g2 < 8; ++g2) { const float o = __shfl(gs, 8 * g2); grank += (o > gs || (o == gs && g2 < g)) ? 1 : 0; }
            const bool gsel = grank < 4;
            const float v = gsel ? biased : -3.0e38f;
            int rank = 0;
#pragma unroll
            for (int e2 = 0; e2 < 64; ++e2) { const float o = __shfl(v, e2); rank += (o > v || (o == v && e2 < lane)) ? 1 : 0; }
            const bool sel = gsel && rank < 8;
            const float wsum = wave_sum(sel ? score : 0.f);
            if (sel) {
                const float wgt = score / wsum * 2.5f;
                const unsigned pos = atomicAdd(&counts[lane], 1u);
                ltok[(size_t)lane * T_TOK + pos] = t;
                float2 kw; kw.x = __int_as_float(rank); kw.y = wgt;
                lkw[(size_t)lane * T_TOK + pos] = kw;
            }
        }
        __syncthreads();
    }
}

struct BlkTab { int start[65]; int total; };
__device__ __forceinline__ void build_blktab(const unsigned* counts, int* tab  ) {
    if (threadIdx.x < 64) {
        const int lane = threadIdx.x;
        const int nb = ((int)counts[lane] + 127) >> 7;
        int incl = nb;
#pragma unroll
        for (int o = 1; o < 64; o <<= 1) { const int v = __shfl_up(incl, o); if (lane >= o) incl += v; }
        tab[lane] = incl - nb;
        if (lane == 63) tab[64] = incl;
    }
    __syncthreads();
}
__device__ __forceinline__ int find_expert(const int* tab, int blk) {
    int e = 0;
#pragma unroll 1
    for (int s = 32; s >= 1; s >>= 1) if (e + s < 64 && tab[e + s] <= blk) e += s;
    return e;
}

__device__ void phase6a(const Params& p, unsigned char* lds) {
    typedef GemmT<128, 256, 2, 4> G;
    unsigned char* ws = p.ws;
    const int tid = threadIdx.x, lane = tid & 63, wid = tid >> 6, wm = wid / 4, wn = wid % 4, q4 = (lane >> 4) * 4, li = lane & 15;
    int* tab = (int*)(lds + G::LDS_BYTES);
    int* rtok = tab + 80; float* rwgt = (float*)(tab + 80 + 128);
    const unsigned* counts = (const unsigned*)(ws + WS_CTRL);
    const int* ltok = (const int*)(ws + WS_LTOK); const float2* lkw = (const float2*)(ws + WS_LKW);
    const bf16_t* x1b = (const bf16_t*)(ws + WS_X1B); const bf16_t* pb = (const bf16_t*)(ws + WS_PB);
    const bf16_t* WguT = (const bf16_t*)(ws + WS_WGUT); const bf16_t* WgT = (const bf16_t*)(ws + WS_WGATE); const bf16_t* WpT = (const bf16_t*)(ws + WS_WPT);
    bf16_t* Hb = (bf16_t*)(ws + WS_HBUF); bf16_t* ple = (bf16_t*)(ws + WS_PLE);
    build_blktab(counts, tab);
    const int nbr = tab[64];
    const int ntiles = 512 + 2 * NBLK_S + 2 * nbr;
    for (int tile = blockIdx.x; tile < ntiles; tile += gridDim.x) {
        if (tile < 512) {
            const int m0 = (tile >> 2) * 128, n0 = (tile & 3) * 256;
            const bf16_t* aptr[G::AL]; const bf16_t* bptr[G::BL];
#pragma unroll
            for (int i = 0; i < G::AL; ++i) aptr[i] = x1b + (size_t)(m0 + (tid >> 3) + 64 * i) * DM + (tid & 7) * 8;
#pragma unroll
            for (int i = 0; i < G::BL; ++i) bptr[i] = WgT + (size_t)(n0 + (tid >> 3) + 64 * i) * DM + (tid & 7) * 8;
            u32x2 sg[G::MT][G::NT];
            {
                f32x4 ga[G::MT][G::NT];
                G::zero(ga);
                G::mainloop(ga, aptr, bptr, DM, lds);
#pragma unroll
                for (int mt = 0; mt < G::MT; ++mt)
#pragma unroll
                    for (int nt = 0; nt < G::NT; ++nt) {
                        sg[mt][nt].x = cvt_pk_bf16(sigmoidf_(ga[mt][nt][0]), sigmoidf_(ga[mt][nt][1]));
                        sg[mt][nt].y = cvt_pk_bf16(sigmoidf_(ga[mt][nt][2]), sigmoidf_(ga[mt][nt][3]));
                    }
            }
#pragma unroll
            for (int i = 0; i < G::AL; ++i) aptr[i] = pb + (size_t)(m0 + (tid >> 3) + 64 * i) * PLE + (tid & 7) * 8;
#pragma unroll
            for (int i = 0; i < G::BL; ++i) bptr[i] = WpT + (size_t)(n0 + (tid >> 3) + 64 * i) * PLE + (tid & 7) * 8;
            f32x4 acc[G::MT][G::NT];
            G::zero(acc);
            G::mainloop(acc, aptr, bptr, PLE, lds);
#pragma unroll
            for (int mt = 0; mt < G::MT; ++mt) {
                const size_t t = m0 + wm * 64 + 16 * mt + li;
#pragma unroll
                for (int nt = 0; nt < G::NT; ++nt) {
                    const int n = n0 + wn * 64 + 16 * nt + q4;
                    u32x2 w; w.x = cvt_pk_bf16(acc[mt][nt][0] * bflo(sg[mt][nt].x), acc[mt][nt][1] * bfhi(sg[mt][nt].x));
                    w.y = cvt_pk_bf16(acc[mt][nt][2] * bflo(sg[mt][nt].y), acc[mt][nt][3] * bfhi(sg[mt][nt].y));
                    *(u32x2*)(ple + t * DM + n) = w;
                }
            }
        } else {
            int e, blk, half, hblk, cnt;
            if (tile < 512 + 2 * NBLK_S) { const int x = tile - 512; e = 64; blk = x >> 1; half = x & 1; hblk = MAXBLK_R + blk; cnt = T_TOK; }
            else { const int x = tile - 512 - 2 * NBLK_S; const int gb = x >> 1; half = x & 1; e = find_expert(tab, gb); blk = gb - tab[e]; hblk = gb; cnt = (int)counts[e]; }
            __syncthreads();
            if (tid < 128) {
                const int pos = blk * 128 + tid;
                int tok = 0; float w = 0.f;
                if (pos < cnt) { if (e == 64) { tok = pos; w = 1.0f; } else { tok = ltok[(size_t)e * T_TOK + pos]; w = lkw[(size_t)e * T_TOK + pos].y; } }
                rtok[tid] = tok; rwgt[tid] = w;
            }
            __syncthreads();
            const int j0 = half * 128;
            const bf16_t* aptr[G::AL]; const bf16_t* bptr[G::BL];
#pragma unroll
            for (int i = 0; i < G::AL; ++i) aptr[i] = x1b + (size_t)rtok[(tid >> 3) + 64 * i] * DM + (tid & 7) * 8;
#pragma unroll
            for (int i = 0; i < G::BL; ++i) {
                const int v = (tid >> 3) + 64 * i;
                const int n = ((v >> 5) & 1) * 256 + j0 + (v >> 6) * 32 + (v & 31);
                bptr[i] = WguT + ((size_t)e * 512 + n) * DM + (tid & 7) * 8;
            }
            f32x4 acc[G::MT][G::NT];
            G::zero(acc);
            G::mainloop(acc, aptr, bptr, DM, lds);
#pragma unroll
            for (int mt = 0; mt < G::MT; ++mt) {
                const int row = wm * 64 + 16 * mt + li;
                const float w = rwgt[row];
                bf16_t* dst = Hb + ((size_t)hblk * 128 + row) * EDIM + j0 + 32 * wn + q4;
#pragma unroll
                for (int nt = 0; nt < 2; ++nt) {
                    float o[4];
#pragma unroll
                    for (int r = 0; r < 4; ++r) o[r] = siluf_(acc[mt][nt][r]) * acc[mt][nt + 2][r] * w;
                    u32x2 wv; wv.x = cvt_pk_bf16(o[0], o[1]); wv.y = cvt_pk_bf16(o[2], o[3]);
                    *(u32x2*)(dst + 16 * nt) = wv;
                }
            }
        }
    }
}

__device__ void phase6b(const Params& p, unsigned char* lds) {
    typedef GemmT<128, 256, 2, 4> G;
    unsigned char* ws = p.ws;
    const int tid = threadIdx.x, lane = tid & 63, wid = tid >> 6, wm = wid / 4, wn = wid % 4, q4 = (lane >> 4) * 4, li = lane & 15;
    int* tab = (int*)(lds + G::LDS_BYTES);
    int* rdst = tab + 80;
    const unsigned* counts = (const unsigned*)(ws + WS_CTRL);
    const int* ltok = (const int*)(ws + WS_LTOK); const float2* lkw = (const float2*)(ws + WS_LKW);
    const bf16_t* Hb = (const bf16_t*)(ws + WS_HBUF); const bf16_t* WdT = (const bf16_t*)(ws + WS_WDT);
    bf16_t* part = (bf16_t*)(ws + WS_PART);
    build_blktab(counts, tab);
    const int nbr = tab[64];
    const int ntiles = 4 * (NBLK_S + nbr);
    for (int tile = blockIdx.x; tile < ntiles; tile += gridDim.x) {
        const int gb0 = tile >> 2, pn = tile & 3;
        int e, blk, hblk, cnt;
        if (gb0 < NBLK_S) { e = 64; blk = gb0; hblk = MAXBLK_R + blk; cnt = T_TOK; }
        else { const int gb = gb0 - NBLK_S; e = find_expert(tab, gb); blk = gb - tab[e]; hblk = gb; cnt = (int)counts[e]; }
        __syncthreads();
        if (tid < 128) {
            const int pos = blk * 128 + tid;
            int d = -1;
            if (pos < cnt) { if (e == 64) d = pos * 9 + 8; else d = ltok[(size_t)e * T_TOK + pos] * 9 + __float_as_int(lkw[(size_t)e * T_TOK + pos].x); }
            rdst[tid] = d;
        }
        __syncthreads();
        const int n0 = pn * 256;
        const bf16_t* aptr[G::AL]; const bf16_t* bptr[G::BL];
#pragma unroll
        for (int i = 0; i < G::AL; ++i) aptr[i] = Hb + ((size_t)hblk * 128 + (tid >> 3) + 64 * i) * EDIM + (tid & 7) * 8;
#pragma unroll
        for (int i = 0; i < G::BL; ++i) bptr[i] = WdT + ((size_t)e * 1024 + n0 + (tid >> 3) + 64 * i) * EDIM + (tid & 7) * 8;
        f32x4 acc[G::MT][G::NT];
        G::zero(acc);
        G::mainloop(acc, aptr, bptr, EDIM, lds);
#pragma unroll
        for (int mt = 0; mt < G::MT; ++mt) {
            const int row = wm * 64 + 16 * mt + li;
            const int d = rdst[row];
            if (d >= 0) {
                bf16_t* dst = part + (size_t)d * DM + n0 + wn * 64 + q4;
#pragma unroll
                for (int nt = 0; nt < G::NT; ++nt) {
                    u32x2 w; w.x = cvt_pk_bf16(acc[mt][nt][0], acc[mt][nt][1]); w.y = cvt_pk_bf16(acc[mt][nt][2], acc[mt][nt][3]);
                    *(u32x2*)(dst + 16 * nt) = w;
                }
            }
        }
    }
}

__device__ void phase7(const Params& p) {
    unsigned char* ws = p.ws;
    const int tid = threadIdx.x, lane = tid & 63, wid = tid >> 6;
    const bf16_t* x1b = (const bf16_t*)(ws + WS_X1B); const bf16_t* ple = (const bf16_t*)(ws + WS_PLE); const bf16_t* part = (const bf16_t*)(ws + WS_PART);
    const float* g2 = p.in[18]; const float* b2 = p.in[19];
    for (int t = blockIdx.x * 8 + wid; t < T_TOK; t += gridDim.x * 8) {
        float v[16];
#pragma unroll
        for (int hf = 0; hf < 2; ++hf) {
            const int c0 = hf * 512 + 8 * lane;
            const u32x4 xv = *(const u32x4*)(x1b + (size_t)t * DM + c0), pv = *(const u32x4*)(ple + (size_t)t * DM + c0);
            float* o = v + 8 * hf;
            o[0] = ALPHA * bflo(xv.x) + bflo(pv.x); o[1] = ALPHA * bfhi(xv.x) + bfhi(pv.x); o[2] = ALPHA * bflo(xv.y) + bflo(pv.y); o[3] = ALPHA * bfhi(xv.y) + bfhi(pv.y);
            o[4] = ALPHA * bflo(xv.z) + bflo(pv.z); o[5] = ALPHA * bfhi(xv.z) + bfhi(pv.z); o[6] = ALPHA * bflo(xv.w) + bflo(pv.w); o[7] = ALPHA * bfhi(xv.w) + bfhi(pv.w);
#pragma unroll
            for (int k = 0; k < 9; ++k) {
                const u32x4 a = *(const u32x4*)(part + ((size_t)t * 9 + k) * DM + c0);
                o[0] += bflo(a.x); o[1] += bfhi(a.x); o[2] += bflo(a.y); o[3] += bfhi(a.y); o[4] += bflo(a.z); o[5] += bfhi(a.z); o[6] += bflo(a.w); o[7] += bfhi(a.w);
            }
        }
        float s = 0.f;
#pragma unroll
        for (int i = 0; i < 16; ++i) s += v[i];
        const float mu = wave_sum(s) * (1.0f / 1024.0f);
        float qv = 0.f;
#pragma unroll
        for (int i = 0; i < 16; ++i) { const float d = v[i] - mu; qv += d * d; }
        const float rstd = rsqrtf(wave_sum(qv) * (1.0f / 1024.0f) + 1e-5f);
#pragma unroll
        for (int hf = 0; hf < 2; ++hf) {
            const int c0 = hf * 512 + 8 * lane;
#pragma unroll
            for (int j = 0; j < 2; ++j) {
                const f32x4 gg = *(const f32x4*)(g2 + c0 + 4 * j), bb = *(const f32x4*)(b2 + c0 + 4 * j);
                f32x4 o;
#pragma unroll
                for (int r = 0; r < 4; ++r) o[r] = (v[8 * hf + 4 * j + r] - mu) * rstd * gg[r] + bb[r];
                *(f32x4*)(p.out + (size_t)t * DM + c0 + 4 * j) = o;
            }
        }
    }
}

constexpr int LDS_TOTAL = 132 * 1024;
constexpr int NPHASE = 9;

__global__ void __launch_bounds__(NTHREADS) mega_kernel(Params p) {
    extern __shared__ __attribute__((aligned(16))) unsigned char smem[];
    cg::grid_group grid = cg::this_grid();
#define RUN_PHASE(i, call) if (p.ph_lo <= (i) && (i) < p.ph_hi) { call; if (p.sync && (i) + 1 < p.ph_hi) grid.sync(); }
    RUN_PHASE(0, phase0(p, smem))
    RUN_PHASE(1, phase1(p, smem))
    RUN_PHASE(2, phase2(p, smem))
    RUN_PHASE(3, phase3(p, smem))
    RUN_PHASE(4, phase4(p, smem))
    RUN_PHASE(5, phase5(p, smem))
    RUN_PHASE(6, phase6a(p, smem))
    RUN_PHASE(7, phase6b(p, smem))
    RUN_PHASE(8, phase7(p))
#undef RUN_PHASE
}

extern "C" void kernel_launch(void* const* d_in, const int* in_sizes, int n_in, void* d_out, int out_size, void* d_ws, size_t ws_size, hipStream_t stream) {
    static int grid_blocks = 0;
    if (grid_blocks == 0) {
        if (n_in != 20 || ws_size < WS_END) { fprintf(stderr, "kernel_launch: unexpected n_in %d / ws_size %zu (need %zu)\n", n_in, ws_size, (size_t)WS_END); grid_blocks = -1; return; }
        int dev = 0, cus = 0, per_cu = 0;
        hipGetDevice(&dev);
        hipDeviceGetAttribute(&cus, hipDeviceAttributeMultiprocessorCount, dev);
        if (hipFuncSetAttribute((const void*)mega_kernel, hipFuncAttributeMaxDynamicSharedMemorySize, LDS_TOTAL) != hipSuccess) { fprintf(stderr, "kernel_launch: hipFuncSetAttribute failed\n"); grid_blocks = -1; return; }
        if (hipOccupancyMaxActiveBlocksPerMultiprocessor(&per_cu, (const void*)mega_kernel, NTHREADS, LDS_TOTAL) != hipSuccess || per_cu < 1) { fprintf(stderr, "kernel_launch: occupancy query failed (%d)\n", per_cu); per_cu = 1; }
        (void)hipGetLastError();
        if (per_cu > 1) per_cu = 1;
        grid_blocks = cus * per_cu;
    }
    if (grid_blocks < 0) return;
    Params p{};
    for (int i = 0; i < 20; ++i) p.in[i] = (const float*)d_in[i];
    p.out = (float*)d_out; p.ws = (unsigned char*)d_ws;
    for (int i = 0; i < 32; ++i) p.inv_freq[i] = (float)pow(10000.0, -(double)i / 32.0);
#if MK_SINGLE
    p.ph_lo = 0; p.ph_hi = NPHASE; p.sync = 1;
    void* args[] = {&p};
    hipError_t e = hipLaunchCooperativeKernel((const void*)mega_kernel, dim3(grid_blocks), dim3(NTHREADS), args, LDS_TOTAL, stream);
    if (e != hipSuccess) fprintf(stderr, "cooperative launch failed: %s (grid %d)\n", hipGetErrorString(e), grid_blocks);
#else
    for (int ph = 0; ph < NPHASE; ++ph) {
        p.ph_lo = ph; p.ph_hi = ph + 1; p.sync = 0;
        hipLaunchKernelGGL(mega_kernel, dim3(grid_blocks), dim3(NTHREADS), LDS_TOTAL, stream, p);
    }
#endif
}
```

```cpp
#include <hip/hip_runtime.h>
#include <hip/hip_cooperative_groups.h>
#include <cstdio>
#include <cstdint>
#include <cmath>
namespace cg = cooperative_groups;

#ifndef MK_SINGLE
#define MK_SINGLE 1
#endif

typedef unsigned short bf16_t;
typedef short bf16x8 __attribute__((ext_vector_type(8)));
typedef short bf16x4 __attribute__((ext_vector_type(4)));
typedef float f32x4 __attribute__((ext_vector_type(4)));
typedef unsigned u32x4 __attribute__((ext_vector_type(4)));
typedef unsigned u32x2 __attribute__((ext_vector_type(2)));

constexpr int T_TOK = 16384, DM = 1024, SEQ = 4096, NB_ = 4, PLE = 256;
constexpr int NPROJ = 3584, NEXP = 64, EDIM = 256, TOPK = 8;
constexpr int NTHREADS = 512;
constexpr float ALPHA = 1.189207115002721f;
constexpr float LOG2E = 1.4426950408889634f;
constexpr float PART_SCALE = 8.0f;
constexpr float WGU_SCALE = 32.0f, X1_SCALE = 4.0f, GU_DESCALE = 1.0f / (32.0f * 4.0f);
constexpr float H_SCALE = 8.0f, WD_SCALE = 32.0f, D_DESCALE = 1.0f / (8.0f * 32.0f);
constexpr float MIX_SCALE = 16.0f, WO_SCALE = 64.0f, O_DESCALE = 1.0f / (16.0f * 64.0f);
constexpr float PLE_SCALE = 16.0f;
constexpr int MAXBLK_R = 576;
constexpr int NBLK_S = 64;

constexpr size_t MiB = 1024ull * 1024ull;
constexpr size_t WS_WDT   = 0;
constexpr size_t WS_CTRL  = 33 * MiB;
constexpr size_t WS_WRF   = 33 * MiB + 262144;
constexpr size_t WS_LGT   = 33 * MiB + 61440;
constexpr size_t WS_LTOK  = 34 * MiB;
constexpr size_t WS_LKW   = 38 * MiB;
constexpr size_t WS_ROPE  = 46 * MiB;
constexpr size_t WS_X1B   = 48 * MiB;
constexpr size_t WS_PLE   = 80 * MiB;
constexpr size_t WS_WPT   = 112 * MiB;
constexpr size_t WS_PB    = 113 * MiB;
constexpr size_t WS_HBUF  = 121 * MiB;
constexpr size_t WS_PART  = 201 * MiB;
constexpr size_t WS_SHO   = 329 * MiB;
constexpr size_t WS_PLE8  = 345 * MiB;
constexpr size_t WS_WGUT  = 201 * MiB;
constexpr size_t WS_WGATE = 266 * MiB;
constexpr size_t WS_WINT  = 268 * MiB;
constexpr size_t WS_WOUTT = 275 * MiB;
constexpr size_t WS_XB    = 277 * MiB;
constexpr size_t WS_X1F8  = 277 * MiB;
constexpr size_t WS_Q     = 309 * MiB;
constexpr size_t WS_K     = 325 * MiB;
constexpr size_t WS_KT    = 341 * MiB;
constexpr size_t WS_VT    = 357 * MiB;
constexpr size_t WS_G     = 373 * MiB;
constexpr size_t WS_NQ    = 389 * MiB;
constexpr size_t WS_NK    = 405 * MiB;
constexpr size_t WS_NVT   = 421 * MiB;
constexpr size_t WS_SST   = 437 * MiB;
constexpr size_t WS_MIX   = 469 * MiB;
constexpr size_t WS_END   = 501 * MiB;

__constant__ double INV_FREQ[32] = {1.0, 0.7498942093324559, 0.5623413251903491, 0.4216965034285822, 0.31622776601683794, 0.23713737056616552, 0.1778279410038923, 0.1333521432163324, 0.1, 0.07498942093324558, 0.05623413251903491, 0.042169650342858224, 0.03162277660168379, 0.023713737056616554, 0.01778279410038923, 0.01333521432163324, 0.01, 0.007498942093324558, 0.005623413251903491, 0.004216965034285823, 0.0031622776601683794, 0.0023713737056616554, 0.0017782794100389228, 0.001333521432163324, 0.001, 0.0007498942093324559, 0.0005623413251903491, 0.00042169650342858224, 0.00031622776601683794, 0.00023713737056616554, 0.00017782794100389227, 0.0001333521432163324};
struct Params {
    const float* in[20];
    float* out;
    unsigned char* ws;
    int ph_lo, ph_hi, sync, pad;
};

__device__ __forceinline__ unsigned cvt_pk_bf16(float lo, float hi) { unsigned r; asm volatile("v_cvt_pk_bf16_f32 %0, %1, %2" : "=v"(r) : "v"(lo), "v"(hi)); return r; }
__device__ __forceinline__ float bf2f(unsigned short v) { return __uint_as_float(((unsigned)v) << 16); }
__device__ __forceinline__ float bflo(unsigned v) { return __uint_as_float(v << 16); }
__device__ __forceinline__ float bfhi(unsigned v) { return __uint_as_float(v & 0xffff0000u); }
__device__ __forceinline__ unsigned short f2bf(float f) { return (unsigned short)(cvt_pk_bf16(f, 0.f) & 0xffffu); }
__device__ __forceinline__ float fast_exp2(float x) { return __builtin_amdgcn_exp2f(x); }
__device__ __forceinline__ float sigmoidf_(float x) { return __builtin_amdgcn_rcpf(1.0f + __expf(-x)); }
__device__ __forceinline__ float siluf_(float x) { return x * __builtin_amdgcn_rcpf(1.0f + __expf(-x)); }
__device__ __forceinline__ float wave_sum(float v) {
#pragma unroll
    for (int o = 32; o >= 1; o >>= 1) v += __shfl_xor(v, o);
    return v;
}
__device__ __forceinline__ int rfl(int v) { return __builtin_amdgcn_readfirstlane(v); }
__device__ __forceinline__ size_t rfl64(size_t v) { return ((size_t)(unsigned)__builtin_amdgcn_readfirstlane((int)(v >> 32)) << 32) | (size_t)(unsigned)__builtin_amdgcn_readfirstlane((int)(unsigned)v); }
#define WV wv_
__device__ __forceinline__ int lane_id() { return (int)__builtin_amdgcn_mbcnt_hi(~0u, __builtin_amdgcn_mbcnt_lo(~0u, 0u)); }
__device__ __forceinline__ float readlane_f(float v, int l) { return __uint_as_float((unsigned)__builtin_amdgcn_readlane((int)__float_as_uint(v), l)); }
__device__ __forceinline__ float shx(float v, int m, int lane_) { return __uint_as_float((unsigned)__builtin_amdgcn_ds_bpermute((lane_ ^ m) << 2, (int)__float_as_uint(v))); }
__device__ __forceinline__ float wave_sum_l(float v, int lane_) {
#pragma unroll
    for (int o = 32; o >= 1; o >>= 1) v += shx(v, o, lane_);
    return v;
}
#define MFMA16(a, b, c) __builtin_amdgcn_mfma_f32_16x16x32_bf16((a), (b), (c), 0, 0, 0)

namespace pg8 {
#define PG8_LAS __attribute__((address_space(3)))
constexpr int BM = 256, BK = 64, HALF = 128, HTB = HALF * BK * 2, STAGE_BYTES = 8 * HTB, NXCD = 8, WGM = 8;
constexpr int PG8_META_OFF = STAGE_BYTES + 2048;
__host__ __device__ __forceinline__ int lds_byte(int r, int c) { const int st = (r >> 4) * 2 + (c >> 5), rr = r & 15, cc = c & 31, ob = rr * 64 + cc * 2; return st * 1024 + (ob ^ (((ob >> 9) & 1) << 5)); }
__host__ __device__ __forceinline__ void stage_rc(int b, int& R, int& C) { const int st = b / 1024, sb = b % 1024, swz = sb ^ (((sb >> 9) & 1) << 5); R = (st >> 1) * 16 + swz / 64; C = (st & 1) * 32 + (swz % 64) / 2; }
__host__ __device__ __forceinline__ int perm32(int rho) { const int n = rho >> 4, i = rho & 15; return 8 * (i >> 2) + 4 * n + (i & 3); }

typedef int i32x4_t __attribute__((ext_vector_type(4)));
typedef int i32x8_t __attribute__((ext_vector_type(8)));
__device__ __forceinline__ i32x8_t cat8(const bf16x8& a, const bf16x8& b) { return __builtin_shufflevector(__builtin_bit_cast(i32x4_t, a), __builtin_bit_cast(i32x4_t, b), 0, 1, 2, 3, 4, 5, 6, 7); }
struct Unit { const char* A; const char* B; int pm, pn, x0, x1, x2, x3; };

struct TileOrder {
    int nM, nN, nwg;
    __device__ void init(int M, int N) { nM = M / BM; nN = N / BM; nwg = nM * nN; }
    __device__ bool map(long L, int& pm, int& pn) const {
        if (L >= nwg) return false;
        int wgid = (int)L; { const int q = nwg / NXCD, r = nwg % NXCD, xcd = wgid % NXCD, off = wgid / NXCD; wgid = (xcd < r ? xcd * (q + 1) : r * (q + 1) + (xcd - r) * q) + off; }
        const int nig = WGM * nN, gid = wgid / nig, fm = gid * WGM, gsz = (nM - fm) < WGM ? (nM - fm) : WGM;
        pm = fm + ((wgid % nig) % gsz); pn = (wgid % nig) / gsz; return true;
    }
};

template <class Epi, class Sched, bool GATHER, bool ALIGN_EPI, bool SP2, bool FP8 = false>
__device__ __forceinline__ void gemm_phase(PG8_LAS unsigned char* lds, const int K, const Sched& S, const Epi& E, const int wv_) {
    const int wid = WV, lane = lane_id(), tid = wid * 64 + lane, wr = wid >> 2, wc = wid & 3, fr = lane & 15, fq = lane >> 4;
    unsigned vA[2][2], vN[2][2], vB[2][2];
#pragma unroll
    for (int i = 0; i < 2; ++i) { int R, C; stage_rc(tid * 16 + i * 8192, R, C); const int Rb = Epi::PERM ? ((R & ~31) + perm32(R & 31)) : R;
#pragma unroll
        for (int h = 0; h < 2; ++h) { vA[h][i] = (unsigned)((R + 128 * h) * K + C) * 2u; vN[h][i] = vA[h][i]; vB[h][i] = (unsigned)((Rb + 128 * h) * K + C) * 2u; } }
    const size_t kstep = (size_t)(BK * 2);
    const unsigned ldsw = (unsigned)wid * 1024u;
    const int aoff = lds_byte(wr * 64 + fr, fq * 8), boff = lds_byte(wc * 32 + fr, fq * 8);
#define PG8_SA(b, h) (((b) * 2 + (h)) * HTB)
#define PG8_SB(b, h) ((4 + (b) * 2 + (h)) * HTB)
#define PG8_STAGE(bufoff, gbase, voff) do { _Pragma("unroll") for (int _i = 0; _i < 2; ++_i) \
        __builtin_amdgcn_global_load_lds((const unsigned*)((const char*)(gbase) + (voff)[_i]), (PG8_LAS unsigned*)(lds + (bufoff) + ldsw + _i * 8192), 16, 0, 0); } while (0)
#define PG8_LDA(dst, b, h) do { _Pragma("unroll") for (int m = 0; m < 4; ++m) _Pragma("unroll") for (int k = 0; k < 2; ++k) dst[m][k] = *(const PG8_LAS bf16x8*)(lds + PG8_SA(b, h) + aoff + m * 2048 + k * 1024); } while (0)
#define PG8_LDB(dst, b, h) do { _Pragma("unroll") for (int n = 0; n < 2; ++n) _Pragma("unroll") for (int k = 0; k < 2; ++k) dst[n][k] = *(const PG8_LAS bf16x8*)(lds + PG8_SB(b, h) + boff + n * 2048 + k * 1024); } while (0)
#define PG8_MMA(ai, bj, At, Bt) do { __builtin_amdgcn_s_setprio(1); _Pragma("unroll") for (int m = 0; m < 4; ++m) _Pragma("unroll") for (int n = 0; n < 2; ++n) { \
        if constexpr (FP8) { const i32x8_t _b8 = cat8(Bt[n][0], Bt[n][1]), _a8 = cat8(At[m][0], At[m][1]); asm volatile("v_mfma_f32_16x16x128_f8f6f4 %0, %1, %2, %0" : "+v"(acc[ai][bj][m][n]) : "v"(_b8), "v"(_a8)); } \
        else { _Pragma("unroll") for (int k = 0; k < 2; ++k) acc[ai][bj][m][n] = __builtin_amdgcn_mfma_f32_16x16x32_bf16(Bt[n][k], At[m][k], acc[ai][bj][m][n], 0, 0, 0); } } __builtin_amdgcn_s_setprio(0); } while (0)
#define PG8_WAIT_V(n) asm volatile("s_waitcnt vmcnt(" #n ")" ::: "memory")
#define PG8_WAIT_L(n) asm volatile("s_waitcnt lgkmcnt(" #n ")" ::: "memory")
#define PG8_BAR __builtin_amdgcn_s_barrier()
#define PG8_SCHED __builtin_amdgcn_sched_barrier(0)
#define PG8_ROWS(dst, unit) do { if constexpr (GATHER) { _Pragma("unroll") for (int _i = 0; _i < 2; ++_i) { int _R, _C; stage_rc(tid * 16 + _i * 8192, _R, _C); \
        _Pragma("unroll") for (int _h = 0; _h < 2; ++_h) dst[_h][_i] = (unsigned)(S.arow(unit, _R + 128 * _h) * K + _C) * 2u; } } } while (0)
    Unit cur, nxt; int ui = 0;
    if (!S.next(0, cur)) return;
    PG8_ROWS(vA, cur);
    if constexpr (Sched::VARK) { const int _K = cur.x3;
#pragma unroll
        for (int _i = 0; _i < 2; ++_i) { int _R, _C; stage_rc(tid * 16 + _i * 8192, _R, _C); const int _Rb = Epi::PERM ? ((_R & ~31) + perm32(_R & 31)) : _R;
#pragma unroll
            for (int _h = 0; _h < 2; ++_h) { vA[_h][_i] = (unsigned)((_R + 128 * _h) * _K + _C) * 2u; vB[_h][_i] = (unsigned)((_Rb + 128 * _h) * _K + _C) * 2u; } } }
#define PG8_META(unit, slot) do { if constexpr (Epi::NMETA > 0) { if (wid < Epi::NMETA) \
        __builtin_amdgcn_global_load_lds((const unsigned*)(E.meta_src(unit, wid) + lane * 16), (PG8_LAS unsigned*)(lds + PG8_META_OFF + (slot) * 4096 + wid * 1024), 16, 0, 0); } } while (0)
    PG8_META(cur, 0);
    f32x4 acc[2][2][4][2];
#pragma unroll
    for (int a = 0; a < 2; ++a)
#pragma unroll
        for (int b = 0; b < 2; ++b)
#pragma unroll
            for (int m = 0; m < 4; ++m)
#pragma unroll
                for (int n = 0; n < 2; ++n) acc[a][b][m][n] = (f32x4){0.f, 0.f, 0.f, 0.f};
    bf16x8 At[4][2], B0[2][2], B1[2][2];
    const char* cA = cur.A; const char* cB = cur.B;
    if constexpr (SP2) {
        PG8_STAGE(PG8_SB(0, 0), cB, vB[0]); PG8_STAGE(PG8_SB(0, 1), cB, vB[1]); PG8_STAGE(PG8_SA(0, 0), cA, vA[0]); PG8_STAGE(PG8_SA(0, 1), cA, vA[1]);
        if (wr == 1) PG8_BAR;
        PG8_WAIT_V(2); PG8_BAR;
        PG8_STAGE(PG8_SB(1, 0), cB + kstep, vB[0]); PG8_STAGE(PG8_SA(1, 0), cA + kstep, vA[0]); PG8_STAGE(PG8_SB(1, 1), cB + kstep, vB[1]);
        PG8_WAIT_V(6); PG8_BAR;
    } else {
        PG8_STAGE(PG8_SB(0, 0), cB, vB[0]); PG8_STAGE(PG8_SA(0, 0), cA, vA[0]); PG8_STAGE(PG8_SB(0, 1), cB, vB[1]); PG8_STAGE(PG8_SA(0, 1), cA, vA[1]);
        if (wr == 1) PG8_BAR;
        PG8_WAIT_V(4); PG8_BAR;
        PG8_STAGE(PG8_SB(1, 0), cB + kstep, vB[0]); PG8_STAGE(PG8_SA(1, 0), cA + kstep, vA[0]); PG8_STAGE(PG8_SB(1, 1), cB + kstep, vB[1]);
        PG8_WAIT_V(6); PG8_BAR;
    }
    for (;;) {
        const bool has_next = S.next(ui + 1, nxt);
        if (has_next) { PG8_META(nxt, (ui + 1) % 3); }
        const char* nA = has_next ? nxt.A : cA; const char* nB = has_next ? nxt.B : cB;
        const int nt = (Sched::VARK ? cur.x3 : K) / BK;
#pragma unroll 1
        for (int t = 0; t < nt; t += 2) {
            const bool last = (t == nt - 2);
            const char* a1 = cA + (size_t)(t + 1) * kstep;
            const char* a2 = last ? nA : cA + (size_t)(t + 2) * kstep; const char* b2 = last ? nB : cB + (size_t)(t + 2) * kstep;
            const char* a3 = a2 + kstep; const char* b3 = b2 + kstep;
            if constexpr (SP2) {
            PG8_LDB(B0, 0, 0); PG8_LDB(B1, 0, 1); PG8_SCHED; PG8_LDA(At, 0, 0); PG8_STAGE(PG8_SA(1, 1), a1, vA[1]);
            if constexpr (GATHER) { if (last && has_next) { const PG8_LAS unsigned char* _mt = (const PG8_LAS unsigned char*)(lds + PG8_META_OFF + ((ui + 1) % 3) * 4096); \
                _Pragma("unroll") for (int _i = 0; _i < 2; ++_i) { int _R, _C; stage_rc(tid * 16 + _i * 8192, _R, _C); \
                _Pragma("unroll") for (int _h = 0; _h < 2; ++_h) vA[_h][_i] = (unsigned)(S.arow_lds(nxt, _R + 128 * _h, _mt) * K + _C) * 2u; } } } \
            if constexpr (Sched::VARK) { if (last && has_next) { const int _K = nxt.x3; \
                _Pragma("unroll") for (int _i = 0; _i < 2; ++_i) { int _R, _C; stage_rc(tid * 16 + _i * 8192, _R, _C); const int _Rb = Epi::PERM ? ((_R & ~31) + perm32(_R & 31)) : _R; \
                _Pragma("unroll") for (int _h = 0; _h < 2; ++_h) { vA[_h][_i] = (unsigned)((_R + 128 * _h) * _K + _C) * 2u; vB[_h][_i] = (unsigned)((_Rb + 128 * _h) * _K + _C) * 2u; } } } }
            PG8_WAIT_V(8); PG8_WAIT_L(0); PG8_BAR; PG8_MMA(0, 0, At, B0); PG8_MMA(0, 1, At, B1); PG8_BAR; PG8_SCHED;
            PG8_LDA(At, 0, 1); PG8_STAGE(PG8_SB(0, 0), b2, vB[0]); PG8_STAGE(PG8_SB(0, 1), b2, vB[1]); PG8_STAGE(PG8_SA(0, 0), a2, vA[0]);
            PG8_WAIT_V(8); PG8_WAIT_L(0); PG8_BAR; PG8_MMA(1, 0, At, B0); PG8_MMA(1, 1, At, B1); PG8_BAR; PG8_SCHED;
            PG8_LDB(B0, 1, 0); PG8_LDB(B1, 1, 1); PG8_SCHED; PG8_LDA(At, 1, 0); PG8_STAGE(PG8_SA(0, 1), a2, vA[1]);
            PG8_WAIT_V(8); PG8_WAIT_L(0); PG8_BAR; PG8_MMA(0, 0, At, B0); PG8_MMA(0, 1, At, B1); PG8_BAR; PG8_SCHED;
            PG8_LDA(At, 1, 1); PG8_STAGE(PG8_SB(1, 0), b3, vB[0]); PG8_STAGE(PG8_SB(1, 1), b3, vB[1]); PG8_STAGE(PG8_SA(1, 0), a3, vA[0]);
            PG8_WAIT_V(8); PG8_WAIT_L(0); PG8_BAR; PG8_MMA(1, 0, At, B0); PG8_MMA(1, 1, At, B1); PG8_BAR; PG8_SCHED;
            } else {
            PG8_LDB(B0, 0, 0); PG8_SCHED; PG8_LDA(At, 0, 0); PG8_STAGE(PG8_SA(1, 1), a1, vA[1]);
            if constexpr (GATHER) { if (last && has_next) { const PG8_LAS unsigned char* _mt = (const PG8_LAS unsigned char*)(lds + PG8_META_OFF + ((ui + 1) % 3) * 4096); \
                _Pragma("unroll") for (int _i = 0; _i < 2; ++_i) { int _R, _C; stage_rc(tid * 16 + _i * 8192, _R, _C); \
                _Pragma("unroll") for (int _h = 0; _h < 2; ++_h) vA[_h][_i] = (unsigned)(S.arow_lds(nxt, _R + 128 * _h, _mt) * K + _C) * 2u; } } } \
            if constexpr (Sched::VARK) { if (last && has_next) { const int _K = nxt.x3; \
                _Pragma("unroll") for (int _i = 0; _i < 2; ++_i) { int _R, _C; stage_rc(tid * 16 + _i * 8192, _R, _C); const int _Rb = Epi::PERM ? ((_R & ~31) + perm32(_R & 31)) : _R; \
                _Pragma("unroll") for (int _h = 0; _h < 2; ++_h) { vA[_h][_i] = (unsigned)((_R + 128 * _h) * _K + _C) * 2u; vB[_h][_i] = (unsigned)((_Rb + 128 * _h) * _K + _C) * 2u; } } } }
            PG8_WAIT_L(8); PG8_BAR; PG8_WAIT_L(0); PG8_MMA(0, 0, At, B0); PG8_BAR; PG8_SCHED;
            PG8_LDB(B1, 0, 1); PG8_STAGE(PG8_SB(0, 0), b2, vB[0]);
            PG8_BAR; PG8_WAIT_L(0); PG8_MMA(0, 1, At, B1); PG8_BAR;
            PG8_LDA(At, 0, 1); PG8_STAGE(PG8_SA(0, 0), a2, vA[0]);
            PG8_BAR; PG8_WAIT_L(0); PG8_MMA(1, 0, At, B0); PG8_BAR; PG8_SCHED;
            PG8_STAGE(PG8_SB(0, 1), b2, vB[1]);
            PG8_WAIT_V(6); PG8_BAR; PG8_MMA(1, 1, At, B1); PG8_BAR;
            PG8_LDB(B0, 1, 0); PG8_SCHED; PG8_LDA(At, 1, 0); PG8_STAGE(PG8_SA(0, 1), a2, vA[1]);
            PG8_WAIT_L(8); PG8_BAR; PG8_WAIT_L(0); PG8_MMA(0, 0, At, B0); PG8_BAR; PG8_SCHED;
            PG8_LDB(B1, 1, 1); PG8_STAGE(PG8_SB(1, 0), b3, vB[0]);
            PG8_BAR; PG8_WAIT_L(0); PG8_MMA(0, 1, At, B1); PG8_BAR;
            PG8_LDA(At, 1, 1); PG8_STAGE(PG8_SA(1, 0), a3, vA[0]);
            PG8_BAR; PG8_WAIT_L(0); PG8_MMA(1, 0, At, B0); PG8_BAR; PG8_SCHED;
            PG8_STAGE(PG8_SB(1, 1), b3, vB[1]);
            PG8_WAIT_V(6); PG8_BAR; PG8_MMA(1, 1, At, B1); PG8_BAR;
            }
        }
        if constexpr (FP8) asm volatile("s_nop 15" ::: "memory");
        if constexpr (ALIGN_EPI) { if (wr == 0) PG8_BAR; }
        E(acc, cur, wr, wc, fr, fq, (const PG8_LAS unsigned char*)(lds + PG8_META_OFF + (ui % 3) * 4096));
        if (!has_next) break;
#pragma unroll
        for (int a = 0; a < 2; ++a)
#pragma unroll
            for (int b = 0; b < 2; ++b)
#pragma unroll
                for (int m = 0; m < 4; ++m)
#pragma unroll
                    for (int n = 0; n < 2; ++n) acc[a][b][m][n] = (f32x4){0.f, 0.f, 0.f, 0.f};
        cur = nxt; cA = nA; cB = nB; ++ui;
        if constexpr (ALIGN_EPI) { if (wr == 1) PG8_BAR; }
    }
    PG8_WAIT_V(0);
    if constexpr (!ALIGN_EPI) { if (wr == 0) PG8_BAR; }
    PG8_BAR;
#undef PG8_SA
#undef PG8_SB
#undef PG8_STAGE
#undef PG8_LDA
#undef PG8_LDB
#undef PG8_MMA
#undef PG8_WAIT_V
#undef PG8_WAIT_L
#undef PG8_BAR
#undef PG8_SCHED
#undef PG8_ROWS
#undef PG8_META
}
}

__device__ __forceinline__ int rowmap(int mode, int col) {
    if (mode == 1) {
        const int l = col & 255, hl = l >> 6, d = l & 63;
        return (col & ~255) + 128 * (hl >> 1) + 32 * (2 * (hl & 1) + ((d >> 4) & 1)) + 16 * (d >> 5) + (d & 15);
    } else if (mode == 2) {
        const int isU = col >> 8, j = col & 255, pn = j >> 7, jl = j & 127;
        return 256 * pn + 128 * isU + 32 * (jl >> 5) + 16 * ((jl >> 2) & 1) + 4 * ((jl >> 3) & 3) + (jl & 3);
    } else if (mode == 4) {
        const int l = col & 255, wc = l >> 6, fq = (l >> 4) & 3, bj = (l >> 3) & 1, n = (l >> 2) & 1, r = l & 3;
        return (col & ~255) + 128 * bj + 32 * wc + 16 * n + 4 * fq + r;
    } else if (mode == 3) {
        const int x = col & 127, pair = x >> 5, y = x & 31;
        return (col & ~127) + 16 * (2 * pair + ((y >> 2) & 1)) + 4 * (y >> 3) + (y & 3);
    }
    return col;
}
__device__ __forceinline__ unsigned pk4_fp8(float a, float b, float c, float d) {
    a = fminf(fmaxf(a, -448.f), 448.f); b = fminf(fmaxf(b, -448.f), 448.f); c = fminf(fmaxf(c, -448.f), 448.f); d = fminf(fmaxf(d, -448.f), 448.f);
    unsigned x = (unsigned)__builtin_amdgcn_cvt_pk_fp8_f32(a, b, 0, false); return (unsigned)__builtin_amdgcn_cvt_pk_fp8_f32(c, d, (int)x, true);
}
template <bool F8>
__device__ void transpose_tile(const float* __restrict__ src, bf16_t* __restrict__ dst, int R, int C, int r0, int c0, float* tile  , int mode, float scale, const int wv_) {
    const int tid = WV * 64 + lane_id();
    f32x4 v[8];
#pragma unroll
    for (int i = 0; i < 8; ++i) v[i] = *(const f32x4*)(src + (size_t)(r0 + (tid >> 6) + 8 * i) * C + c0 + (tid & 63) * 4);
#pragma unroll
    for (int i = 0; i < 8; ++i) {
        float* tp = tile + ((tid >> 6) + 8 * i) * 257 + (tid & 63) * 4;
        tp[0] = v[i][0]; tp[1] = v[i][1]; tp[2] = v[i][2]; tp[3] = v[i][3];
    }
    __syncthreads();
    if constexpr (F8) {
        unsigned char* d8 = (unsigned char*)dst;
#pragma unroll
        for (int k = 0; k < 2; ++k) {
            const int id = tid + 512 * k, c = id >> 2, rr = (id & 3) * 16;
            float x[16];
#pragma unroll
            for (int j = 0; j < 16; ++j) x[j] = tile[(rr + j) * 257 + c] * scale;
            u32x4 w; w.x = pk4_fp8(x[0], x[1], x[2], x[3]); w.y = pk4_fp8(x[4], x[5], x[6], x[7]); w.z = pk4_fp8(x[8], x[9], x[10], x[11]); w.w = pk4_fp8(x[12], x[13], x[14], x[15]);
            *(u32x4*)(d8 + (size_t)rowmap(mode, c0 + c) * R + r0 + rr) = w;
        }
        __syncthreads();
        return;
    }
#pragma unroll
    for (int k = 0; k < 4; ++k) {
        const int id = tid + 512 * k, c = id >> 3, rr = (id & 7) * 8;
        float x[8];
#pragma unroll
        for (int j = 0; j < 8; ++j) x[j] = tile[(rr + j) * 257 + c];
        u32x4 w; w.x = cvt_pk_bf16(x[0], x[1]); w.y = cvt_pk_bf16(x[2], x[3]); w.z = cvt_pk_bf16(x[4], x[5]); w.w = cvt_pk_bf16(x[6], x[7]);
        *(u32x4*)(dst + (size_t)rowmap(mode, c0 + c) * R + r0 + rr) = w;
    }
    __syncthreads();
}

template <bool F8 = false>
__device__ __forceinline__ int transpose_job(const float* src, bf16_t* dst, int batch, int R, int C, int base, float* tile, int mode, const int wv_, float scale = 1.0f) {
    const int nb = gridDim.x, bid = blockIdx.x;
    const int tr = R / 64, tc = C / 256, per = tr * tc, tot = per * batch;
    const int first = (bid - (base % nb) + nb) % nb;
    for (int t = first; t < tot; t += nb) {
        const int e = t / per, r = t % per, ti = r / tc, tj = r % tc;
        transpose_tile<F8>(src + (size_t)e * R * C, F8 ? (bf16_t*)((unsigned char*)dst + (size_t)e * R * C) : dst + (size_t)e * R * C, R, C, ti * 64, tj * 256, tile, mode, scale, wv_);
    }
    return base + tot;
}

__device__ __forceinline__ float log2_sigmoid(float x) {
    const float ax = fabsf(x);
    const float sp = fmaxf(-x, 0.f) + log1pf(__expf(-ax));
    return -sp * LOG2E;
}

__device__ void phase0(const Params& p, unsigned char* lds, const int wv_) {
    unsigned char* ws = p.ws;
    const int tid = WV * 64 + lane_id(), nb = gridDim.x, bid = blockIdx.x;
    for (int idx = bid * NTHREADS + tid; idx < SEQ * 32; idx += nb * NTHREADS) {
        const int s = idx >> 5, i = idx & 31;
        const double ang = (double)s * INV_FREQ[i];
        const double rev = ang * 0.15915494309189535;
        const double fr = rev - floor(rev);
        const float ff = (float)fr;
        float2 cs; cs.x = __builtin_amdgcn_cosf(ff); cs.y = __builtin_amdgcn_sinf(ff);
        ((float2*)(ws + WS_ROPE))[idx] = cs;
    }
    if (bid == 0 && tid < 16) ((float*)(ws + WS_LGT))[tid] = log2_sigmoid(tid < 8 ? p.in[3][tid] : p.in[4][tid - 8]);
    for (int idx = bid * NTHREADS + tid; idx < 8 * 4 * 4 * 64; idx += nb * NTHREADS) {
        const int ln = idx & 63, nt = (idx >> 6) & 3, ks = (idx >> 8) & 3, w = idx >> 10, li = ln & 15, q = ln >> 4;
        float wv[8];
#pragma unroll
        for (int j = 0; j < 8; ++j) wv[j] = p.in[10][(size_t)(128 * w + 32 * ks + 8 * q + j) * 64 + 16 * nt + li];
        u32x4 hi, lo;
        hi.x = cvt_pk_bf16(wv[0], wv[1]); hi.y = cvt_pk_bf16(wv[2], wv[3]); hi.z = cvt_pk_bf16(wv[4], wv[5]); hi.w = cvt_pk_bf16(wv[6], wv[7]);
        lo.x = cvt_pk_bf16(wv[0] - bflo(hi.x), wv[1] - bfhi(hi.x)); lo.y = cvt_pk_bf16(wv[2] - bflo(hi.y), wv[3] - bfhi(hi.y));
        lo.z = cvt_pk_bf16(wv[4] - bflo(hi.z), wv[5] - bfhi(hi.z)); lo.w = cvt_pk_bf16(wv[6] - bflo(hi.w), wv[7] - bfhi(hi.w));
        u32x4* dst = (u32x4*)(ws + WS_WRF) + (size_t)(((w * 4 + ks) * 4 + nt) * 2) * 64 + ln;
        dst[0] = hi; dst[64] = lo;
    }
    {
        const float* x = p.in[0]; bf16_t* xb = (bf16_t*)(ws + WS_XB);
        const size_t n8 = (size_t)T_TOK * DM / 8;
        for (size_t i = (size_t)bid * NTHREADS + tid; i < n8; i += (size_t)nb * NTHREADS) {
            const f32x4 a = *(const f32x4*)(x + i * 8), b = *(const f32x4*)(x + i * 8 + 4);
            u32x4 w; w.x = cvt_pk_bf16(a[0], a[1]); w.y = cvt_pk_bf16(a[2], a[3]); w.z = cvt_pk_bf16(b[0], b[1]); w.w = cvt_pk_bf16(b[2], b[3]);
            *(u32x4*)(xb + i * 8) = w;
        }
        const float* pp = p.in[1]; bf16_t* pb = (bf16_t*)(ws + WS_PB);
        const size_t m8 = (size_t)T_TOK * PLE / 8;
        for (size_t i = (size_t)bid * NTHREADS + tid; i < m8; i += (size_t)nb * NTHREADS) {
            const f32x4 a = *(const f32x4*)(pp + i * 8), b = *(const f32x4*)(pp + i * 8 + 4);
            u32x4 w; w.x = cvt_pk_bf16(a[0], a[1]); w.y = cvt_pk_bf16(a[2], a[3]); w.z = cvt_pk_bf16(b[0], b[1]); w.w = cvt_pk_bf16(b[2], b[3]);
            *(u32x4*)(pb + i * 8) = w;
        }
    }
    float* tile = (float*)lds;
    int base = 0;
    base = transpose_job(p.in[2],  (bf16_t*)(ws + WS_WINT), 1, 1024, 3584, base, tile, 1, wv_);
    base = transpose_job<true>(p.in[7],  (bf16_t*)(ws + WS_WOUTT), 1, 1024, 1024, base, tile, 3, wv_, WO_SCALE);
    base = transpose_job<true>(p.in[12], (bf16_t*)(ws + WS_WGUT), 64, 1024, 512, base, tile, 2, wv_, WGU_SCALE);
    base = transpose_job<true>(p.in[14], (bf16_t*)(ws + WS_WGUT + (size_t)64 * 512 * 1024), 1, 1024, 512, base, tile, 2, wv_, WGU_SCALE);
    base = transpose_job<true>(p.in[13], (bf16_t*)(ws + WS_WDT), 64, 256, 1024, base, tile, 4, wv_, WD_SCALE);
    base = transpose_job<true>(p.in[15], (bf16_t*)(ws + WS_WDT + (size_t)64 * 1024 * 256), 1, 256, 1024, base, tile, 4, wv_, WD_SCALE);
    base = transpose_job<true>(p.in[17], (bf16_t*)(ws + WS_WGATE), 1, 1024, 1024, base, tile, 4, wv_, WGU_SCALE);
    base = transpose_job(p.in[16], (bf16_t*)(ws + WS_WPT), 1, 256, 1024, base, tile, 4, wv_);
}

struct SchedDense {
    static constexpr bool VARK = false;
    const char* A; const char* B; int K; pg8::TileOrder ord;
    __device__ bool next(int i, pg8::Unit& u) const {
        int pm, pn; if (!ord.map((long)i * gridDim.x + blockIdx.x, pm, pn)) return false;
        u.pm = pm; u.pn = pn; u.A = A + (size_t)pm * 256 * K * 2; u.B = B + (size_t)pn * 256 * K * 2; u.x0 = u.x1 = u.x2 = u.x3 = 0; return true;
    }
    __device__ int arow(const pg8::Unit&, int r) const { return r; }
};
struct EpiInProj {
    static constexpr bool PERM = false; static constexpr int NMETA = 0;
    __device__ const char* meta_src(const pg8::Unit&, int) const { return nullptr; }
    unsigned char* ws;
    __device__ __forceinline__ void operator()(const f32x4 (&acc)[2][2][4][2], const pg8::Unit& u, int wr, int wc, int fr_, int fq_, const PG8_LAS unsigned char* meta) const {
        int fr = fr_, fq = fq_; asm volatile("" : "+v"(fr), "+v"(fq));
        if (u.x0 == 1) {
            unsigned char* proj = ws + WS_PLE;
#pragma unroll
            for (int ai = 0; ai < 2; ++ai)
#pragma unroll
                for (int m = 0; m < 4; ++m) {
                    const size_t t = u.pm * 256 + 128 * ai + 64 * wr + 16 * m + fr;
                    u32x4 w; unsigned o[4];
#pragma unroll
                    for (int bj = 0; bj < 2; ++bj)
#pragma unroll
                        for (int n = 0; n < 2; ++n) { const f32x4 a = acc[ai][bj][m][n] * PLE_SCALE; o[2 * bj + n] = pk4_fp8(a[0], a[1], a[2], a[3]); }
                    w.x = o[0]; w.y = o[1]; w.z = o[2]; w.w = o[3];
                    *(u32x4*)(proj + t * DM + u.pn * 256 + 64 * wc + 16 * fq) = w;
                }
            return;
        }
        const float2* rope = (const float2*)(ws + WS_ROPE);
        const int region = u.pn >> 1, d0 = 16 * (wc & 1) + 4 * fq;
#pragma unroll
        for (int ai = 0; ai < 2; ++ai)
#pragma unroll
            for (int m = 0; m < 4; ++m) {
                const int t = u.pm * 256 + 128 * ai + 64 * wr + 16 * m + fr, b = t >> 12, s = t & 4095;
                f32x4 cs0, cs1;
                if (region <= 1) { cs0 = *(const f32x4*)(rope + (size_t)s * 32 + d0); cs1 = *(const f32x4*)(rope + (size_t)s * 32 + d0 + 2); }
#pragma unroll
                for (int bj = 0; bj < 2; ++bj) {
                    const int head = 4 * (u.pn & 1) + 2 * bj + (wc >> 1), bh = b * 8 + head;
                    const f32x4 a0 = acc[ai][bj][m][0], a1 = acc[ai][bj][m][1];
                    if (region <= 1) {
                        const float sc = region == 1 ? 0.125f : 1.0f;
                        const float co[4] = {cs0[0], cs0[2], cs1[0], cs1[2]}, si[4] = {cs0[1], cs0[3], cs1[1], cs1[3]};
                        float o1[4], o2[4];
#pragma unroll
                        for (int r = 0; r < 4; ++r) { o1[r] = (a0[r] * co[r] - a1[r] * si[r]) * sc; o2[r] = (a0[r] * si[r] + a1[r] * co[r]) * sc; }
                        u32x2 w1, w2; w1.x = cvt_pk_bf16(o1[0], o1[1]); w1.y = cvt_pk_bf16(o1[2], o1[3]); w2.x = cvt_pk_bf16(o2[0], o2[1]); w2.y = cvt_pk_bf16(o2[2], o2[3]);
                        bf16_t* dst = (bf16_t*)(ws + (region == 0 ? WS_Q : WS_K)) + ((size_t)bh * SEQ + s) * 64;
                        *(u32x2*)(dst + d0) = w1; *(u32x2*)(dst + d0 + 32) = w2;
                        if (region == 1) {
                            bf16_t* dstT = (bf16_t*)(ws + WS_KT) + (size_t)bh * 64 * SEQ + s;
                            dstT[(size_t)(d0 + 0) * SEQ] = (bf16_t)(w1.x & 0xffff); dstT[(size_t)(d0 + 1) * SEQ] = (bf16_t)(w1.x >> 16);
                            dstT[(size_t)(d0 + 2) * SEQ] = (bf16_t)(w1.y & 0xffff); dstT[(size_t)(d0 + 3) * SEQ] = (bf16_t)(w1.y >> 16);
                            dstT[(size_t)(d0 + 32) * SEQ] = (bf16_t)(w2.x & 0xffff); dstT[(size_t)(d0 + 33) * SEQ] = (bf16_t)(w2.x >> 16);
                            dstT[(size_t)(d0 + 34) * SEQ] = (bf16_t)(w2.y & 0xffff); dstT[(size_t)(d0 + 35) * SEQ] = (bf16_t)(w2.y >> 16);
                        }
                    } else if (region == 2 || region == 6) {
                        bf16_t* dstT = (bf16_t*)(ws + (region == 2 ? WS_VT : WS_NVT)) + (size_t)bh * 64 * SEQ + s;
#pragma unroll
                        for (int r = 0; r < 4; ++r) { dstT[(size_t)(d0 + r) * SEQ] = f2bf(a0[r]); dstT[(size_t)(d0 + 32 + r) * SEQ] = f2bf(a1[r]); }
                    } else if (region == 3) {
                        bf16_t* dst = (bf16_t*)(ws + WS_G) + (size_t)t * 512 + head * 64;
                        u32x2 w1, w2; w1.x = cvt_pk_bf16(siluf_(a0[0]), siluf_(a0[1])); w1.y = cvt_pk_bf16(siluf_(a0[2]), siluf_(a0[3]));
                        w2.x = cvt_pk_bf16(siluf_(a1[0]), siluf_(a1[1])); w2.y = cvt_pk_bf16(siluf_(a1[2]), siluf_(a1[3]));
                        *(u32x2*)(dst + d0) = w1; *(u32x2*)(dst + d0 + 32) = w2;
                    } else {
                        const float sc = region == 4 ? 0.125f : 1.0f;
                        bf16_t* dst = (bf16_t*)(ws + (region == 4 ? WS_NQ : WS_NK)) + ((size_t)bh * SEQ + s) * 64;
                        u32x2 w1, w2; w1.x = cvt_pk_bf16(a0[0] * sc, a0[1] * sc); w1.y = cvt_pk_bf16(a0[2] * sc, a0[3] * sc);
                        w2.x = cvt_pk_bf16(a1[0] * sc, a1[1] * sc); w2.y = cvt_pk_bf16(a1[2] * sc, a1[3] * sc);
                        *(u32x2*)(dst + d0) = w1; *(u32x2*)(dst + d0 + 32) = w2;
                    }
                }
            }
    }
};
struct SchedP1 {
    static constexpr bool VARK = true;
    unsigned char* ws; pg8::TileOrder ord;
    __device__ bool next(int i, pg8::Unit& u) const {
        const long L = (long)i * gridDim.x + blockIdx.x;
        int pm, pn;
        if (ord.map(L, pm, pn)) {
            u.pm = pm; u.pn = pn; u.x0 = 0; u.x1 = u.x2 = 0; u.x3 = DM;
            u.A = (const char*)(ws + WS_XB) + (size_t)pm * 256 * DM * 2; u.B = (const char*)(ws + WS_WINT) + (size_t)pn * 256 * DM * 2; return true;
        }
        const int lastr = ord.nwg / (int)gridDim.x, c = (int)blockIdx.x, nfree = (int)gridDim.x - ord.nwg % (int)gridDim.x, cf = c - ord.nwg % (int)gridDim.x;
        if (cf < 0 || i < lastr) return false;
        const int per = (256 + nfree - 1) / nfree, j = i - lastr;
        if (j >= per) return false;
        const int x = cf * per + j;
        if (x >= 256) return false;
        u.pm = x >> 2; u.pn = x & 3; u.x0 = 1; u.x1 = u.x2 = 0; u.x3 = PLE;
        u.A = (const char*)(ws + WS_PB) + (size_t)u.pm * 256 * PLE * 2; u.B = (const char*)(ws + WS_WPT) + (size_t)u.pn * 256 * PLE * 2; return true;
    }
    __device__ int arow(const pg8::Unit&, int r) const { return r; }
};
__device__ void phase1(const Params& p, unsigned char* lds, const int wv_) {
    SchedP1 S; S.ws = p.ws; S.ord.init(T_TOK, NPROJ);
    EpiInProj E; E.ws = p.ws;
    pg8::gemm_phase<EpiInProj, SchedP1, false, true, true>((PG8_LAS unsigned char*)lds, DM, S, E, wv_);
}


__device__ void phase2(const Params& p, unsigned char* lds, const int wv_) {
    unsigned char* ws = p.ws;
    const int lane = lane_id(), wid = WV, tid = wid * 64 + lane, q = lane >> 4, li = lane & 15;
    const bf16_t* KT = (const bf16_t*)(ws + WS_KT); const bf16_t* VT = (const bf16_t*)(ws + WS_VT);
    const bf16_t* NQ = (const bf16_t*)(ws + WS_NQ); const bf16_t* NK = (const bf16_t*)(ws + WS_NK); const bf16_t* NVT = (const bf16_t*)(ws + WS_NVT);
    float* SST = (float*)(ws + WS_SST);
    unsigned char* mix = ws + WS_MIX;
    constexpr int KS_BYTES = 576 * 128, VROW = 1168, VS_BYTES = 64 * VROW;
    unsigned char* Ks = lds; unsigned char* Vs = lds + KS_BYTES; float* biasL = (float*)(lds + KS_BYTES + VS_BYTES);
    bf16_t* PS = (bf16_t*)(ws + WS_SST);
    const int G_ = gridDim.x, c_ = blockIdx.x, cswz = (G_ & 7) == 0 ? (c_ & 7) * (G_ >> 3) + (c_ >> 3) : c_;
    for (int u = cswz; u < 256; u += gridDim.x) {
        const int bh = u >> 3, dir = (u >> 2) & 1, dvt = u & 3, h = bh & 7;
        const float lg = ((const float*)(ws + WS_LGT))[8 * dir + h];
        const float gC = fast_exp2(lg * 128.f);
        constexpr int SLOT = 80 * 256;
        const bf16_t* src[3]; unsigned ldso[3];
#pragma unroll
        for (int k = 0; k < 3; ++k) {
            const int id = tid + 512 * k, r = (id >> 4) < 80 ? (id >> 4) : 0, ch = id & 15;
            src[k] = (r < 16 ? VT + ((size_t)bh * 64 + 16 * dvt + r) * SEQ : KT + ((size_t)bh * 64 + (r - 16)) * SEQ) + ch * 8;
            ldso[k] = (unsigned)(r * 256 + ((ch ^ (r & 15)) << 4));
        }
        const bool has3 = tid < 256;
        u32x4 rg[3][3];
#define SCAN_LOAD(slot, c) do { _Pragma("unroll") for (int k = 0; k < 2; ++k) rg[slot][k] = *(const u32x4*)(src[k] + (c) * 128); if (has3) rg[slot][2] = *(const u32x4*)(src[2] + (c) * 128); } while (0)
#define SCAN_STORE(slot, ls) do { _Pragma("unroll") for (int k = 0; k < 2; ++k) *(u32x4*)(lds + (ls) * SLOT + ldso[k]) = rg[slot][k]; if (has3) *(u32x4*)(lds + (ls) * SLOT + ldso[2]) = rg[slot][2]; } while (0)
#define SCAN_CH(step) (dir == 0 ? (step) : 31 - (step))
        SCAN_LOAD(0, SCAN_CH(0)); SCAN_LOAD(1, SCAN_CH(1)); SCAN_LOAD(2, SCAN_CH(2));
        float wg[4][8];
#pragma unroll
        for (int ks = 0; ks < 4; ++ks)
#pragma unroll
            for (int j = 0; j < 8; ++j) { const int jl = 32 * ks + 8 * q + j; wg[ks][j] = fast_exp2(lg * (float)(dir == 0 ? (127 - jl) : jl)); }
        f32x4 st = (f32x4){0.f, 0.f, 0.f, 0.f};
        __syncthreads();
        SCAN_STORE(0, 0);
#pragma unroll 1
        for (int s3 = 0; s3 < 33; s3 += 3) {
#pragma unroll
            for (int j = 0; j < 3; ++j) {
                const int step = s3 + j;
                if (step < 32) {
                    if (step + 3 < 32) SCAN_LOAD(j, SCAN_CH(step + 3));
                    __syncthreads();
                    if (step + 1 < 32) SCAN_STORE((j + 1) % 3, (step + 1) & 1);
                    if (wid < 4) {
                        const int c = SCAN_CH(step);
                        bf16_t* dst = PS + ((size_t)(bh * 32 + c) * 2 + dir) * 4096;
#pragma unroll
                        for (int r = 0; r < 4; ++r) dst[(16 * dvt + 4 * q + r) * 64 + 16 * wid + li] = f2bf(st[r]);
                        st = st * gC;
                        const unsigned char* sl = lds + (step & 1) * SLOT;
#pragma unroll
                        for (int ks = 0; ks < 4; ++ks) {
                            const u32x4 vr = *(const u32x4*)(sl + li * 256 + (((4 * ks + q) ^ li) << 4));
                            const u32x4 kr = *(const u32x4*)(sl + (16 + 16 * wid + li) * 256 + (((4 * ks + q) ^ li) << 4));
                            u32x4 kw;
                            kw.x = cvt_pk_bf16(bflo(kr.x) * wg[ks][0], bfhi(kr.x) * wg[ks][1]); kw.y = cvt_pk_bf16(bflo(kr.y) * wg[ks][2], bfhi(kr.y) * wg[ks][3]);
                            kw.z = cvt_pk_bf16(bflo(kr.z) * wg[ks][4], bfhi(kr.z) * wg[ks][5]); kw.w = cvt_pk_bf16(bflo(kr.w) * wg[ks][6], bfhi(kr.w) * wg[ks][7]);
                            st = MFMA16(__builtin_bit_cast(bf16x8, vr), __builtin_bit_cast(bf16x8, kw), st);
                        }
                    }
                }
            }
        }
#undef SCAN_LOAD
#undef SCAN_STORE
#undef SCAN_CH
    }
    u32x4 kreg[9], vreg[9]; float breg = 0.f;
#define NA_DECODE(xx) const int rp = (xx) & 31, h = ((xx) >> 5) & 7, b = (xx) >> 8, bh = b * 8 + h; const int r0 = 2 * rp, base_r = min(min(max(r0 - 4, 0), 56), 55)
#define NA_LOAD(xx) do { NA_DECODE(xx); const u32x4* ksrc = (const u32x4*)(NK + ((size_t)bh * SEQ + base_r * 64) * 64); \
        _Pragma("unroll") for (int i = 0; i < 9; ++i) kreg[i] = ksrc[tid + 512 * i]; \
        _Pragma("unroll") for (int i = 0; i < 9; ++i) { const int id = tid + 512 * i, row = id / 72, ch = id % 72; vreg[i] = *(const u32x4*)(NVT + ((size_t)bh * 64 + row) * SEQ + base_r * 64 + ch * 8); } \
        if (tid < 15 * 31) breg = p.in[6][h * 15 * 31 + tid]; } while (0)
    if (cswz < 1024) NA_LOAD(cswz);
    for (int x = cswz; x < 1024; x += gridDim.x) {
        {
            NA_DECODE(x);
            __syncthreads();
            if (tid < 15 * 31) biasL[tid] = breg;
#pragma unroll
            for (int i = 0; i < 9; ++i) { const int id = tid + 512 * i, row = id >> 3, ch = id & 7; *(u32x4*)(Ks + row * 128 + ((ch ^ (row & 7)) << 4)) = kreg[i]; }
#pragma unroll
            for (int i = 0; i < 9; ++i) { const int id = tid + 512 * i, row = id / 72, ch = id % 72; *(u32x4*)(Vs + row * VROW + ch * 16) = vreg[i]; }
            __syncthreads();
            if (x + (int)gridDim.x < 1024) NA_LOAD(x + (int)gridDim.x);
            const int r = r0 + (wid >> 2), cblk = wid & 3;
            const int rs = min(max(r - 4, 0), 56), kr0 = rs - base_r;
            const int cw = cblk == 0 ? 0 : (cblk == 1 ? 8 : (cblk == 2 ? 24 : 32));
            const int c = 16 * cblk + li, cs = min(max(c - 8, 0), 48);
            const size_t qtok = (size_t)bh * SEQ + r * 64 + c;
            bf16x8 qf[2];
            qf[0] = *(const bf16x8*)(NQ + qtok * 64 + 8 * q); qf[1] = *(const bf16x8*)(NQ + qtok * 64 + 32 + 8 * q);
            f32x4 sT[16];
            const int wcol_l = 8 * (li >> 2) + (li & 3);
#pragma unroll
            for (int kt = 0; kt < 16; ++kt) {
                const int krow = (kr0 + (kt >> 1)) * 64 + cw + wcol_l + 4 * (kt & 1);
                const bf16x8 k0 = *(const bf16x8*)(Ks + krow * 128 + ((q ^ (krow & 7)) << 4));
                const bf16x8 k1 = *(const bf16x8*)(Ks + krow * 128 + (((4 + q) ^ (krow & 7)) << 4));
                f32x4 a = (f32x4){0.f, 0.f, 0.f, 0.f};
                a = MFMA16(k0, qf[0], a); a = MFMA16(k1, qf[1], a);
                sT[kt] = a;
            }
            float mx = -3.0e38f;
#pragma unroll
            for (int kt = 0; kt < 16; ++kt) {
                const float* brow = biasL + (rs + (kt >> 1) - r + 7) * 31;
#pragma unroll
                for (int rr = 0; rr < 4; ++rr) {
                    const int kc = cw + 8 * q + 4 * (kt & 1) + rr;
                    const bool valid = (kc >= cs) && (kc <= cs + 15);
                    const int bi = min(max(kc - c + 15, 0), 30);
                    float bv = brow[bi]; asm volatile("" : "+v"(bv));
                    const float sv = valid ? (sT[kt][rr] + bv) : -3.0e38f;
                    sT[kt][rr] = sv; mx = fmaxf(mx, sv);
                }
            }
            mx = fmaxf(mx, __shfl_xor(mx, 16)); mx = fmaxf(mx, __shfl_xor(mx, 32));
            float sum = 0.f;
#pragma unroll
            for (int kt = 0; kt < 16; ++kt)
#pragma unroll
                for (int rr = 0; rr < 4; ++rr) { const float e = fast_exp2((sT[kt][rr] - mx) * LOG2E); sT[kt][rr] = e; sum += e; }
            sum += __shfl_xor(sum, 16); sum += __shfl_xor(sum, 32);
            const float inv = 1.0f / sum;
            f32x4 oT[4];
#pragma unroll
            for (int d = 0; d < 4; ++d) oT[d] = (f32x4){0.f, 0.f, 0.f, 0.f};
#pragma unroll
            for (int ks = 0; ks < 8; ++ks) {
                u32x4 pw; pw.x = cvt_pk_bf16(sT[2 * ks][0], sT[2 * ks][1]); pw.y = cvt_pk_bf16(sT[2 * ks][2], sT[2 * ks][3]);
                pw.z = cvt_pk_bf16(sT[2 * ks + 1][0], sT[2 * ks + 1][1]); pw.w = cvt_pk_bf16(sT[2 * ks + 1][2], sT[2 * ks + 1][3]);
                const bf16x8 pf = __builtin_bit_cast(bf16x8, pw);
                const int vtok = (kr0 + ks) * 64 + cw + 8 * q;
#pragma unroll
                for (int d = 0; d < 4; ++d) {
                    const bf16x8 vf = *(const bf16x8*)(Vs + (16 * d + li) * VROW + vtok * 2);
                    oT[d] = MFMA16(vf, pf, oT[d]);
                }
            }
            unsigned char* dst = mix + ((size_t)b * SEQ + r * 64 + c) * DM + 512 + h * 64 + 4 * q;
            const float invs = inv * MIX_SCALE;
#pragma unroll
            for (int d = 0; d < 4; ++d) *(unsigned*)(dst + 16 * d) = pk4_fp8(oT[d][0] * invs, oT[d][1] * invs, oT[d][2] * invs, oT[d][3] * invs);
        }
    }
}

__device__ void phase3(const Params& p, unsigned char* lds, const int wv_) {
    unsigned char* ws = p.ws;
    const int lane = lane_id(), wid = WV, tid = wid * 64 + lane, q = lane >> 4, li = lane & 15;
    const bf16_t* Q = (const bf16_t*)(ws + WS_Q); const bf16_t* Kp = (const bf16_t*)(ws + WS_K); const bf16_t* VT = (const bf16_t*)(ws + WS_VT);
    const bf16_t* Gt = (const bf16_t*)(ws + WS_G);
    const bf16_t* PS = (const bf16_t*)(ws + WS_SST);
    unsigned char* mix = ws + WS_MIX;
    constexpr int PROW = 144;
    unsigned char* Ks = lds + 2 * 64 * PROW;
    unsigned char* Vs = Ks + 128 * 128;
    for (int u = blockIdx.x; u < 1024; u += gridDim.x) {
        const int bh = u >> 5, c = u & 31, h = bh & 7, b = bh >> 3;
        const float lf = ((const float*)(ws + WS_LGT))[h], lb = ((const float*)(ws + WS_LGT))[8 + h];
        __syncthreads();
        u32x4 kreg[2], vreg[2];
#pragma unroll
        for (int i = 0; i < 2; ++i) {
            const int id = tid + 512 * i;
            kreg[i] = *(const u32x4*)(Kp + ((size_t)bh * SEQ + c * 128) * 64 + id * 8);
            vreg[i] = *(const u32x4*)(VT + ((size_t)bh * 64 + (id >> 4)) * SEQ + c * 128 + (id & 15) * 8);
        }
        u32x4 preg[2];
#pragma unroll
        for (int rep = 0; rep < 2; ++rep) preg[rep] = *(const u32x4*)(PS + (size_t)(bh * 32 + c) * 2 * 4096 + (size_t)(tid + 512 * rep) * 8);
#pragma unroll
        for (int rep = 0; rep < 2; ++rep) {
            const int id = tid + 512 * rep, dir = id >> 9, dv = (id >> 3) & 63, ch = id & 7;
            *(u32x4*)(lds + dir * (64 * PROW) + dv * PROW + ch * 16) = preg[rep];
        }
#pragma unroll
        for (int i = 0; i < 2; ++i) {
            const int id = tid + 512 * i;
            { const int row = id >> 3, ch = id & 7; *(u32x4*)(Ks + row * 128 + ((ch ^ (row & 7)) << 4)) = kreg[i]; }
            { const int row = id >> 4, ch = id & 15; *(u32x4*)(Vs + row * 256 + ((ch ^ (row & 15)) << 4)) = vreg[i]; }
        }
        __syncthreads();
        const int ii = 16 * wid + li;
        const size_t qrow = (size_t)bh * SEQ + c * 128 + ii;
        bf16x8 qf[2];
        qf[0] = *(const bf16x8*)(Q + qrow * 64 + 8 * q); qf[1] = *(const bf16x8*)(Q + qrow * 64 + 32 + 8 * q);
        f32x4 sT[8];
        const int kl = 8 * (li >> 2) + (li & 3);
#pragma unroll
        for (int jt = 0; jt < 8; ++jt) {
            const int krow = 32 * (jt >> 1) + kl + 4 * (jt & 1);
            const bf16x8 k0 = *(const bf16x8*)(Ks + krow * 128 + ((q ^ (krow & 7)) << 4));
            const bf16x8 k1 = *(const bf16x8*)(Ks + krow * 128 + (((4 + q) ^ (krow & 7)) << 4));
            f32x4 a = (f32x4){0.f, 0.f, 0.f, 0.f};
            a = MFMA16(k0, qf[0], a); a = MFMA16(k1, qf[1], a);
#pragma unroll
            for (int rr = 0; rr < 4; ++rr) {
                const int j = 32 * (jt >> 1) + 8 * q + 4 * (jt & 1) + rr, diff = ii - j;
                const float d = diff >= 0 ? fast_exp2(lf * (float)diff) : fast_exp2(lb * (float)(-diff));
                a[rr] *= d;
            }
            sT[jt] = a;
        }
        f32x4 yT[4], uf[4], ub[4];
#pragma unroll
        for (int d = 0; d < 4; ++d) { yT[d] = (f32x4){0.f, 0.f, 0.f, 0.f}; uf[d] = yT[d]; ub[d] = yT[d]; }
#pragma unroll
        for (int ks = 0; ks < 4; ++ks) {
            u32x4 pw; pw.x = cvt_pk_bf16(sT[2 * ks][0], sT[2 * ks][1]); pw.y = cvt_pk_bf16(sT[2 * ks][2], sT[2 * ks][3]);
            pw.z = cvt_pk_bf16(sT[2 * ks + 1][0], sT[2 * ks + 1][1]); pw.w = cvt_pk_bf16(sT[2 * ks + 1][2], sT[2 * ks + 1][3]);
            const bf16x8 pf = __builtin_bit_cast(bf16x8, pw);
#pragma unroll
            for (int d = 0; d < 4; ++d) {
                const int vrow = 16 * d + li;
                const bf16x8 vf = *(const bf16x8*)(Vs + vrow * 256 + (((4 * ks + q) ^ li) << 4));
                yT[d] = MFMA16(vf, pf, yT[d]);
            }
        }
#pragma unroll
        for (int d = 0; d < 4; ++d)
#pragma unroll
            for (int ks = 0; ks < 2; ++ks) {
                const bf16x8 pfw = *(const bf16x8*)(lds + (16 * d + li) * PROW + ks * 64 + q * 16);
                const bf16x8 pbw = *(const bf16x8*)(lds + 64 * PROW + (16 * d + li) * PROW + ks * 64 + q * 16);
                uf[d] = MFMA16(pfw, qf[ks], uf[d]); ub[d] = MFMA16(pbw, qf[ks], ub[d]);
            }
        const float df = fast_exp2(lf * (float)(ii + 1)), db = fast_exp2(lb * (float)(128 - ii));
        float sum = 0.f;
#pragma unroll
        for (int d = 0; d < 4; ++d)
#pragma unroll
            for (int rr = 0; rr < 4; ++rr) { const float y = yT[d][rr] + df * uf[d][rr] + db * ub[d][rr]; yT[d][rr] = y; sum += y; }
        sum += __shfl_xor(sum, 16); sum += __shfl_xor(sum, 32);
        const float mu = sum * (1.0f / 64.0f);
        float var = 0.f;
#pragma unroll
        for (int d = 0; d < 4; ++d)
#pragma unroll
            for (int rr = 0; rr < 4; ++rr) { const float t = yT[d][rr] - mu; var += t * t; }
        var += __shfl_xor(var, 16); var += __shfl_xor(var, 32);
        const float rstd = rsqrtf(var * (1.0f / 64.0f) + 1e-6f);
        const size_t tg = (size_t)b * SEQ + c * 128 + ii;
#pragma unroll
        for (int d = 0; d < 4; ++d) {
            const int dv = 16 * d + 4 * q;
            const f32x4 gn = *(const f32x4*)(p.in[5] + h * 64 + dv);
            const u32x2 gw = *(const u32x2*)(Gt + tg * 512 + h * 64 + dv);
            const float o0 = (yT[d][0] - mu) * rstd * gn[0] * bflo(gw.x), o1 = (yT[d][1] - mu) * rstd * gn[1] * bfhi(gw.x);
            const float o2 = (yT[d][2] - mu) * rstd * gn[2] * bflo(gw.y), o3 = (yT[d][3] - mu) * rstd * gn[3] * bfhi(gw.y);
            *(unsigned*)(mix + tg * DM + h * 64 + dv) = pk4_fp8(o0 * MIX_SCALE, o1 * MIX_SCALE, o2 * MIX_SCALE, o3 * MIX_SCALE);
        }
    }
}

__device__ void phase4(const Params& p, unsigned char* lds, const int wv_) {
    unsigned char* ws = p.ws;
    const int lane = lane_id(), wid = WV, tid = wid * 64 + lane, q = lane >> 4, li = lane & 15;
    const unsigned char* A = ws + WS_MIX; const unsigned char* Bt = ws + WS_WOUTT;
    const float* x = p.in[0]; const float* g1 = p.in[8]; const float* b1 = p.in[9]; const float* rb = p.in[11];
    bf16_t* x1b = (bf16_t*)(ws + WS_X1B);
    unsigned* counts = (unsigned*)(ws + WS_CTRL);
    int* ltok = (int*)(ws + WS_LTOK); float2* lkw = (float2*)(ws + WS_LKW);
    float* pl = (float*)lds;
    float* red = (float*)(lds + 147456);
    unsigned* lcnt = (unsigned*)(lds + 147456 + 2048);
    for (int unit = blockIdx.x; unit < T_TOK / 64; unit += gridDim.x) {
        const int m0 = unit * 64;
        f32x4 acc[4][8];
        {
            int lane2 = lane_id(); asm volatile("" : "+v"(lane2)); const int li2 = lane2 & 15, q2 = lane2 >> 4;
            constexpr int GA = 64 * 128, GSTAGE = GA + 256 * 128;
            PG8_LAS unsigned char* L = (PG8_LAS unsigned char*)lds;
            const int prow = lane2 >> 3, pch = (lane2 & 7) ^ (lane2 >> 3);
            const char* asrc = (const char*)(A + (size_t)(m0 + 8 * wid + prow) * DM) + pch * 16;
            const char* bsrc = (const char*)(Bt + (size_t)(128 * wid + prow) * DM) + pch * 16;
            const unsigned rA = (unsigned)li2 * 128u, rB = (unsigned)GA + (unsigned)(wid * 32 + li2) * 128u;
            const unsigned c0_ = (unsigned)((q2 ^ (li2 & 7)) << 4), c1_ = (unsigned)(((4 + q2) ^ (li2 & 7)) << 4);
#define P4_ISSUE(T, ST) do { const int _ps = (T) >> 3, _kt = (T) & 7, _st = (ST); \
        __builtin_amdgcn_global_load_lds((const unsigned*)(asrc + _kt * 128), (PG8_LAS unsigned*)(L + _st * GSTAGE + wid * 1024), 16, 0, 0); \
        _Pragma("unroll") for (int _j = 0; _j < 4; ++_j) __builtin_amdgcn_global_load_lds((const unsigned*)(bsrc + (size_t)(32 * _ps + 8 * _j) * DM + _kt * 128), \
            (PG8_LAS unsigned*)(L + _st * GSTAGE + GA + (4 * wid + _j) * 1024), 16, 0, 0); } while (0)
            __syncthreads();
            P4_ISSUE(0, 0); P4_ISSUE(1, 1);
            int st_c = 0, st_n = 2;
            asm volatile("s_waitcnt vmcnt(5)" ::: "memory");
            __builtin_amdgcn_s_barrier(); asm volatile("" ::: "memory");
#pragma unroll
            for (int ps = 0; ps < 4; ++ps) {
#pragma unroll
                for (int m = 0; m < 4; ++m)
#pragma unroll
                    for (int n = 0; n < 2; ++n) acc[m][2 * ps + n] = (f32x4){0.f, 0.f, 0.f, 0.f};
#pragma unroll 1
                for (int kt = 0; kt < 8; ++kt) {
                    const int T = ps * 8 + kt;
                    if (T + 2 < 32) P4_ISSUE(T + 2, st_n);
                    const PG8_LAS unsigned char* cur = L + st_c * GSTAGE;
                    st_c = st_c == 2 ? 0 : st_c + 1; st_n = st_n == 2 ? 0 : st_n + 1;
                    {
                        bf16x8 af[4][2], bfr[2][2];
#pragma unroll
                        for (int m = 0; m < 4; ++m) { af[m][0] = *(const PG8_LAS bf16x8*)(cur + rA + m * 2048 + c0_); af[m][1] = *(const PG8_LAS bf16x8*)(cur + rA + m * 2048 + c1_); }
#pragma unroll
                        for (int n = 0; n < 2; ++n) { bfr[n][0] = *(const PG8_LAS bf16x8*)(cur + rB + n * 2048 + c0_); bfr[n][1] = *(const PG8_LAS bf16x8*)(cur + rB + n * 2048 + c1_); }
                        asm volatile("s_waitcnt lgkmcnt(0)" ::: "memory");
#pragma unroll
                        for (int m = 0; m < 4; ++m)
#pragma unroll
                            for (int n = 0; n < 2; ++n) { const pg8::i32x8_t _b8 = pg8::cat8(bfr[n][0], bfr[n][1]), _a8 = pg8::cat8(af[m][0], af[m][1]);
                                asm volatile("v_mfma_f32_16x16x128_f8f6f4 %0, %1, %2, %0" : "+v"(acc[m][2 * ps + n]) : "v"(_b8), "v"(_a8)); }
                    }
                    if (T + 2 < 32) asm volatile("s_waitcnt vmcnt(5) lgkmcnt(0)" ::: "memory");
                    else            asm volatile("s_waitcnt vmcnt(0) lgkmcnt(0)" ::: "memory");
                    __builtin_amdgcn_s_barrier(); asm volatile("" ::: "memory");
                }
            }
#undef P4_ISSUE
            asm volatile("s_nop 15" ::: "memory");
            __syncthreads();
        }
        int li_ = li, q_ = q, lane_ = lane; asm volatile("" : "+v"(li_), "+v"(q_), "+v"(lane_));
        {
            PG8_LAS unsigned char* XL = (PG8_LAS unsigned char*)lds;
#define P4_XISSUE(mm) do { _Pragma("unroll") for (int _j = 0; _j < 8; ++_j) { const int _pc = 8 * wid + _j, _rr = _pc >> 2, _qd = _pc & 3; \
        __builtin_amdgcn_global_load_lds((const unsigned*)((const char*)(x + (size_t)(m0 + 16 * (mm) + _rr) * DM) + (64 * _qd + (lane_ ^ _rr)) * 16), \
            (PG8_LAS unsigned*)(XL + ((mm) & 1) * 65536 + _rr * 4096 + _qd * 1024), 16, 0, 0); } } while (0)
            P4_XISSUE(0); P4_XISSUE(1);
#pragma unroll
            for (int m = 0; m < 4; ++m) {
                if (m < 3) asm volatile("s_waitcnt vmcnt(8)" ::: "memory"); else asm volatile("s_waitcnt vmcnt(0)" ::: "memory");
                __builtin_amdgcn_s_barrier(); asm volatile("" ::: "memory");
                const PG8_LAS unsigned char* xb_ = XL + (m & 1) * 65536 + li_ * 4096;
                float s = 0.f;
#pragma unroll
                for (int pr = 0; pr < 4; ++pr) {
                    const int lc = 32 * wid + 8 * pr + 2 * q_;
                    const f32x4 x0 = *(const PG8_LAS f32x4*)(xb_ + ((lc ^ li_) << 4)), x1v = *(const PG8_LAS f32x4*)(xb_ + (((lc + 1) ^ li_) << 4));
                    acc[m][2 * pr] = x0 * ALPHA + acc[m][2 * pr] * O_DESCALE; acc[m][2 * pr + 1] = x1v * ALPHA + acc[m][2 * pr + 1] * O_DESCALE;
                    s += (acc[m][2 * pr][0] + acc[m][2 * pr][1]) + (acc[m][2 * pr][2] + acc[m][2 * pr][3]) + (acc[m][2 * pr + 1][0] + acc[m][2 * pr + 1][1]) + (acc[m][2 * pr + 1][2] + acc[m][2 * pr + 1][3]);
                }
                s += shx(s, 16, lane_); s += shx(s, 32, lane_);
                if (q_ == 0) red[wid * 64 + 16 * m + li_] = s;
                if (m < 2) {
                    asm volatile("s_waitcnt lgkmcnt(0)" ::: "memory");
                    __builtin_amdgcn_s_barrier(); asm volatile("" ::: "memory");
                    if (m == 0) P4_XISSUE(2); else P4_XISSUE(3);
                }
            }
#undef P4_XISSUE
        }
        __syncthreads();
        float mu[4], rstd[4];
#pragma unroll
        for (int m = 0; m < 4; ++m) {
            float s = 0.f;
#pragma unroll
            for (int w = 0; w < 8; ++w) s += red[w * 64 + 16 * m + li_];
            mu[m] = s * (1.0f / 1024.0f);
        }
        __syncthreads();
#pragma unroll
        for (int m = 0; m < 4; ++m) {
            float qv = 0.f;
#pragma unroll
            for (int n = 0; n < 8; ++n)
#pragma unroll
                for (int r = 0; r < 4; ++r) { const float d = acc[m][n][r] - mu[m]; qv += d * d; }
            qv += shx(qv, 16, lane_); qv += shx(qv, 32, lane_);
            if (q_ == 0) red[wid * 64 + 16 * m + li_] = qv;
        }
        __syncthreads();
#pragma unroll
        for (int m = 0; m < 4; ++m) {
            float s = 0.f;
#pragma unroll
            for (int w = 0; w < 8; ++w) s += red[w * 64 + 16 * m + li_];
            rstd[m] = rsqrtf(s * (1.0f / 1024.0f) + 1e-5f);
#pragma unroll
            for (int n = 0; n < 8; ++n) acc[m][n] = (acc[m][n] - mu[m]) * rstd[m];
        }
        __syncthreads();
        const u32x4* wfp = (const u32x4*)(ws + WS_WRF) + (size_t)wid * 2048 + (q_ * 16 + li_);
#pragma unroll
        for (int mh = 0; mh < 2; ++mh) {
            f32x4 lg[2][4];
#pragma unroll
            for (int m = 0; m < 2; ++m)
#pragma unroll
                for (int n = 0; n < 4; ++n) lg[m][n] = (f32x4){0.f, 0.f, 0.f, 0.f};
#pragma unroll
            for (int pr = 0; pr < 4; ++pr) {
                const int c0 = 128 * wid + 32 * pr + 8 * q_;
                const f32x4 ga = *(const f32x4*)(g1 + c0), gb = *(const f32x4*)(g1 + c0 + 4), ba = *(const f32x4*)(b1 + c0), bb = *(const f32x4*)(b1 + c0 + 4);
                bf16x8 wfh[4], wfl[4];
                const u32x4* wp = wfp + pr * 512; asm volatile("" : "+v"(wp));
#pragma unroll
                for (int nt = 0; nt < 4; ++nt) { wfh[nt] = __builtin_bit_cast(bf16x8, wp[nt * 128]); wfl[nt] = __builtin_bit_cast(bf16x8, wp[nt * 128 + 64]); }
#pragma unroll
                for (int m2 = 0; m2 < 2; ++m2) {
                    const int m = 2 * mh + m2;
                    float o[8];
#pragma unroll
                    for (int r = 0; r < 4; ++r) { o[r] = acc[m][2 * pr][r] * ga[r] + ba[r]; o[4 + r] = acc[m][2 * pr + 1][r] * gb[r] + bb[r]; }
                    u32x4 hi, lo;
                    hi.x = cvt_pk_bf16(o[0], o[1]); hi.y = cvt_pk_bf16(o[2], o[3]); hi.z = cvt_pk_bf16(o[4], o[5]); hi.w = cvt_pk_bf16(o[6], o[7]);
                    lo.x = cvt_pk_bf16(o[0] - bflo(hi.x), o[1] - bfhi(hi.x)); lo.y = cvt_pk_bf16(o[2] - bflo(hi.y), o[3] - bfhi(hi.y));
                    lo.z = cvt_pk_bf16(o[4] - bflo(hi.z), o[5] - bfhi(hi.z)); lo.w = cvt_pk_bf16(o[6] - bflo(hi.w), o[7] - bfhi(hi.w));
                    *(u32x4*)(x1b + (size_t)(m0 + 16 * m + li_) * DM + c0) = hi;
                    { u32x2 f8; f8.x = pk4_fp8(o[0] * X1_SCALE, o[1] * X1_SCALE, o[2] * X1_SCALE, o[3] * X1_SCALE); f8.y = pk4_fp8(o[4] * X1_SCALE, o[5] * X1_SCALE, o[6] * X1_SCALE, o[7] * X1_SCALE);
                      *(u32x2*)(ws + WS_X1F8 + (size_t)(m0 + 16 * m + li_) * DM + c0) = f8; }
                    const bf16x8 xh = __builtin_bit_cast(bf16x8, hi), xl = __builtin_bit_cast(bf16x8, lo);
#pragma unroll
                    for (int nt = 0; nt < 4; ++nt) {
                        lg[m2][nt] = MFMA16(wfl[nt], xh, lg[m2][nt]);
                        lg[m2][nt] = MFMA16(wfh[nt], xl, lg[m2][nt]);
                        lg[m2][nt] = MFMA16(wfh[nt], xh, lg[m2][nt]);
                    }
                }
            }
#pragma unroll
            for (int m2 = 0; m2 < 2; ++m2)
#pragma unroll
                for (int nt = 0; nt < 4; ++nt) *(f32x4*)(pl + (wid * 64 + 16 * (2 * mh + m2) + li_) * 64 + 16 * nt + 4 * q_) = lg[m2][nt];
        }
        if (wid == 0) lcnt[lane_] = 0u;
        __syncthreads();
        const float rbias = rb[lane_];
        unsigned selmask = 0u; unsigned lpos[8]; float lw[8]; int lrank[8];
#pragma unroll
        for (int k = 0; k < 8; ++k) {
            const int tk = wid * 8 + k;
            float logit = 0.f;
#pragma unroll
            for (int w = 0; w < 8; ++w) logit += pl[(w * 64 + tk) * 64 + lane_];
            const float score = 1.0f / (1.0f + expf(-logit));
            const float biased = score + rbias;
            float m1 = biased;
            m1 = fmaxf(m1, shx(m1, 1, lane_)); m1 = fmaxf(m1, shx(m1, 2, lane_)); m1 = fmaxf(m1, shx(m1, 4, lane_));
            const unsigned long long eqm = __ballot(biased == m1);
            const int g = lane_ >> 3;
            const unsigned gbits = (unsigned)((eqm >> (8 * g)) & 0xffull);
            const int first = __builtin_ctz(gbits);
            float m2 = ((lane_ & 7) == first) ? -3.0e38f : biased;
            m2 = fmaxf(m2, shx(m2, 1, lane_)); m2 = fmaxf(m2, shx(m2, 2, lane_)); m2 = fmaxf(m2, shx(m2, 4, lane_));
            const float gs = m1 + m2;
            const unsigned gsu = __float_as_uint(gs), gkey = ((gsu ^ ((gsu >> 31) ? 0xffffffffu : 0x80000000u)) & ~7u) | (unsigned)(7 - g);
            int grank = 0;
#pragma unroll
            for (int g2 = 0; g2 < 8; ++g2) grank += ((unsigned)__builtin_amdgcn_readlane((int)gkey, 8 * g2) > gkey) ? 1 : 0;
            const bool gsel = grank < 4;
            const unsigned bu = __float_as_uint(biased), vkey = gsel ? (((bu ^ ((bu >> 31) ? 0xffffffffu : 0x80000000u)) & ~63u) | (unsigned)(63 - lane_)) : 0u;
            int rank = 0;
            const unsigned long long gm = __ballot(gsel);
#pragma unroll
            for (int g2 = 0; g2 < 8; ++g2)
                if ((gm >> (8 * g2)) & 1ull) {
#pragma unroll
                    for (int i2 = 0; i2 < 8; ++i2) rank += ((unsigned)__builtin_amdgcn_readlane((int)vkey, 8 * g2 + i2) > vkey) ? 1 : 0;
                }
            const bool sel = gsel && rank < 8;
            const float wsum = wave_sum_l(sel ? score : 0.f, lane_);
            lw[k] = score / wsum * 2.5f; lrank[k] = rank; lpos[k] = 0u;
            if (sel) { selmask |= 1u << k; lpos[k] = atomicAdd(&lcnt[lane_], 1u); }
        }
        __syncthreads();
        if (wid == 0) lcnt[64 + lane_] = atomicAdd(&counts[lane_ * 64], lcnt[lane_]);
        __syncthreads();
        {
            const unsigned gbase = lcnt[64 + lane_];
#pragma unroll
            for (int k = 0; k < 8; ++k)
                if (selmask & (1u << k)) {
                    const unsigned pos = gbase + lpos[k];
                    ltok[(size_t)lane_ * T_TOK + pos] = m0 + wid * 8 + k;
                    float2 kw; kw.x = __int_as_float(lrank[k]); kw.y = lw[k];
                    lkw[(size_t)lane_ * T_TOK + pos] = kw;
                }
        }
    }
}

struct BlkTab { int start[65]; int total; };
__device__ __forceinline__ void build_blktab(const unsigned* counts, int* tab  , const int wv_) {
    if (WV == 0) {
        const int lane = lane_id();
        const int nb = ((int)counts[lane * 64] + 255) >> 8;
        int incl = nb;
#pragma unroll
        for (int o = 1; o < 64; o <<= 1) { const int v = __shfl_up(incl, o); if (lane >= o) incl += v; }
        tab[lane] = incl - nb;
        if (lane == 63) tab[64] = incl;
    }
    __syncthreads();
}
__device__ __forceinline__ int find_expert(const int* tab, int blk) {
    int e = 0;
#pragma unroll 1
    for (int s = 32; s >= 1; s >>= 1) if (e + s < 64 && tab[e + s] <= blk) e += s;
    return e;
}

constexpr int P6_TAB_OFF = pg8::STAGE_BYTES;
constexpr int P6_UT_OFF = P6_TAB_OFF + 512;
__device__ __forceinline__ int unit_index(int i) { const int G_ = gridDim.x, c_ = blockIdx.x; return i * G_ + ((G_ & 7) == 0 ? (c_ & 7) * (G_ >> 3) + (c_ >> 3) : c_); }
struct Sched6a {
    static constexpr bool VARK = false;
    unsigned char* ws; const int* ut;
    __device__ static void build(const unsigned char* ws, const int* tab, int* ut, const int wv_) {
        if (WV == 0) {
            const int i = lane_id();
            if (i < 16) {
                const int nbr = tab[64], L = unit_index(i), n_r = 2 * nbr, n_s = 2 * NBLK_S;
                int e = -1, pm = 0, pn = 0, bin = 0, cnt = 0;
                if (L < n_r + n_s) {
                    const int blk = L >> 1; pn = L & 1;
                    if (L < n_r) { e = find_expert(tab, blk); bin = blk - tab[e]; cnt = (int)((const unsigned*)(ws + WS_CTRL))[e * 64]; pm = blk; }
                    else { e = 64; bin = blk - nbr; cnt = T_TOK; pm = MAXBLK_R + bin; }
                } else { const int x = L - n_r - n_s; if (x < 256) { e = 65; pm = x >> 2; pn = x & 3; bin = x >> 2; cnt = T_TOK; } }
                int* d = ut + 8 * i; d[0] = e; d[1] = pm; d[2] = pn; d[3] = bin; d[4] = cnt;
            }
        }
        __syncthreads();
    }
    __device__ bool next(int i, pg8::Unit& u) const {
        const pg8::i32x4_t a = *(const pg8::i32x4_t*)(ut + 8 * i); const int cnt = ut[8 * i + 4];
        const int e = rfl(a.x);
        if (e < 0) return false;
        u.pm = rfl(a.y); u.pn = rfl(a.z); u.x0 = e; u.x1 = rfl(a.w); u.x2 = rfl(cnt); u.x3 = 0;
        u.A = (const char*)(ws + WS_X1F8);
        u.B = e == 65 ? (const char*)(ws + WS_WGATE) + (size_t)(u.pn * 256) * DM : (const char*)(ws + WS_WGUT) + ((size_t)e * 512 + 256 * u.pn) * DM;
        return true;
    }
    __device__ int arow(const pg8::Unit& u, int r) const {
        const int pos = u.x1 * 256 + r;
        if (u.x0 >= 64) return pos;
        return pos < u.x2 ? ((const int*)(ws + WS_LTOK))[(size_t)u.x0 * T_TOK + pos] : 0;
    }
    __device__ int arow_lds(const pg8::Unit& u, int r, const PG8_LAS unsigned char* meta) const {
        const int pos = u.x1 * 256 + r;
        if (u.x0 >= 64) return pos;
        return pos < u.x2 ? ((const PG8_LAS int*)(meta + 2048))[r] : 0;
    }
};
struct Epi6a {
    static constexpr bool PERM = false; static constexpr int NMETA = 3;
    unsigned char* ws;
    __device__ const char* meta_src(const pg8::Unit& u, int i) const {
        const size_t base = (size_t)(u.x0 & 63) * T_TOK + (size_t)u.x1 * 256;
        return i < 2 ? (const char*)(ws + WS_LKW) + base * 8 + i * 1024 : (const char*)(ws + WS_LTOK) + base * 4;
    }
    __device__ __forceinline__ void operator()(const f32x4 (&acc)[2][2][4][2], const pg8::Unit& u, int wr, int wc, int fr_, int fq_, const PG8_LAS unsigned char* meta) const {
        int fr = fr_, fq = fq_; asm volatile("" : "+v"(fr), "+v"(fq));
        if (u.x0 == 65) {
            const unsigned char* proj = ws + WS_PLE; unsigned char* ple8 = ws + WS_PLE8;
#pragma unroll
            for (int ai = 0; ai < 2; ++ai)
#pragma unroll
                for (int m = 0; m < 4; ++m) {
                    const size_t t = u.pm * 256 + 128 * ai + 64 * wr + 16 * m + fr;
                    const int c0 = u.pn * 256 + 64 * wc + 16 * fq;
                    const u32x4 p0 = *(const u32x4*)(proj + t * DM + c0);
                    const unsigned pj[4] = {p0.x, p0.y, p0.z, p0.w};
                    typedef float f32x2v __attribute__((ext_vector_type(2)));
                    unsigned o[4];
#pragma unroll
                    for (int bj = 0; bj < 2; ++bj)
#pragma unroll
                        for (int n = 0; n < 2; ++n) {
                            const f32x4 a = acc[ai][bj][m][n] * GU_DESCALE;
                            const f32x2v ql = __builtin_amdgcn_cvt_pk_f32_fp8((int)pj[2 * bj + n], false), qh = __builtin_amdgcn_cvt_pk_f32_fp8((int)pj[2 * bj + n], true);
                            o[2 * bj + n] = pk4_fp8(sigmoidf_(a[0]) * ql[0], sigmoidf_(a[1]) * ql[1], sigmoidf_(a[2]) * qh[0], sigmoidf_(a[3]) * qh[1]);
                        }
                    u32x4 w; w.x = o[0]; w.y = o[1]; w.z = o[2]; w.w = o[3];
                    *(u32x4*)(ple8 + t * DM + c0) = w;
                    asm volatile("" ::: "memory");
                }
        } else {
            unsigned char* Hb = ws + WS_HBUF;
#pragma unroll
            for (int ai = 0; ai < 2; ++ai)
#pragma unroll
                for (int m = 0; m < 4; ++m) {
                    const int row = 128 * ai + 64 * wr + 16 * m + fr, pos = u.x1 * 256 + row;
                    float w = 1.0f;
                    if (u.x0 < 64) w = pos < u.x2 ? ((const PG8_LAS float*)meta)[2 * row + 1] : 0.f;
                    unsigned char* dst = Hb + ((size_t)u.pm * 256 + row) * EDIM + 128 * u.pn + 32 * wc + 8 * fq;
                    u32x2 wv; w *= H_SCALE * GU_DESCALE;
                    {
                        const f32x4 g = acc[ai][0][m][0] * GU_DESCALE, uu = acc[ai][1][m][0];
                        wv.x = pk4_fp8(siluf_(g[0]) * uu[0] * w, siluf_(g[1]) * uu[1] * w, siluf_(g[2]) * uu[2] * w, siluf_(g[3]) * uu[3] * w);
                    }
                    {
                        const f32x4 g = acc[ai][0][m][1] * GU_DESCALE, uu = acc[ai][1][m][1];
                        wv.y = pk4_fp8(siluf_(g[0]) * uu[0] * w, siluf_(g[1]) * uu[1] * w, siluf_(g[2]) * uu[2] * w, siluf_(g[3]) * uu[3] * w);
                    }
                    *(u32x2*)dst = wv;
                    asm volatile("" ::: "memory");
                }
        }
    }
};
__device__ void phase6a(const Params& p, unsigned char* lds, const int wv_) {
    int* tab = (int*)(lds + P6_TAB_OFF);
    build_blktab((const unsigned*)(p.ws + WS_CTRL), tab, wv_);
    int* ut = (int*)(lds + P6_UT_OFF);
    Sched6a::build(p.ws, tab, ut, wv_);
    Sched6a S; S.ws = p.ws; S.ut = ut;
    Epi6a E; E.ws = p.ws;
    pg8::gemm_phase<Epi6a, Sched6a, true, true, true, true>((PG8_LAS unsigned char*)lds, DM / 2, S, E, wv_);
}

struct Sched6b {
    static constexpr bool VARK = false;
    unsigned char* ws; const int* ut;
    __device__ static void build(const unsigned char* ws, const int* tab, int* ut, const int wv_) {
        if (WV == 0) {
            const int i = lane_id();
            if (i < 16) {
                const int nbr = tab[64], L = unit_index(i), n_r = 4 * nbr, n_s = 4 * NBLK_S;
                int e = -1, hblk = 0, pn = 0, bin = 0, cnt = 0;
                if (L < n_r + n_s) {
                    const int blk = L >> 2; pn = L & 3;
                    if (L < n_r) { e = find_expert(tab, blk); bin = blk - tab[e]; cnt = (int)((const unsigned*)(ws + WS_CTRL))[e * 64]; hblk = blk; }
                    else { e = 64; bin = blk - nbr; cnt = T_TOK; hblk = MAXBLK_R + bin; }
                }
                int* d = ut + 8 * i; d[0] = e; d[1] = hblk; d[2] = pn; d[3] = bin; d[4] = cnt;
            }
        }
        __syncthreads();
    }
    __device__ bool next(int i, pg8::Unit& u) const {
        const pg8::i32x4_t a = *(const pg8::i32x4_t*)(ut + 8 * i); const int cnt = ut[8 * i + 4];
        const int e = rfl(a.x);
        if (e < 0) return false;
        u.pm = rfl(a.y); u.pn = rfl(a.z); u.x0 = e; u.x1 = rfl(a.w); u.x2 = rfl(cnt); u.x3 = 0;
        u.A = (const char*)(ws + WS_HBUF) + (size_t)u.pm * 256 * EDIM; u.B = (const char*)(ws + WS_WDT) + ((size_t)e * 1024 + 256 * u.pn) * EDIM;
        return true;
    }
    __device__ int arow(const pg8::Unit&, int r) const { return r; }
};
struct Epi6b {
    static constexpr bool PERM = false;
    static constexpr int NMETA = 3;
    unsigned char* ws;
    __device__ const char* meta_src(const pg8::Unit& u, int i) const {
        const size_t base = (size_t)(u.x0 & 63) * T_TOK + (size_t)u.x1 * 256;
        return i < 2 ? (const char*)(ws + WS_LKW) + base * 8 + i * 1024 : (const char*)(ws + WS_LTOK) + base * 4;
    }
    __device__ __forceinline__ void operator()(const f32x4 (&acc)[2][2][4][2], const pg8::Unit& u, int wr, int wc, int fr_, int fq_, const PG8_LAS unsigned char* meta) const {
        int fr = fr_, fq = fq_; asm volatile("" : "+v"(fr), "+v"(fq));
        unsigned char* part = ws + WS_PART; unsigned char* sho = ws + WS_SHO;
#pragma unroll
        for (int ai = 0; ai < 2; ++ai)
#pragma unroll
            for (int m = 0; m < 4; ++m) {
                const int row = 128 * ai + 64 * wr + 16 * m + fr, pos = u.x1 * 256 + row;
                const int c0 = u.pn * 256 + 64 * wc + 16 * fq;
                if (u.x0 == 64) {
                    u32x4 w; unsigned wq[4];
#pragma unroll
                    for (int bj = 0; bj < 2; ++bj)
#pragma unroll
                        for (int n = 0; n < 2; ++n) {
                            const f32x4 a = acc[ai][bj][m][n] * (PART_SCALE * D_DESCALE);
                            unsigned x = (unsigned)__builtin_amdgcn_cvt_pk_fp8_f32(a[0], a[1], 0, false); x = (unsigned)__builtin_amdgcn_cvt_pk_fp8_f32(a[2], a[3], (int)x, true);
                            wq[2 * bj + n] = x;
                        }
                    w.x = wq[0]; w.y = wq[1]; w.z = wq[2]; w.w = wq[3];
                    *(u32x4*)(sho + (size_t)pos * DM + c0) = w;
                } else if (pos < u.x2) {
                    const int d = ((const PG8_LAS int*)(meta + 2048))[row] * 8 + ((const PG8_LAS int*)meta)[2 * row];
                    u32x4 w; unsigned wq[4];
#pragma unroll
                    for (int bj = 0; bj < 2; ++bj)
#pragma unroll
                        for (int n = 0; n < 2; ++n) {
                            const f32x4 a = acc[ai][bj][m][n] * (PART_SCALE * D_DESCALE);
                            unsigned x = (unsigned)__builtin_amdgcn_cvt_pk_fp8_f32(a[0], a[1], 0, false); x = (unsigned)__builtin_amdgcn_cvt_pk_fp8_f32(a[2], a[3], (int)x, true);
                            wq[2 * bj + n] = x;
                        }
                    w.x = wq[0]; w.y = wq[1]; w.z = wq[2]; w.w = wq[3];
                    *(u32x4*)(part + (size_t)d * DM + c0) = w;
                }
            }
    }
};
__device__ void phase6b(const Params& p, unsigned char* lds, const int wv_) {
    int* tab = (int*)(lds + P6_TAB_OFF);
    build_blktab((const unsigned*)(p.ws + WS_CTRL), tab, wv_);
    int* ut = (int*)(lds + P6_UT_OFF);
    Sched6b::build(p.ws, tab, ut, wv_);
    Sched6b S; S.ws = p.ws; S.ut = ut;
    Epi6b E; E.ws = p.ws;
    int kk = EDIM / 2; asm volatile("" : "+s"(kk));
    pg8::gemm_phase<Epi6b, Sched6b, false, true, true, true>((PG8_LAS unsigned char*)lds, kk, S, E, wv_);
}

__device__ void phase7(const Params& p, unsigned char* lds, const int wv_) {
    unsigned char* ws = p.ws;
    const int lane = lane_id(), wid = WV;
    const bf16_t* x1b = (const bf16_t*)(ws + WS_X1B); const unsigned char* ple = ws + WS_PLE8; const unsigned char* sho = ws + WS_SHO;
    const unsigned char* part = ws + WS_PART;
    const float* g2 = p.in[18]; const float* b2 = p.in[19];
    typedef float f32x2v __attribute__((ext_vector_type(2)));
    float* rowL = (float*)(lds + wid * 4096);
    for (int t0 = (blockIdx.x * 8 + wid) * 2; t0 < T_TOK; t0 += gridDim.x * 16) {
        u32x4 xr[2][2]; u32x2 pr[2][2], ar[2][2][9];
#pragma unroll
        for (int tt = 0; tt < 2; ++tt)
#pragma unroll
            for (int hf = 0; hf < 2; ++hf) {
                const size_t t = t0 + tt; const int c0 = 512 * hf + 8 * lane;
                xr[tt][hf] = *(const u32x4*)(x1b + t * DM + c0); pr[tt][hf] = *(const u32x2*)(ple + t * DM + c0); ar[tt][hf][8] = *(const u32x2*)(sho + t * DM + c0);
#pragma unroll
                for (int k = 0; k < 8; ++k) ar[tt][hf][k] = *(const u32x2*)(part + (t * 8 + k) * DM + c0);
            }
#pragma unroll
        for (int tt = 0; tt < 2; ++tt) {
            const size_t t = t0 + tt;
            float v[16];
#pragma unroll
            for (int hf = 0; hf < 2; ++hf) {
                float rsum[8];
#pragma unroll
                for (int i = 0; i < 8; ++i) rsum[i] = 0.f;
#pragma unroll
                for (int k = 0; k < 9; ++k) {
                    const u32x2 a = ar[tt][hf][k];
                    const f32x2v l0 = __builtin_amdgcn_cvt_pk_f32_fp8((int)a.x, false), h0 = __builtin_amdgcn_cvt_pk_f32_fp8((int)a.x, true);
                    const f32x2v l1 = __builtin_amdgcn_cvt_pk_f32_fp8((int)a.y, false), h1 = __builtin_amdgcn_cvt_pk_f32_fp8((int)a.y, true);
                    rsum[0] += l0[0]; rsum[1] += l0[1]; rsum[2] += h0[0]; rsum[3] += h0[1]; rsum[4] += l1[0]; rsum[5] += l1[1]; rsum[6] += h1[0]; rsum[7] += h1[1];
                }
                const u32x4 xv = xr[tt][hf]; const u32x2 pv = pr[tt][hf];
                const unsigned xw[4] = {xv.x, xv.y, xv.z, xv.w};
                const f32x2v pl0 = __builtin_amdgcn_cvt_pk_f32_fp8((int)pv.x, false), ph0 = __builtin_amdgcn_cvt_pk_f32_fp8((int)pv.x, true);
                const f32x2v pl1 = __builtin_amdgcn_cvt_pk_f32_fp8((int)pv.y, false), ph1 = __builtin_amdgcn_cvt_pk_f32_fp8((int)pv.y, true);
                const float pf[8] = {pl0[0], pl0[1], ph0[0], ph0[1], pl1[0], pl1[1], ph1[0], ph1[1]};
#pragma unroll
                for (int j = 0; j < 4; ++j) {
                    v[8 * hf + 2 * j]     = ALPHA * bflo(xw[j]) + pf[2 * j] * (1.0f / PLE_SCALE) + rsum[2 * j] * (1.0f / PART_SCALE);
                    v[8 * hf + 2 * j + 1] = ALPHA * bfhi(xw[j]) + pf[2 * j + 1] * (1.0f / PLE_SCALE) + rsum[2 * j + 1] * (1.0f / PART_SCALE);
                }
            }
            float s = 0.f;
#pragma unroll
            for (int i = 0; i < 16; ++i) s += v[i];
            const float mu = wave_sum(s) * (1.0f / 1024.0f);
            float qv = 0.f;
#pragma unroll
            for (int i = 0; i < 16; ++i) { const float d = v[i] - mu; qv += d * d; }
            const float rstd = rsqrtf(wave_sum(qv) * (1.0f / 1024.0f) + 1e-5f);
#pragma unroll
            for (int hf = 0; hf < 2; ++hf)
#pragma unroll
                for (int j = 0; j < 2; ++j) {
                    f32x4 o;
#pragma unroll
                    for (int r = 0; r < 4; ++r) o[r] = (v[8 * hf + 4 * j + r] - mu) * rstd;
                    *(f32x4*)(rowL + 512 * hf + 8 * lane + 4 * j) = o;
                }
#pragma unroll
            for (int i = 0; i < 4; ++i) {
                const int c = 256 * i + 4 * lane;
                const f32x4 y = *(const f32x4*)(rowL + c), gg = *(const f32x4*)(g2 + c), bb = *(const f32x4*)(b2 + c);
                *(f32x4*)(p.out + t * DM + c) = y * gg + bb;
            }
        }
    }
}

#define XB_TMO      128
#define XB_XCNT(j)  (256  + 64 * (j))
#define XB_XSUB(j)  (1280 + 64 * (j))
#define XB_XGEN(j)  (2304 + 64 * (j))
#define XB_TOP      3328
#define XB_TOPGEN   3392
#define XCD_BAR_WORDS 3456
#define XB_SPIN_CAP (1u << 18)
#define LAS __attribute__((address_space(3)))
__device__ __forceinline__ unsigned xb_ld(unsigned* p)              { return __hip_atomic_load(p, __ATOMIC_RELAXED, __HIP_MEMORY_SCOPE_AGENT); }
__device__ __forceinline__ unsigned xb_add(unsigned* p, unsigned v) { return __hip_atomic_fetch_add(p, v, __ATOMIC_RELAXED, __HIP_MEMORY_SCOPE_AGENT); }
__device__ __forceinline__ unsigned xb_xcc_id() { return (unsigned)__builtin_amdgcn_s_getreg((3 << 11) | 20) & 0xFu; }
#define XB_SPIN(cond, bar) do { unsigned _sp = 0; while (cond) { __builtin_amdgcn_s_sleep(1); \
    if ((++_sp & 255u) == 0u) { if (xb_ld(&(bar)[XB_TMO])) break; if (_sp > XB_SPIN_CAP) { atomicAdd(&(bar)[XB_TMO], 1u); break; } } } } while (0)
struct XcdBarrier { unsigned* bar; unsigned x; volatile LAS unsigned* st; };
__device__ __forceinline__ XcdBarrier xcd_barrier_post(unsigned* bar, volatile LAS unsigned* st, const int wv_) {
    XcdBarrier b; b.bar = bar; b.x = xb_xcc_id(); b.st = st;
    if (WV == 0 && lane_id() == 0) (void)xb_add(&bar[XB_XCNT(b.x)], 1u);
    return b;
}
__device__ __forceinline__ void xcd_barrier_complete(unsigned* bar, unsigned x, unsigned& nloc, unsigned& nx) {
    const unsigned G = gridDim.x * gridDim.y * gridDim.z;
    unsigned sum, cnt, mine, sp = 0u;
    for (;;) {
        sum = 0u; cnt = 0u; mine = 0u;
#pragma unroll
        for (unsigned j = 0; j < 16; ++j) { const unsigned c = xb_ld(&bar[XB_XCNT(j)]); sum += c; cnt += (c > 0u) ? 1u : 0u; mine = (j == x) ? c : mine; }
        if (sum == G) break;
        __builtin_amdgcn_s_sleep(1);
        if ((++sp & 255u) == 0u) { if (xb_ld(&bar[XB_TMO])) break; if (sp > XB_SPIN_CAP) { atomicAdd(&bar[XB_TMO], 1u); break; } }
    }
    nloc = mine > 0u ? mine : 1u; nx = cnt > 0u ? cnt : 1u;
}
__device__ __forceinline__ void xcd_barrier(const XcdBarrier& b, const int wv_) {
    asm volatile("s_waitcnt vmcnt(0)" ::: "memory");
    __syncthreads();
    if (WV == 0 && lane_id() == 0) {
        unsigned* bar = b.bar;
        __builtin_amdgcn_s_waitcnt(0);
        unsigned nloc = b.st[0], nx = b.st[1];
        if (nloc == 0u) { xcd_barrier_complete(bar, b.x, nloc, nx); b.st[0] = nloc; b.st[1] = nx; }
        const unsigned old = xb_add(&bar[XB_XSUB(b.x)], 1u);
        const unsigned gen = old / nloc;
        if (old + 1u == (gen + 1u) * nloc) {
            __builtin_amdgcn_fence(__ATOMIC_RELEASE, "agent");
            asm volatile("s_waitcnt vmcnt(0)" ::: "memory");
            const unsigned og = xb_add(&bar[XB_TOP], 1u);
            const unsigned tg = og / nx;
            if (og + 1u == (tg + 1u) * nx) xb_add(&bar[XB_TOPGEN], 1u);
            else XB_SPIN(xb_ld(&bar[XB_TOPGEN]) == tg, bar);
            __builtin_amdgcn_fence(__ATOMIC_ACQUIRE, "agent");
            xb_add(&bar[XB_XGEN(b.x)], 1u);
            asm volatile("s_waitcnt vmcnt(0)" ::: "memory");
        } else {
            XB_SPIN(xb_ld(&bar[XB_XGEN(b.x)]) == gen, bar);
            __builtin_amdgcn_fence(__ATOMIC_ACQUIRE, "agent");
            asm volatile("s_waitcnt vmcnt(0)" ::: "memory");
        }
    }
    __syncthreads();
}

constexpr int LDS_TOTAL = 152 * 1024;
constexpr int NPHASE = 8;

constexpr size_t CTRL_BAR_OFF = 65536;
constexpr size_t CTRL_ZERO_BYTES = 131072;

__global__ void __launch_bounds__(NTHREADS) mega_kernel(Params p) {
    extern __shared__ __attribute__((aligned(16))) unsigned char smem[];
    const int wv_ = __builtin_amdgcn_readfirstlane((int)(threadIdx.x >> 6));
    volatile LAS unsigned* bst = (volatile LAS unsigned*)(smem + LDS_TOTAL - 16);
    XcdBarrier xb;
    if (p.sync) {
        if (WV == 0 && lane_id() == 0) { bst[0] = 0u; bst[1] = 0u; }
        __syncthreads();
        xb = xcd_barrier_post((unsigned*)(p.ws + WS_CTRL + CTRL_BAR_OFF), bst, wv_);
    }
#define RUN_PHASE(i, call) if (p.ph_lo <= (i) && (i) < p.ph_hi) { call; if (p.sync && (i) + 1 < p.ph_hi) { xcd_barrier(xb, wv_); } }
    RUN_PHASE(0, phase0(p, smem, wv_))
    RUN_PHASE(1, phase1(p, smem, wv_))
    RUN_PHASE(2, phase2(p, smem, wv_))
    RUN_PHASE(3, phase3(p, smem, wv_))
    RUN_PHASE(4, phase4(p, smem, wv_))
    RUN_PHASE(5, phase6a(p, smem, wv_))
    RUN_PHASE(6, phase6b(p, smem, wv_))
    RUN_PHASE(7, phase7(p, smem, wv_))
#undef RUN_PHASE
}

extern "C" void kernel_launch(void* const* d_in, const int* in_sizes, int n_in, void* d_out, int out_size, void* d_ws, size_t ws_size, hipStream_t stream) {
    static int grid_blocks = 0;
    if (grid_blocks == 0) {
        if (n_in != 20 || ws_size < WS_END) { fprintf(stderr, "kernel_launch: unexpected n_in %d / ws_size %zu (need %zu)\n", n_in, ws_size, (size_t)WS_END); grid_blocks = -1; return; }
        int dev = 0, cus = 0, per_cu = 0;
        hipGetDevice(&dev);
        hipDeviceGetAttribute(&cus, hipDeviceAttributeMultiprocessorCount, dev);
        if (hipFuncSetAttribute((const void*)mega_kernel, hipFuncAttributeMaxDynamicSharedMemorySize, LDS_TOTAL) != hipSuccess) { fprintf(stderr, "kernel_launch: hipFuncSetAttribute failed\n"); grid_blocks = -1; return; }
        if (hipOccupancyMaxActiveBlocksPerMultiprocessor(&per_cu, (const void*)mega_kernel, NTHREADS, LDS_TOTAL) != hipSuccess || per_cu < 1) { fprintf(stderr, "kernel_launch: occupancy query failed (%d)\n", per_cu); per_cu = 1; }
        (void)hipGetLastError();
        if (per_cu > 1) per_cu = 1;
        grid_blocks = cus * per_cu;
    }
    if (grid_blocks < 0) return;
    (void)hipMemsetAsync((char*)d_ws + WS_CTRL, 0, CTRL_ZERO_BYTES, stream);
    Params p{};
    for (int i = 0; i < 20; ++i) p.in[i] = (const float*)d_in[i];
    p.out = (float*)d_out; p.ws = (unsigned char*)d_ws;
#if MK_SINGLE
    p.ph_lo = 0; p.ph_hi = NPHASE; p.sync = 1;
    void* args[] = {&p};
    hipError_t e = hipLaunchCooperativeKernel((const void*)mega_kernel, dim3(grid_blocks), dim3(NTHREADS), args, LDS_TOTAL, stream);
    if (e != hipSuccess) fprintf(stderr, "cooperative launch failed: %s (grid %d)\n", hipGetErrorString(e), grid_blocks);
#else
    for (int ph = 0; ph < NPHASE; ++ph) {
        p.ph_lo = ph; p.ph_hi = ph + 1; p.sync = 0;
        hipLaunchKernelGGL(mega_kernel, dim3(grid_blocks), dim3(NTHREADS), LDS_TOTAL, stream, p);
#ifdef PROBE_REPEAT
        if (ph == PROBE_REPEAT) {
            for (int rep = 0; rep < 2; ++rep) {
                if (ph == 4 || ph == 2) (void)hipMemsetAsync((char*)d_ws + WS_CTRL, 0, 16384, stream);
                hipLaunchKernelGGL(mega_kernel, dim3(grid_blocks), dim3(NTHREADS), LDS_TOTAL, stream, p);
            }
        }
#endif
    }
#endif
}
```

```cpp
#include <hip/hip_runtime.h>
#include <hip/hip_cooperative_groups.h>
#include <cstdio>
#include <cstdint>
#include <cmath>
namespace cg = cooperative_groups;

#ifndef MK_SINGLE
#define MK_SINGLE 1
#endif

typedef unsigned short bf16_t;
typedef short bf16x8 __attribute__((ext_vector_type(8)));
typedef short bf16x4 __attribute__((ext_vector_type(4)));
typedef float f32x4 __attribute__((ext_vector_type(4)));
typedef unsigned u32x4 __attribute__((ext_vector_type(4)));
typedef unsigned u32x2 __attribute__((ext_vector_type(2)));

constexpr int T_TOK = 16384, DM = 1024, SEQ = 4096, NB_ = 4, PLE = 256;
constexpr int NPROJ = 3584, NEXP = 64, EDIM = 256, TOPK = 8;
constexpr int NTHREADS = 512;
constexpr float ALPHA = 1.189207115002721f;
constexpr float LOG2E = 1.4426950408889634f;
constexpr float PART_SCALE = 8.0f;
constexpr float WGU_SCALE = 32.0f, X1_SCALE = 4.0f, GU_DESCALE = 1.0f / (32.0f * 4.0f);
constexpr float H_SCALE = 8.0f, WD_SCALE = 32.0f, D_DESCALE = 1.0f / (8.0f * 32.0f);
constexpr float MIX_SCALE = 16.0f, WO_SCALE = 64.0f, O_DESCALE = 1.0f / (16.0f * 64.0f);
constexpr float PLE_SCALE = 16.0f;
constexpr float X8_SCALE = 8.0f, WIN8_SCALE = 32.0f, NA_DESCALE = 1.0f / (8.0f * 32.0f);
constexpr float P8_SCALE = 8.0f, WP8_SCALE = 32.0f, PLEP_DESCALE = 1.0f / (8.0f * 32.0f);
constexpr int MAXBLK_R = 576;
constexpr int NBLK_S = 64;

constexpr size_t MiB = 1024ull * 1024ull;
constexpr size_t WS_WDT   = 0;
constexpr size_t WS_CTRL  = 33 * MiB;
constexpr size_t WS_WRF   = 33 * MiB + 262144;
constexpr size_t WS_LGT   = 33 * MiB + 61440;
constexpr size_t WS_LTOK  = 34 * MiB;
constexpr size_t WS_LKW   = 38 * MiB;
constexpr size_t WS_ROPE  = 46 * MiB;
constexpr size_t WS_X1B   = 48 * MiB;
constexpr size_t WS_PLE   = 80 * MiB;
constexpr size_t WS_WPT   = 112 * MiB;
constexpr size_t WS_PB    = 113 * MiB;
constexpr size_t WS_HBUF  = 121 * MiB;
constexpr size_t WS_PART  = 201 * MiB;
constexpr size_t WS_SHO   = 329 * MiB;
constexpr size_t WS_PLE8  = 345 * MiB;
constexpr size_t WS_WGUT  = 201 * MiB;
constexpr size_t WS_WGATE = 266 * MiB;
constexpr size_t WS_WINT  = 268 * MiB;
constexpr size_t WS_WOUTT = 275 * MiB;
constexpr size_t WS_XB    = 277 * MiB;
constexpr size_t WS_X1F8  = 277 * MiB;
constexpr size_t WS_Q     = 309 * MiB;
constexpr size_t WS_K     = 325 * MiB;
constexpr size_t WS_KT    = 341 * MiB;
constexpr size_t WS_VT    = 357 * MiB;
constexpr size_t WS_G     = 373 * MiB;
constexpr size_t WS_NQ    = 389 * MiB;
constexpr size_t WS_NK    = 405 * MiB;
constexpr size_t WS_NVT   = 421 * MiB;
constexpr size_t WS_SST   = 437 * MiB;
constexpr size_t WS_MIX   = 469 * MiB;
constexpr size_t WS_X8    = 469 * MiB;
constexpr size_t WS_WIN8  = 485 * MiB;
constexpr size_t WS_END   = 501 * MiB;

__constant__ double INV_FREQ[32] = {1.0, 0.7498942093324559, 0.5623413251903491, 0.4216965034285822, 0.31622776601683794, 0.23713737056616552, 0.1778279410038923, 0.1333521432163324, 0.1, 0.07498942093324558, 0.05623413251903491, 0.042169650342858224, 0.03162277660168379, 0.023713737056616554, 0.01778279410038923, 0.01333521432163324, 0.01, 0.007498942093324558, 0.005623413251903491, 0.004216965034285823, 0.0031622776601683794, 0.0023713737056616554, 0.0017782794100389228, 0.001333521432163324, 0.001, 0.0007498942093324559, 0.0005623413251903491, 0.00042169650342858224, 0.00031622776601683794, 0.00023713737056616554, 0.00017782794100389227, 0.0001333521432163324};
struct Params {
    const float* in[20];
    float* out;
    unsigned char* ws;
    int ph_lo, ph_hi, sync, pad;
};

__device__ __forceinline__ unsigned cvt_pk_bf16(float lo, float hi) { unsigned r; asm volatile("v_cvt_pk_bf16_f32 %0, %1, %2" : "=v"(r) : "v"(lo), "v"(hi)); return r; }
__device__ __forceinline__ float bf2f(unsigned short v) { return __uint_as_float(((unsigned)v) << 16); }
__device__ __forceinline__ float bflo(unsigned v) { return __uint_as_float(v << 16); }
__device__ __forceinline__ float bfhi(unsigned v) { return __uint_as_float(v & 0xffff0000u); }
__device__ __forceinline__ unsigned short f2bf(float f) { return (unsigned short)(cvt_pk_bf16(f, 0.f) & 0xffffu); }
__device__ __forceinline__ float fast_exp2(float x) { return __builtin_amdgcn_exp2f(x); }
__device__ __forceinline__ float sigmoidf_(float x) { return __builtin_amdgcn_rcpf(1.0f + __expf(-x)); }
__device__ __forceinline__ float siluf_(float x) { return x * __builtin_amdgcn_rcpf(1.0f + __expf(-x)); }
__device__ __forceinline__ float wave_sum(float v) {
#pragma unroll
    for (int o = 32; o >= 1; o >>= 1) v += __shfl_xor(v, o);
    return v;
}
__device__ __forceinline__ int rfl(int v) { return __builtin_amdgcn_readfirstlane(v); }
__device__ __forceinline__ size_t rfl64(size_t v) { return ((size_t)(unsigned)__builtin_amdgcn_readfirstlane((int)(v >> 32)) << 32) | (size_t)(unsigned)__builtin_amdgcn_readfirstlane((int)(unsigned)v); }
#define WV wv_
__device__ __forceinline__ int lane_id() { return (int)__builtin_amdgcn_mbcnt_hi(~0u, __builtin_amdgcn_mbcnt_lo(~0u, 0u)); }
__device__ __forceinline__ float readlane_f(float v, int l) { return __uint_as_float((unsigned)__builtin_amdgcn_readlane((int)__float_as_uint(v), l)); }
__device__ __forceinline__ float shx(float v, int m, int lane_) { return __uint_as_float((unsigned)__builtin_amdgcn_ds_bpermute((lane_ ^ m) << 2, (int)__float_as_uint(v))); }
__device__ __forceinline__ float wave_sum_l(float v, int lane_) {
#pragma unroll
    for (int o = 32; o >= 1; o >>= 1) v += shx(v, o, lane_);
    return v;
}
#define MFMA16(a, b, c) __builtin_amdgcn_mfma_f32_16x16x32_bf16((a), (b), (c), 0, 0, 0)

namespace pg8 {
#define PG8_LAS __attribute__((address_space(3)))
constexpr int BM = 256, BK = 64, HALF = 128, HTB = HALF * BK * 2, STAGE_BYTES = 8 * HTB, NXCD = 8, WGM = 8;
constexpr int PG8_META_OFF = STAGE_BYTES + 2048;
__host__ __device__ __forceinline__ int lds_byte(int r, int c) { const int st = (r >> 4) * 2 + (c >> 5), rr = r & 15, cc = c & 31, ob = rr * 64 + cc * 2; return st * 1024 + (ob ^ (((ob >> 9) & 1) << 5)); }
__host__ __device__ __forceinline__ void stage_rc(int b, int& R, int& C) { const int st = b / 1024, sb = b % 1024, swz = sb ^ (((sb >> 9) & 1) << 5); R = (st >> 1) * 16 + swz / 64; C = (st & 1) * 32 + (swz % 64) / 2; }
__host__ __device__ __forceinline__ int perm32(int rho) { const int n = rho >> 4, i = rho & 15; return 8 * (i >> 2) + 4 * n + (i & 3); }

typedef int i32x4_t __attribute__((ext_vector_type(4)));
typedef int i32x8_t __attribute__((ext_vector_type(8)));
__device__ __forceinline__ i32x8_t cat8(const bf16x8& a, const bf16x8& b) { return __builtin_shufflevector(__builtin_bit_cast(i32x4_t, a), __builtin_bit_cast(i32x4_t, b), 0, 1, 2, 3, 4, 5, 6, 7); }
struct Unit { const char* A; const char* B; int pm, pn, x0, x1, x2, x3; };

struct TileOrder {
    int nM, nN, nwg;
    __device__ void init(int M, int N) { nM = M / BM; nN = N / BM; nwg = nM * nN; }
    __device__ bool map(long L, int& pm, int& pn) const {
        if (L >= nwg) return false;
        int wgid = (int)L; { const int q = nwg / NXCD, r = nwg % NXCD, xcd = wgid % NXCD, off = wgid / NXCD; wgid = (xcd < r ? xcd * (q + 1) : r * (q + 1) + (xcd - r) * q) + off; }
        const int nig = WGM * nN, gid = wgid / nig, fm = gid * WGM, gsz = (nM - fm) < WGM ? (nM - fm) : WGM;
        pm = fm + ((wgid % nig) % gsz); pn = (wgid % nig) / gsz; return true;
    }
};

template <class Epi, class Sched, bool GATHER, bool ALIGN_EPI, bool SP2, bool FP8 = false>
__device__ __forceinline__ void gemm_phase(PG8_LAS unsigned char* lds, const int K, const Sched& S, const Epi& E, const int wv_) {
    const int wid = WV, lane = lane_id(), tid = wid * 64 + lane, wr = wid >> 2, wc = wid & 3, fr = lane & 15, fq = lane >> 4;
    unsigned vA[2][2], vN[2][2], vB[2][2];
#pragma unroll
    for (int i = 0; i < 2; ++i) { int R, C; stage_rc(tid * 16 + i * 8192, R, C); const int Rb = Epi::PERM ? ((R & ~31) + perm32(R & 31)) : R;
#pragma unroll
        for (int h = 0; h < 2; ++h) { vA[h][i] = (unsigned)((R + 128 * h) * K + C) * 2u; vN[h][i] = vA[h][i]; vB[h][i] = (unsigned)((Rb + 128 * h) * K + C) * 2u; } }
    const size_t kstep = (size_t)(BK * 2);
    const unsigned ldsw = (unsigned)wid * 1024u;
    const int aoff = lds_byte(wr * 64 + fr, fq * 8), boff = lds_byte(wc * 32 + fr, fq * 8);
#define PG8_SA(b, h) (((b) * 2 + (h)) * HTB)
#define PG8_SB(b, h) ((4 + (b) * 2 + (h)) * HTB)
#define PG8_STAGE(bufoff, gbase, voff) do { _Pragma("unroll") for (int _i = 0; _i < 2; ++_i) \
        __builtin_amdgcn_global_load_lds((const unsigned*)((const char*)(gbase) + (voff)[_i]), (PG8_LAS unsigned*)(lds + (bufoff) + ldsw + _i * 8192), 16, 0, 0); } while (0)
#define PG8_LDA(dst, b, h) do { _Pragma("unroll") for (int m = 0; m < 4; ++m) _Pragma("unroll") for (int k = 0; k < 2; ++k) dst[m][k] = *(const PG8_LAS bf16x8*)(lds + PG8_SA(b, h) + aoff + m * 2048 + k * 1024); } while (0)
#define PG8_LDB(dst, b, h) do { _Pragma("unroll") for (int n = 0; n < 2; ++n) _Pragma("unroll") for (int k = 0; k < 2; ++k) dst[n][k] = *(const PG8_LAS bf16x8*)(lds + PG8_SB(b, h) + boff + n * 2048 + k * 1024); } while (0)
#define PG8_MMA(ai, bj, At, Bt) do { __builtin_amdgcn_s_setprio(1); _Pragma("unroll") for (int m = 0; m < 4; ++m) _Pragma("unroll") for (int n = 0; n < 2; ++n) { \
        if constexpr (FP8) { const i32x8_t _b8 = cat8(Bt[n][0], Bt[n][1]), _a8 = cat8(At[m][0], At[m][1]); asm volatile("v_mfma_f32_16x16x128_f8f6f4 %0, %1, %2, %0" : "+v"(acc[ai][bj][m][n]) : "v"(_b8), "v"(_a8)); } \
        else { _Pragma("unroll") for (int k = 0; k < 2; ++k) acc[ai][bj][m][n] = __builtin_amdgcn_mfma_f32_16x16x32_bf16(Bt[n][k], At[m][k], acc[ai][bj][m][n], 0, 0, 0); } } __builtin_amdgcn_s_setprio(0); } while (0)
#define PG8_WAIT_V(n) asm volatile("s_waitcnt vmcnt(" #n ")" ::: "memory")
#define PG8_WAIT_L(n) asm volatile("s_waitcnt lgkmcnt(" #n ")" ::: "memory")
#define PG8_BAR __builtin_amdgcn_s_barrier()
#define PG8_SCHED __builtin_amdgcn_sched_barrier(0)
#define PG8_ROWS(dst, unit) do { if constexpr (GATHER) { _Pragma("unroll") for (int _i = 0; _i < 2; ++_i) { int _R, _C; stage_rc(tid * 16 + _i * 8192, _R, _C); \
        _Pragma("unroll") for (int _h = 0; _h < 2; ++_h) dst[_h][_i] = (unsigned)(S.arow(unit, _R + 128 * _h) * K + _C) * 2u; } } } while (0)
    Unit cur, nxt; int ui = 0;
    if (!S.next(0, cur)) return;
    PG8_ROWS(vA, cur);
    if constexpr (Sched::VARK) { const int _K = cur.x3;
#pragma unroll
        for (int _i = 0; _i < 2; ++_i) { int _R, _C; stage_rc(tid * 16 + _i * 8192, _R, _C); const int _Rb = Epi::PERM ? ((_R & ~31) + perm32(_R & 31)) : _R;
#pragma unroll
            for (int _h = 0; _h < 2; ++_h) { vA[_h][_i] = (unsigned)((_R + 128 * _h) * _K + _C) * 2u; vB[_h][_i] = (unsigned)((_Rb + 128 * _h) * _K + _C) * 2u; } } }
#define PG8_META(unit, slot) do { if constexpr (Epi::NMETA > 0) { if (wid < Epi::NMETA) \
        __builtin_amdgcn_global_load_lds((const unsigned*)(E.meta_src(unit, wid) + lane * 16), (PG8_LAS unsigned*)(lds + PG8_META_OFF + (slot) * 4096 + wid * 1024), 16, 0, 0); } } while (0)
    PG8_META(cur, 0);
    f32x4 acc[2][2][4][2];
#pragma unroll
    for (int a = 0; a < 2; ++a)
#pragma unroll
        for (int b = 0; b < 2; ++b)
#pragma unroll
            for (int m = 0; m < 4; ++m)
#pragma unroll
                for (int n = 0; n < 2; ++n) acc[a][b][m][n] = (f32x4){0.f, 0.f, 0.f, 0.f};
    bf16x8 At[4][2], B0[2][2], B1[2][2];
    const char* cA = cur.A; const char* cB = cur.B;
    if constexpr (SP2) {
        PG8_STAGE(PG8_SB(0, 0), cB, vB[0]); PG8_STAGE(PG8_SB(0, 1), cB, vB[1]); PG8_STAGE(PG8_SA(0, 0), cA, vA[0]); PG8_STAGE(PG8_SA(0, 1), cA, vA[1]);
        if (wr == 1) PG8_BAR;
        PG8_WAIT_V(2); PG8_BAR;
        PG8_STAGE(PG8_SB(1, 0), cB + kstep, vB[0]); PG8_STAGE(PG8_SA(1, 0), cA + kstep, vA[0]); PG8_STAGE(PG8_SB(1, 1), cB + kstep, vB[1]);
        PG8_WAIT_V(6); PG8_BAR;
    } else {
        PG8_STAGE(PG8_SB(0, 0), cB, vB[0]); PG8_STAGE(PG8_SA(0, 0), cA, vA[0]); PG8_STAGE(PG8_SB(0, 1), cB, vB[1]); PG8_STAGE(PG8_SA(0, 1), cA, vA[1]);
        if (wr == 1) PG8_BAR;
        PG8_WAIT_V(4); PG8_BAR;
        PG8_STAGE(PG8_SB(1, 0), cB + kstep, vB[0]); PG8_STAGE(PG8_SA(1, 0), cA + kstep, vA[0]); PG8_STAGE(PG8_SB(1, 1), cB + kstep, vB[1]);
        PG8_WAIT_V(6); PG8_BAR;
    }
    for (;;) {
        const bool has_next = S.next(ui + 1, nxt);
        if (has_next) { PG8_META(nxt, (ui + 1) % 3); }
        const char* nA = has_next ? nxt.A : cA; const char* nB = has_next ? nxt.B : cB;
        const int nt = (Sched::VARK ? cur.x3 : K) / BK;
#pragma unroll 1
        for (int t = 0; t < nt; t += 2) {
            const bool last = (t == nt - 2);
            const char* a1 = cA + (size_t)(t + 1) * kstep;
            const char* a2 = last ? nA : cA + (size_t)(t + 2) * kstep; const char* b2 = last ? nB : cB + (size_t)(t + 2) * kstep;
            const char* a3 = a2 + kstep; const char* b3 = b2 + kstep;
            if constexpr (SP2) {
            PG8_LDB(B0, 0, 0); PG8_LDB(B1, 0, 1); PG8_SCHED; PG8_LDA(At, 0, 0); PG8_STAGE(PG8_SA(1, 1), a1, vA[1]);
            if constexpr (GATHER) { if (last && has_next) { const PG8_LAS unsigned char* _mt = (const PG8_LAS unsigned char*)(lds + PG8_META_OFF + ((ui + 1) % 3) * 4096); \
                _Pragma("unroll") for (int _i = 0; _i < 2; ++_i) { int _R, _C; stage_rc(tid * 16 + _i * 8192, _R, _C); \
                _Pragma("unroll") for (int _h = 0; _h < 2; ++_h) vA[_h][_i] = (unsigned)(S.arow_lds(nxt, _R + 128 * _h, _mt) * K + _C) * 2u; } } } \
            if constexpr (Sched::VARK) { if (last && has_next) { const int _K = nxt.x3; \
                _Pragma("unroll") for (int _i = 0; _i < 2; ++_i) { int _R, _C; stage_rc(tid * 16 + _i * 8192, _R, _C); const int _Rb = Epi::PERM ? ((_R & ~31) + perm32(_R & 31)) : _R; \
                _Pragma("unroll") for (int _h = 0; _h < 2; ++_h) { vA[_h][_i] = (unsigned)((_R + 128 * _h) * _K + _C) * 2u; vB[_h][_i] = (unsigned)((_Rb + 128 * _h) * _K + _C) * 2u; } } } }
            PG8_WAIT_V(8); PG8_WAIT_L(0); PG8_BAR; PG8_MMA(0, 0, At, B0); PG8_MMA(0, 1, At, B1); PG8_BAR; PG8_SCHED;
            PG8_LDA(At, 0, 1); PG8_STAGE(PG8_SB(0, 0), b2, vB[0]); PG8_STAGE(PG8_SB(0, 1), b2, vB[1]); PG8_STAGE(PG8_SA(0, 0), a2, vA[0]);
            PG8_WAIT_V(8); PG8_WAIT_L(0); PG8_BAR; PG8_MMA(1, 0, At, B0); PG8_MMA(1, 1, At, B1); PG8_BAR; PG8_SCHED;
            PG8_LDB(B0, 1, 0); PG8_LDB(B1, 1, 1); PG8_SCHED; PG8_LDA(At, 1, 0); PG8_STAGE(PG8_SA(0, 1), a2, vA[1]);
            PG8_WAIT_V(8); PG8_WAIT_L(0); PG8_BAR; PG8_MMA(0, 0, At, B0); PG8_MMA(0, 1, At, B1); PG8_BAR; PG8_SCHED;
            PG8_LDA(At, 1, 1); PG8_STAGE(PG8_SB(1, 0), b3, vB[0]); PG8_STAGE(PG8_SB(1, 1), b3, vB[1]); PG8_STAGE(PG8_SA(1, 0), a3, vA[0]);
            PG8_WAIT_V(8); PG8_WAIT_L(0); PG8_BAR; PG8_MMA(1, 0, At, B0); PG8_MMA(1, 1, At, B1); PG8_BAR; PG8_SCHED;
            } else {
            PG8_LDB(B0, 0, 0); PG8_SCHED; PG8_LDA(At, 0, 0); PG8_STAGE(PG8_SA(1, 1), a1, vA[1]);
            if constexpr (GATHER) { if (last && has_next) { const PG8_LAS unsigned char* _mt = (const PG8_LAS unsigned char*)(lds + PG8_META_OFF + ((ui + 1) % 3) * 4096); \
                _Pragma("unroll") for (int _i = 0; _i < 2; ++_i) { int _R, _C; stage_rc(tid * 16 + _i * 8192, _R, _C); \
                _Pragma("unroll") for (int _h = 0; _h < 2; ++_h) vA[_h][_i] = (unsigned)(S.arow_lds(nxt, _R + 128 * _h, _mt) * K + _C) * 2u; } } } \
            if constexpr (Sched::VARK) { if (last && has_next) { const int _K = nxt.x3; \
                _Pragma("unroll") for (int _i = 0; _i < 2; ++_i) { int _R, _C; stage_rc(tid * 16 + _i * 8192, _R, _C); const int _Rb = Epi::PERM ? ((_R & ~31) + perm32(_R & 31)) : _R; \
                _Pragma("unroll") for (int _h = 0; _h < 2; ++_h) { vA[_h][_i] = (unsigned)((_R + 128 * _h) * _K + _C) * 2u; vB[_h][_i] = (unsigned)((_Rb + 128 * _h) * _K + _C) * 2u; } } } }
            PG8_WAIT_L(8); PG8_BAR; PG8_WAIT_L(0); PG8_MMA(0, 0, At, B0); PG8_BAR; PG8_SCHED;
            PG8_LDB(B1, 0, 1); PG8_STAGE(PG8_SB(0, 0), b2, vB[0]);
            PG8_BAR; PG8_WAIT_L(0); PG8_MMA(0, 1, At, B1); PG8_BAR;
            PG8_LDA(At, 0, 1); PG8_STAGE(PG8_SA(0, 0), a2, vA[0]);
            PG8_BAR; PG8_WAIT_L(0); PG8_MMA(1, 0, At, B0); PG8_BAR; PG8_SCHED;
            PG8_STAGE(PG8_SB(0, 1), b2, vB[1]);
            PG8_WAIT_V(6); PG8_BAR; PG8_MMA(1, 1, At, B1); PG8_BAR;
            PG8_LDB(B0, 1, 0); PG8_SCHED; PG8_LDA(At, 1, 0); PG8_STAGE(PG8_SA(0, 1), a2, vA[1]);
            PG8_WAIT_L(8); PG8_BAR; PG8_WAIT_L(0); PG8_MMA(0, 0, At, B0); PG8_BAR; PG8_SCHED;
            PG8_LDB(B1, 1, 1); PG8_STAGE(PG8_SB(1, 0), b3, vB[0]);
            PG8_BAR; PG8_WAIT_L(0); PG8_MMA(0, 1, At, B1); PG8_BAR;
            PG8_LDA(At, 1, 1); PG8_STAGE(PG8_SA(1, 0), a3, vA[0]);
            PG8_BAR; PG8_WAIT_L(0); PG8_MMA(1, 0, At, B0); PG8_BAR; PG8_SCHED;
            PG8_STAGE(PG8_SB(1, 1), b3, vB[1]);
            PG8_WAIT_V(6); PG8_BAR; PG8_MMA(1, 1, At, B1); PG8_BAR;
            }
        }
        if constexpr (FP8) asm volatile("s_nop 15" ::: "memory");
        if constexpr (ALIGN_EPI) { if (wr == 0) PG8_BAR; }
        E(acc, cur, wr, wc, fr, fq, (const PG8_LAS unsigned char*)(lds + PG8_META_OFF + (ui % 3) * 4096));
        if (!has_next) break;
#pragma unroll
        for (int a = 0; a < 2; ++a)
#pragma unroll
            for (int b = 0; b < 2; ++b)
#pragma unroll
                for (int m = 0; m < 4; ++m)
#pragma unroll
                    for (int n = 0; n < 2; ++n) acc[a][b][m][n] = (f32x4){0.f, 0.f, 0.f, 0.f};
        cur = nxt; cA = nA; cB = nB; ++ui;
        if constexpr (ALIGN_EPI) { if (wr == 1) PG8_BAR; }
    }
    PG8_WAIT_V(0);
    if constexpr (!ALIGN_EPI) { if (wr == 0) PG8_BAR; }
    PG8_BAR;
#undef PG8_SA
#undef PG8_SB
#undef PG8_STAGE
#undef PG8_LDA
#undef PG8_LDB
#undef PG8_MMA
#undef PG8_WAIT_V
#undef PG8_WAIT_L
#undef PG8_BAR
#undef PG8_SCHED
#undef PG8_ROWS
#undef PG8_META
}
}

__device__ __forceinline__ int rowmap(int mode, int col) {
    if (mode == 1) {
        const int l = col & 255, hl = l >> 6, d = l & 63;
        return (col & ~255) + 128 * (hl >> 1) + 32 * (2 * (hl & 1) + ((d >> 4) & 1)) + 16 * (d >> 5) + (d & 15);
    } else if (mode == 2) {
        const int isU = col >> 8, j = col & 255, pn = j >> 7, jl = j & 127;
        return 256 * pn + 128 * isU + 32 * (jl >> 5) + 16 * ((jl >> 2) & 1) + 4 * ((jl >> 3) & 3) + (jl & 3);
    } else if (mode == 4) {
        const int l = col & 255, wc = l >> 6, fq = (l >> 4) & 3, bj = (l >> 3) & 1, n = (l >> 2) & 1, r = l & 3;
        return (col & ~255) + 128 * bj + 32 * wc + 16 * n + 4 * fq + r;
    } else if (mode == 3) {
        const int x = col & 127, pair = x >> 5, y = x & 31;
        return (col & ~127) + 16 * (2 * pair + ((y >> 2) & 1)) + 4 * (y >> 3) + (y & 3);
    }
    return col;
}
__device__ __forceinline__ unsigned pk4_fp8(float a, float b, float c, float d) {
    a = fminf(fmaxf(a, -448.f), 448.f); b = fminf(fmaxf(b, -448.f), 448.f); c = fminf(fmaxf(c, -448.f), 448.f); d = fminf(fmaxf(d, -448.f), 448.f);
    unsigned x = (unsigned)__builtin_amdgcn_cvt_pk_fp8_f32(a, b, 0, false); return (unsigned)__builtin_amdgcn_cvt_pk_fp8_f32(c, d, (int)x, true);
}
template <bool F8>
__device__ void transpose_tile(const float* __restrict__ src, bf16_t* __restrict__ dst, int R, int C, int r0, int c0, float* tile  , int mode, float scale, const int wv_) {
    const int tid = WV * 64 + lane_id();
    f32x4 v[8];
#pragma unroll
    for (int i = 0; i < 8; ++i) v[i] = *(const f32x4*)(src + (size_t)(r0 + (tid >> 6) + 8 * i) * C + c0 + (tid & 63) * 4);
#pragma unroll
    for (int i = 0; i < 8; ++i) {
        float* tp = tile + ((tid >> 6) + 8 * i) * 257 + (tid & 63) * 4;
        tp[0] = v[i][0]; tp[1] = v[i][1]; tp[2] = v[i][2]; tp[3] = v[i][3];
    }
    __syncthreads();
    if constexpr (F8) {
        unsigned char* d8 = (unsigned char*)dst;
#pragma unroll
        for (int k = 0; k < 2; ++k) {
            const int id = tid + 512 * k, c = id >> 2, rr = (id & 3) * 16;
            float x[16];
#pragma unroll
            for (int j = 0; j < 16; ++j) x[j] = tile[(rr + j) * 257 + c] * scale;
            u32x4 w; w.x = pk4_fp8(x[0], x[1], x[2], x[3]); w.y = pk4_fp8(x[4], x[5], x[6], x[7]); w.z = pk4_fp8(x[8], x[9], x[10], x[11]); w.w = pk4_fp8(x[12], x[13], x[14], x[15]);
            *(u32x4*)(d8 + (size_t)rowmap(mode, c0 + c) * R + r0 + rr) = w;
        }
        __syncthreads();
        return;
    }
#pragma unroll
    for (int k = 0; k < 4; ++k) {
        const int id = tid + 512 * k, c = id >> 3, rr = (id & 7) * 8;
        float x[8];
#pragma unroll
        for (int j = 0; j < 8; ++j) x[j] = tile[(rr + j) * 257 + c];
        u32x4 w; w.x = cvt_pk_bf16(x[0], x[1]); w.y = cvt_pk_bf16(x[2], x[3]); w.z = cvt_pk_bf16(x[4], x[5]); w.w = cvt_pk_bf16(x[6], x[7]);
        *(u32x4*)(dst + (size_t)rowmap(mode, c0 + c) * R + r0 + rr) = w;
    }
    __syncthreads();
}

template <bool F8 = false>
__device__ __forceinline__ int transpose_job(const float* src, bf16_t* dst, int batch, int R, int C, int base, float* tile, int mode, const int wv_, float scale = 1.0f, int tj0 = 0, int tjn = 0) {
    const int nb = gridDim.x, bid = blockIdx.x;
    const int tr = R / 64, tc = tjn ? tjn : C / 256, per = tr * tc, tot = per * batch;
    const int first = (bid - (base % nb) + nb) % nb;
    for (int t = first; t < tot; t += nb) {
        const int e = t / per, r = t % per, ti = r / tc, tj = r % tc;
        transpose_tile<F8>(src + (size_t)e * R * C, F8 ? (bf16_t*)((unsigned char*)dst + (size_t)e * R * C) : dst + (size_t)e * R * C, R, C, ti * 64, (tj0 + tj) * 256, tile, mode, scale, wv_);
    }
    return base + tot;
}

__device__ __forceinline__ float log2_sigmoid(float x) {
    const float ax = fabsf(x);
    const float sp = fmaxf(-x, 0.f) + log1pf(__expf(-ax));
    return -sp * LOG2E;
}

__device__ void phase0(const Params& p, unsigned char* lds, const int wv_) {
    unsigned char* ws = p.ws;
    const int tid = WV * 64 + lane_id(), nb = gridDim.x, bid = blockIdx.x;
    for (int idx = bid * NTHREADS + tid; idx < SEQ * 32; idx += nb * NTHREADS) {
        const int s = idx >> 5, i = idx & 31;
        const double ang = (double)s * INV_FREQ[i];
        const double rev = ang * 0.15915494309189535;
        const double fr = rev - floor(rev);
        const float ff = (float)fr;
        float2 cs; cs.x = __builtin_amdgcn_cosf(ff); cs.y = __builtin_amdgcn_sinf(ff);
        ((float2*)(ws + WS_ROPE))[idx] = cs;
    }
    if (bid == 0 && tid < 16) ((float*)(ws + WS_LGT))[tid] = log2_sigmoid(tid < 8 ? p.in[3][tid] : p.in[4][tid - 8]);
    for (int idx = bid * NTHREADS + tid; idx < 8 * 4 * 4 * 64; idx += nb * NTHREADS) {
        const int ln = idx & 63, nt = (idx >> 6) & 3, ks = (idx >> 8) & 3, w = idx >> 10, li = ln & 15, q = ln >> 4;
        float wv[8];
#pragma unroll
        for (int j = 0; j < 8; ++j) wv[j] = p.in[10][(size_t)(128 * w + 32 * ks + 8 * q + j) * 64 + 16 * nt + li];
        u32x4 hi, lo;
        hi.x = cvt_pk_bf16(wv[0], wv[1]); hi.y = cvt_pk_bf16(wv[2], wv[3]); hi.z = cvt_pk_bf16(wv[4], wv[5]); hi.w = cvt_pk_bf16(wv[6], wv[7]);
        lo.x = cvt_pk_bf16(wv[0] - bflo(hi.x), wv[1] - bfhi(hi.x)); lo.y = cvt_pk_bf16(wv[2] - bflo(hi.y), wv[3] - bfhi(hi.y));
        lo.z = cvt_pk_bf16(wv[4] - bflo(hi.z), wv[5] - bfhi(hi.z)); lo.w = cvt_pk_bf16(wv[6] - bflo(hi.w), wv[7] - bfhi(hi.w));
        u32x4* dst = (u32x4*)(ws + WS_WRF) + (size_t)(((w * 4 + ks) * 4 + nt) * 2) * 64 + ln;
        dst[0] = hi; dst[64] = lo;
    }
    {
        const float* x = p.in[0]; bf16_t* xb = (bf16_t*)(ws + WS_XB); unsigned char* x8 = ws + WS_X8;
        const size_t n8 = (size_t)T_TOK * DM / 8;
        for (size_t i = (size_t)bid * NTHREADS + tid; i < n8; i += (size_t)nb * NTHREADS) {
            const f32x4 a = *(const f32x4*)(x + i * 8), b = *(const f32x4*)(x + i * 8 + 4);
            u32x4 w; w.x = cvt_pk_bf16(a[0], a[1]); w.y = cvt_pk_bf16(a[2], a[3]); w.z = cvt_pk_bf16(b[0], b[1]); w.w = cvt_pk_bf16(b[2], b[3]);
            *(u32x4*)(xb + i * 8) = w;
            u32x2 f; f.x = pk4_fp8(a[0] * X8_SCALE, a[1] * X8_SCALE, a[2] * X8_SCALE, a[3] * X8_SCALE); f.y = pk4_fp8(b[0] * X8_SCALE, b[1] * X8_SCALE, b[2] * X8_SCALE, b[3] * X8_SCALE);
            *(u32x2*)(x8 + i * 8) = f;
        }
        const float* pp = p.in[1]; unsigned char* p8 = ws + WS_PB;
        const size_t m8 = (size_t)T_TOK * PLE / 8;
        for (size_t i = (size_t)bid * NTHREADS + tid; i < m8; i += (size_t)nb * NTHREADS) {
            const f32x4 a = *(const f32x4*)(pp + i * 8), b = *(const f32x4*)(pp + i * 8 + 4);
            u32x2 f; f.x = pk4_fp8(a[0] * P8_SCALE, a[1] * P8_SCALE, a[2] * P8_SCALE, a[3] * P8_SCALE); f.y = pk4_fp8(b[0] * P8_SCALE, b[1] * P8_SCALE, b[2] * P8_SCALE, b[3] * P8_SCALE);
            *(u32x2*)(p8 + i * 8) = f;
        }
    }
    float* tile = (float*)lds;
    int base = 0;
    base = transpose_job(p.in[2],  (bf16_t*)(ws + WS_WINT), 1, 1024, 3584, base, tile, 1, wv_, 1.0f, 0, 8);
    base = transpose_job<true>(p.in[2], (bf16_t*)(ws + WS_WIN8 - (size_t)2048 * 1024), 1, 1024, 3584, base, tile, 1, wv_, WIN8_SCALE, 8, 6);
    base = transpose_job<true>(p.in[7],  (bf16_t*)(ws + WS_WOUTT), 1, 1024, 1024, base, tile, 3, wv_, WO_SCALE);
    base = transpose_job<true>(p.in[12], (bf16_t*)(ws + WS_WGUT), 64, 1024, 512, base, tile, 2, wv_, WGU_SCALE);
    base = transpose_job<true>(p.in[14], (bf16_t*)(ws + WS_WGUT + (size_t)64 * 512 * 1024), 1, 1024, 512, base, tile, 2, wv_, WGU_SCALE);
    base = transpose_job<true>(p.in[13], (bf16_t*)(ws + WS_WDT), 64, 256, 1024, base, tile, 4, wv_, WD_SCALE);
    base = transpose_job<true>(p.in[15], (bf16_t*)(ws + WS_WDT + (size_t)64 * 1024 * 256), 1, 256, 1024, base, tile, 4, wv_, WD_SCALE);
    base = transpose_job<true>(p.in[17], (bf16_t*)(ws + WS_WGATE), 1, 1024, 1024, base, tile, 4, wv_, WGU_SCALE);
    base = transpose_job<true>(p.in[16], (bf16_t*)(ws + WS_WPT), 1, 256, 1024, base, tile, 0, wv_, WP8_SCALE);
}

struct SchedDense {
    static constexpr bool VARK = false;
    const char* A; const char* B; int K; pg8::TileOrder ord;
    __device__ bool next(int i, pg8::Unit& u) const {
        int pm, pn; if (!ord.map((long)i * gridDim.x + blockIdx.x, pm, pn)) return false;
        u.pm = pm; u.pn = pn; u.A = A + (size_t)pm * 256 * K * 2; u.B = B + (size_t)pn * 256 * K * 2; u.x0 = u.x1 = u.x2 = u.x3 = 0; return true;
    }
    __device__ int arow(const pg8::Unit&, int r) const { return r; }
};
template <bool F8>
struct EpiInProjT {
    static constexpr bool PERM = false; static constexpr int NMETA = 0;
    __device__ const char* meta_src(const pg8::Unit&, int) const { return nullptr; }
    unsigned char* ws;
    __device__ __forceinline__ void operator()(const f32x4 (&acc)[2][2][4][2], const pg8::Unit& u, int wr, int wc, int fr_, int fq_, const PG8_LAS unsigned char* meta) const {
        int fr = fr_, fq = fq_; asm volatile("" : "+v"(fr), "+v"(fq));
        if constexpr (F8) {
        if (u.x0 == 1) {
            bf16_t* ple = (bf16_t*)(ws + WS_PLE);
#pragma unroll
            for (int ai = 0; ai < 2; ++ai)
#pragma unroll
                for (int m = 0; m < 4; ++m) {
                    const size_t t = u.pm * 256 + 128 * ai + 64 * wr + 16 * m + fr;
#pragma unroll
                    for (int bj = 0; bj < 2; ++bj)
#pragma unroll
                        for (int n = 0; n < 2; ++n) {
                            const f32x4 a = acc[ai][bj][m][n] * PLEP_DESCALE;
                            u32x2 w; w.x = cvt_pk_bf16(a[0], a[1]); w.y = cvt_pk_bf16(a[2], a[3]);
                            *(u32x2*)(ple + t * DM + u.pn * 256 + 128 * bj + 32 * wc + 16 * n + 4 * fq) = w;
                        }
                }
            return;
        }
        }
        const float2* rope = (const float2*)(ws + WS_ROPE);
        const int region = u.pn >> 1, d0 = 16 * (wc & 1) + 4 * fq;
#pragma unroll
        for (int ai = 0; ai < 2; ++ai)
#pragma unroll
            for (int m = 0; m < 4; ++m) {
                const int t = u.pm * 256 + 128 * ai + 64 * wr + 16 * m + fr, b = t >> 12, s = t & 4095;
                f32x4 cs0, cs1;
                if constexpr (!F8) { if (region <= 1) { cs0 = *(const f32x4*)(rope + (size_t)s * 32 + d0); cs1 = *(const f32x4*)(rope + (size_t)s * 32 + d0 + 2); } }
#pragma unroll
                for (int bj = 0; bj < 2; ++bj) {
                    const int head = 4 * (u.pn & 1) + 2 * bj + (wc >> 1), bh = b * 8 + head;
                    const f32x4 a0 = acc[ai][bj][m][0], a1 = acc[ai][bj][m][1];
                    if constexpr (!F8) {
                    if (region <= 1) {
                        const float sc = region == 1 ? 0.125f : 1.0f;
                        const float co[4] = {cs0[0], cs0[2], cs1[0], cs1[2]}, si[4] = {cs0[1], cs0[3], cs1[1], cs1[3]};
                        float o1[4], o2[4];
#pragma unroll
                        for (int r = 0; r < 4; ++r) { o1[r] = (a0[r] * co[r] - a1[r] * si[r]) * sc; o2[r] = (a0[r] * si[r] + a1[r] * co[r]) * sc; }
                        u32x2 w1, w2; w1.x = cvt_pk_bf16(o1[0], o1[1]); w1.y = cvt_pk_bf16(o1[2], o1[3]); w2.x = cvt_pk_bf16(o2[0], o2[1]); w2.y = cvt_pk_bf16(o2[2], o2[3]);
                        bf16_t* dst = (bf16_t*)(ws + (region == 0 ? WS_Q : WS_K)) + ((size_t)bh * SEQ + s) * 64;
                        *(u32x2*)(dst + d0) = w1; *(u32x2*)(dst + d0 + 32) = w2;
                        if (region == 1) {
                            bf16_t* dstT = (bf16_t*)(ws + WS_KT) + (size_t)bh * 64 * SEQ + s;
                            dstT[(size_t)(d0 + 0) * SEQ] = (bf16_t)(w1.x & 0xffff); dstT[(size_t)(d0 + 1) * SEQ] = (bf16_t)(w1.x >> 16);
                            dstT[(size_t)(d0 + 2) * SEQ] = (bf16_t)(w1.y & 0xffff); dstT[(size_t)(d0 + 3) * SEQ] = (bf16_t)(w1.y >> 16);
                            dstT[(size_t)(d0 + 32) * SEQ] = (bf16_t)(w2.x & 0xffff); dstT[(size_t)(d0 + 33) * SEQ] = (bf16_t)(w2.x >> 16);
                            dstT[(size_t)(d0 + 34) * SEQ] = (bf16_t)(w2.y & 0xffff); dstT[(size_t)(d0 + 35) * SEQ] = (bf16_t)(w2.y >> 16);
                        }
                    } else if (region == 2) {
                        bf16_t* dstT = (bf16_t*)(ws + WS_VT) + (size_t)bh * 64 * SEQ + s;
#pragma unroll
                        for (int r = 0; r < 4; ++r) { dstT[(size_t)(d0 + r) * SEQ] = f2bf(a0[r]); dstT[(size_t)(d0 + 32 + r) * SEQ] = f2bf(a1[r]); }
                    } else {
                        bf16_t* dst = (bf16_t*)(ws + WS_G) + (size_t)t * 512 + head * 64;
                        u32x2 w1, w2; w1.x = cvt_pk_bf16(siluf_(a0[0]), siluf_(a0[1])); w1.y = cvt_pk_bf16(siluf_(a0[2]), siluf_(a0[3]));
                        w2.x = cvt_pk_bf16(siluf_(a1[0]), siluf_(a1[1])); w2.y = cvt_pk_bf16(siluf_(a1[2]), siluf_(a1[3]));
                        *(u32x2*)(dst + d0) = w1; *(u32x2*)(dst + d0 + 32) = w2;
                    }
                    } else {
                    if (region == 6) {
                        bf16_t* dstT = (bf16_t*)(ws + WS_NVT) + (size_t)bh * 64 * SEQ + s;
#pragma unroll
                        for (int r = 0; r < 4; ++r) { dstT[(size_t)(d0 + r) * SEQ] = f2bf(a0[r] * NA_DESCALE); dstT[(size_t)(d0 + 32 + r) * SEQ] = f2bf(a1[r] * NA_DESCALE); }
                    } else {
                        const float sc = (region == 4 ? 0.125f : 1.0f) * NA_DESCALE;
                        bf16_t* dst = (bf16_t*)(ws + (region == 4 ? WS_NQ : WS_NK)) + ((size_t)bh * SEQ + s) * 64;
                        u32x2 w1, w2; w1.x = cvt_pk_bf16(a0[0] * sc, a0[1] * sc); w1.y = cvt_pk_bf16(a0[2] * sc, a0[3] * sc);
                        w2.x = cvt_pk_bf16(a1[0] * sc, a1[1] * sc); w2.y = cvt_pk_bf16(a1[2] * sc, a1[3] * sc);
                        *(u32x2*)(dst + d0) = w1; *(u32x2*)(dst + d0 + 32) = w2;
                    }
                    }
                }
            }
    }
};
struct SchedP1a {
    static constexpr bool VARK = false;
    unsigned char* ws; pg8::TileOrder ord;
    __device__ bool next(int i, pg8::Unit& u) const {
        const long L = (long)i * gridDim.x + blockIdx.x;
        int pm, pn;
        if (!ord.map(L, pm, pn)) return false;
        u.pm = pm; u.pn = pn; u.x0 = 0; u.x1 = u.x2 = 0; u.x3 = DM;
        u.A = (const char*)(ws + WS_XB) + (size_t)pm * 256 * DM * 2; u.B = (const char*)(ws + WS_WINT) + (size_t)pn * 256 * DM * 2; return true;
    }
    __device__ int arow(const pg8::Unit&, int r) const { return r; }
};
struct SchedP1b {
    static constexpr bool VARK = true;
    unsigned char* ws; pg8::TileOrder ord;
    __device__ bool next(int i, pg8::Unit& u) const {
        const long L = (long)i * gridDim.x + blockIdx.x;
        int pm, pn;
        if (ord.map(L, pm, pn)) {
            u.pm = pm; u.pn = 8 + pn; u.x0 = 0; u.x1 = u.x2 = 0; u.x3 = DM / 2;
            u.A = (const char*)(ws + WS_X8) + (size_t)pm * 256 * DM; u.B = (const char*)(ws + WS_WIN8) + (size_t)pn * 256 * DM; return true;
        }
        const int lastr = ord.nwg / (int)gridDim.x, c = (int)blockIdx.x, nfree = (int)gridDim.x - ord.nwg % (int)gridDim.x, cf = c - ord.nwg % (int)gridDim.x;
        if (cf < 0 || i < lastr) return false;
        const int per = (256 + nfree - 1) / nfree, j = i - lastr;
        if (j >= per) return false;
        const int x = cf * per + j;
        if (x >= 256) return false;
        u.pm = x >> 2; u.pn = x & 3; u.x0 = 1; u.x1 = u.x2 = 0; u.x3 = PLE / 2;
        u.A = (const char*)(ws + WS_PB) + (size_t)u.pm * 256 * PLE; u.B = (const char*)(ws + WS_WPT) + (size_t)u.pn * 256 * PLE; return true;
    }
    __device__ int arow(const pg8::Unit&, int r) const { return r; }
};
__device__ void phase1(const Params& p, unsigned char* lds, const int wv_) {
    {
        SchedP1a S; S.ws = p.ws; S.ord.init(T_TOK, 2048);
        EpiInProjT<false> E; E.ws = p.ws;
        pg8::gemm_phase<EpiInProjT<false>, SchedP1a, false, true, true>((PG8_LAS unsigned char*)lds, DM, S, E, wv_);
    }
    {
        SchedP1b S; S.ws = p.ws; S.ord.init(T_TOK, 1536);
        EpiInProjT<true> E; E.ws = p.ws;
        pg8::gemm_phase<EpiInProjT<true>, SchedP1b, false, true, true, true>((PG8_LAS unsigned char*)lds, DM / 2, S, E, wv_);
    }
}


__device__ void phase2(const Params& p, unsigned char* lds, const int wv_) {
    unsigned char* ws = p.ws;
    const int lane = lane_id(), wid = WV, tid = wid * 64 + lane, q = lane >> 4, li = lane & 15;
    const bf16_t* KT = (const bf16_t*)(ws + WS_KT); const bf16_t* VT = (const bf16_t*)(ws + WS_VT);
    const bf16_t* NQ = (const bf16_t*)(ws + WS_NQ); const bf16_t* NK = (const bf16_t*)(ws + WS_NK); const bf16_t* NVT = (const bf16_t*)(ws + WS_NVT);
    float* SST = (float*)(ws + WS_SST);
    unsigned char* mix = ws + WS_MIX;
    constexpr int KS_BYTES = 576 * 128, VROW = 1168, VS_BYTES = 64 * VROW;
    unsigned char* Ks = lds; unsigned char* Vs = lds + KS_BYTES; float* biasL = (float*)(lds + KS_BYTES + VS_BYTES);
    bf16_t* PS = (bf16_t*)(ws + WS_SST);
    const int G_ = gridDim.x, c_ = blockIdx.x, cswz = (G_ & 7) == 0 ? (c_ & 7) * (G_ >> 3) + (c_ >> 3) : c_;
    for (int u = cswz; u < 256; u += gridDim.x) {
        const int bh = u >> 3, dir = (u >> 2) & 1, dvt = u & 3, h = bh & 7;
        const float lg = ((const float*)(ws + WS_LGT))[8 * dir + h];
        const float gC = fast_exp2(lg * 128.f);
        constexpr int SLOT = 80 * 256;
        const bf16_t* src[3]; unsigned ldso[3];
#pragma unroll
        for (int k = 0; k < 3; ++k) {
            const int id = tid + 512 * k, r = (id >> 4) < 80 ? (id >> 4) : 0, ch = id & 15;
            src[k] = (r < 16 ? VT + ((size_t)bh * 64 + 16 * dvt + r) * SEQ : KT + ((size_t)bh * 64 + (r - 16)) * SEQ) + ch * 8;
            ldso[k] = (unsigned)(r * 256 + ((ch ^ (r & 15)) << 4));
        }
        const bool has3 = tid < 256;
        u32x4 rg[3][3];
#define SCAN_LOAD(slot, c) do { _Pragma("unroll") for (int k = 0; k < 2; ++k) rg[slot][k] = *(const u32x4*)(src[k] + (c) * 128); if (has3) rg[slot][2] = *(const u32x4*)(src[2] + (c) * 128); } while (0)
#define SCAN_STORE(slot, ls) do { _Pragma("unroll") for (int k = 0; k < 2; ++k) *(u32x4*)(lds + (ls) * SLOT + ldso[k]) = rg[slot][k]; if (has3) *(u32x4*)(lds + (ls) * SLOT + ldso[2]) = rg[slot][2]; } while (0)
#define SCAN_CH(step) (dir == 0 ? (step) : 31 - (step))
        SCAN_LOAD(0, SCAN_CH(0)); SCAN_LOAD(1, SCAN_CH(1)); SCAN_LOAD(2, SCAN_CH(2));
        float wg[4][8];
#pragma unroll
        for (int ks = 0; ks < 4; ++ks)
#pragma unroll
            for (int j = 0; j < 8; ++j) { const int jl = 32 * ks + 8 * q + j; wg[ks][j] = fast_exp2(lg * (float)(dir == 0 ? (127 - jl) : jl)); }
        f32x4 st = (f32x4){0.f, 0.f, 0.f, 0.f};
        __syncthreads();
        SCAN_STORE(0, 0);
#pragma unroll 1
        for (int s3 = 0; s3 < 33; s3 += 3) {
#pragma unroll
            for (int j = 0; j < 3; ++j) {
                const int step = s3 + j;
                if (step < 32) {
                    if (step + 3 < 32) SCAN_LOAD(j, SCAN_CH(step + 3));
                    __syncthreads();
                    if (step + 1 < 32) SCAN_STORE((j + 1) % 3, (step + 1) & 1);
                    if (wid < 4) {
                        const int c = SCAN_CH(step);
                        bf16_t* dst = PS + ((size_t)(bh * 32 + c) * 2 + dir) * 4096;
#pragma unroll
                        for (int r = 0; r < 4; ++r) dst[(16 * dvt + 4 * q + r) * 64 + 16 * wid + li] = f2bf(st[r]);
                        st = st * gC;
                        const unsigned char* sl = lds + (step & 1) * SLOT;
#pragma unroll
                        for (int ks = 0; ks < 4; ++ks) {
                            const u32x4 vr = *(const u32x4*)(sl + li * 256 + (((4 * ks + q) ^ li) << 4));
                            const u32x4 kr = *(const u32x4*)(sl + (16 + 16 * wid + li) * 256 + (((4 * ks + q) ^ li) << 4));
                            u32x4 kw;
                            kw.x = cvt_pk_bf16(bflo(kr.x) * wg[ks][0], bfhi(kr.x) * wg[ks][1]); kw.y = cvt_pk_bf16(bflo(kr.y) * wg[ks][2], bfhi(kr.y) * wg[ks][3]);
                            kw.z = cvt_pk_bf16(bflo(kr.z) * wg[ks][4], bfhi(kr.z) * wg[ks][5]); kw.w = cvt_pk_bf16(bflo(kr.w) * wg[ks][6], bfhi(kr.w) * wg[ks][7]);
                            st = MFMA16(__builtin_bit_cast(bf16x8, vr), __builtin_bit_cast(bf16x8, kw), st);
                        }
                    }
                }
            }
        }
#undef SCAN_LOAD
#undef SCAN_STORE
#undef SCAN_CH
    }
    u32x4 kreg[9], vreg[9]; float breg = 0.f;
#define NA_DECODE(xx) const int rp = (xx) & 31, h = ((xx) >> 5) & 7, b = (xx) >> 8, bh = b * 8 + h; const int r0 = 2 * rp, base_r = min(min(max(r0 - 4, 0), 56), 55)
#define NA_LOAD(xx) do { NA_DECODE(xx); const u32x4* ksrc = (const u32x4*)(NK + ((size_t)bh * SEQ + base_r * 64) * 64); \
        _Pragma("unroll") for (int i = 0; i < 9; ++i) kreg[i] = ksrc[tid + 512 * i]; \
        _Pragma("unroll") for (int i = 0; i < 9; ++i) { const int id = tid + 512 * i, row = id / 72, ch = id % 72; vreg[i] = *(const u32x4*)(NVT + ((size_t)bh * 64 + row) * SEQ + base_r * 64 + ch * 8); } \
        if (tid < 15 * 31) breg = p.in[6][h * 15 * 31 + tid]; } while (0)
    if (cswz < 1024) NA_LOAD(cswz);
    for (int x = cswz; x < 1024; x += gridDim.x) {
        {
            NA_DECODE(x);
            __syncthreads();
            if (tid < 15 * 31) biasL[tid] = breg;
#pragma unroll
            for (int i = 0; i < 9; ++i) { const int id = tid + 512 * i, row = id >> 3, ch = id & 7; *(u32x4*)(Ks + row * 128 + ((ch ^ (row & 7)) << 4)) = kreg[i]; }
#pragma unroll
            for (int i = 0; i < 9; ++i) { const int id = tid + 512 * i, row = id / 72, ch = id % 72; *(u32x4*)(Vs + row * VROW + ch * 16) = vreg[i]; }
            __syncthreads();
            if (x + (int)gridDim.x < 1024) NA_LOAD(x + (int)gridDim.x);
            const int r = r0 + (wid >> 2), cblk = wid & 3;
            const int rs = min(max(r - 4, 0), 56), kr0 = rs - base_r;
            const int cw = cblk == 0 ? 0 : (cblk == 1 ? 8 : (cblk == 2 ? 24 : 32));
            const int c = 16 * cblk + li, cs = min(max(c - 8, 0), 48);
            const size_t qtok = (size_t)bh * SEQ + r * 64 + c;
            bf16x8 qf[2];
            qf[0] = *(const bf16x8*)(NQ + qtok * 64 + 8 * q); qf[1] = *(const bf16x8*)(NQ + qtok * 64 + 32 + 8 * q);
            f32x4 sT[16];
            const int wcol_l = 8 * (li >> 2) + (li & 3);
#pragma unroll
            for (int kt = 0; kt < 16; ++kt) {
                const int krow = (kr0 + (kt >> 1)) * 64 + cw + wcol_l + 4 * (kt & 1);
                const bf16x8 k0 = *(const bf16x8*)(Ks + krow * 128 + ((q ^ (krow & 7)) << 4));
                const bf16x8 k1 = *(const bf16x8*)(Ks + krow * 128 + (((4 + q) ^ (krow & 7)) << 4));
                f32x4 a = (f32x4){0.f, 0.f, 0.f, 0.f};
                a = MFMA16(k0, qf[0], a); a = MFMA16(k1, qf[1], a);
                sT[kt] = a;
            }
            float mx = -3.0e38f;
#pragma unroll
            for (int kt = 0; kt < 16; ++kt) {
                const float* brow = biasL + (rs + (kt >> 1) - r + 7) * 31;
#pragma unroll
                for (int rr = 0; rr < 4; ++rr) {
                    const int kc = cw + 8 * q + 4 * (kt & 1) + rr;
                    const bool valid = (kc >= cs) && (kc <= cs + 15);
                    const int bi = min(max(kc - c + 15, 0), 30);
                    float bv = brow[bi]; asm volatile("" : "+v"(bv));
                    const float sv = valid ? (sT[kt][rr] + bv) : -3.0e38f;
                    sT[kt][rr] = sv; mx = fmaxf(mx, sv);
                }
            }
            mx = fmaxf(mx, __shfl_xor(mx, 16)); mx = fmaxf(mx, __shfl_xor(mx, 32));
            float sum = 0.f;
#pragma unroll
            for (int kt = 0; kt < 16; ++kt)
#pragma unroll
                for (int rr = 0; rr < 4; ++rr) { const float e = fast_exp2((sT[kt][rr] - mx) * LOG2E); sT[kt][rr] = e; sum += e; }
            sum += __shfl_xor(sum, 16); sum += __shfl_xor(sum, 32);
            const float inv = 1.0f / sum;
            f32x4 oT[4];
#pragma unroll
            for (int d = 0; d < 4; ++d) oT[d] = (f32x4){0.f, 0.f, 0.f, 0.f};
#pragma unroll
            for (int ks = 0; ks < 8; ++ks) {
                u32x4 pw; pw.x = cvt_pk_bf16(sT[2 * ks][0], sT[2 * ks][1]); pw.y = cvt_pk_bf16(sT[2 * ks][2], sT[2 * ks][3]);
                pw.z = cvt_pk_bf16(sT[2 * ks + 1][0], sT[2 * ks + 1][1]); pw.w = cvt_pk_bf16(sT[2 * ks + 1][2], sT[2 * ks + 1][3]);
                const bf16x8 pf = __builtin_bit_cast(bf16x8, pw);
                const int vtok = (kr0 + ks) * 64 + cw + 8 * q;
#pragma unroll
                for (int d = 0; d < 4; ++d) {
                    const bf16x8 vf = *(const bf16x8*)(Vs + (16 * d + li) * VROW + vtok * 2);
                    oT[d] = MFMA16(vf, pf, oT[d]);
                }
            }
            unsigned char* dst = mix + ((size_t)b * SEQ + r * 64 + c) * DM + 512 + h * 64 + 4 * q;
            const float invs = inv * MIX_SCALE;
#pragma unroll
            for (int d = 0; d < 4; ++d) *(unsigned*)(dst + 16 * d) = pk4_fp8(oT[d][0] * invs, oT[d][1] * invs, oT[d][2] * invs, oT[d][3] * invs);
        }
    }
}

__device__ void phase3(const Params& p, unsigned char* lds, const int wv_) {
    unsigned char* ws = p.ws;
    const int lane = lane_id(), wid = WV, tid = wid * 64 + lane, q = lane >> 4, li = lane & 15;
    const bf16_t* Q = (const bf16_t*)(ws + WS_Q); const bf16_t* Kp = (const bf16_t*)(ws + WS_K); const bf16_t* VT = (const bf16_t*)(ws + WS_VT);
    const bf16_t* Gt = (const bf16_t*)(ws + WS_G);
    const bf16_t* PS = (const bf16_t*)(ws + WS_SST);
    unsigned char* mix = ws + WS_MIX;
    constexpr int PROW = 144;
    unsigned char* Ks = lds + 2 * 64 * PROW;
    unsigned char* Vs = Ks + 128 * 128;
    for (int u = blockIdx.x; u < 1024; u += gridDim.x) {
        const int bh = u >> 5, c = u & 31, h = bh & 7, b = bh >> 3;
        const float lf = ((const float*)(ws + WS_LGT))[h], lb = ((const float*)(ws + WS_LGT))[8 + h];
        __syncthreads();
        u32x4 kreg[2], vreg[2];
#pragma unroll
        for (int i = 0; i < 2; ++i) {
            const int id = tid + 512 * i;
            kreg[i] = *(const u32x4*)(Kp + ((size_t)bh * SEQ + c * 128) * 64 + id * 8);
            vreg[i] = *(const u32x4*)(VT + ((size_t)bh * 64 + (id >> 4)) * SEQ + c * 128 + (id & 15) * 8);
        }
        u32x4 preg[2];
#pragma unroll
        for (int rep = 0; rep < 2; ++rep) preg[rep] = *(const u32x4*)(PS + (size_t)(bh * 32 + c) * 2 * 4096 + (size_t)(tid + 512 * rep) * 8);
#pragma unroll
        for (int rep = 0; rep < 2; ++rep) {
            const int id = tid + 512 * rep, dir = id >> 9, dv = (id >> 3) & 63, ch = id & 7;
            *(u32x4*)(lds + dir * (64 * PROW) + dv * PROW + ch * 16) = preg[rep];
        }
#pragma unroll
        for (int i = 0; i < 2; ++i) {
            const int id = tid + 512 * i;
            { const int row = id >> 3, ch = id & 7; *(u32x4*)(Ks + row * 128 + ((ch ^ (row & 7)) << 4)) = kreg[i]; }
            { const int row = id >> 4, ch = id & 15; *(u32x4*)(Vs + row * 256 + ((ch ^ (row & 15)) << 4)) = vreg[i]; }
        }
        __syncthreads();
        const int ii = 16 * wid + li;
        const size_t qrow = (size_t)bh * SEQ + c * 128 + ii;
        bf16x8 qf[2];
        qf[0] = *(const bf16x8*)(Q + qrow * 64 + 8 * q); qf[1] = *(const bf16x8*)(Q + qrow * 64 + 32 + 8 * q);
        f32x4 sT[8];
        const int kl = 8 * (li >> 2) + (li & 3);
#pragma unroll
        for (int jt = 0; jt < 8; ++jt) {
            const int krow = 32 * (jt >> 1) + kl + 4 * (jt & 1);
            const bf16x8 k0 = *(const bf16x8*)(Ks + krow * 128 + ((q ^ (krow & 7)) << 4));
            const bf16x8 k1 = *(const bf16x8*)(Ks + krow * 128 + (((4 + q) ^ (krow & 7)) << 4));
            f32x4 a = (f32x4){0.f, 0.f, 0.f, 0.f};
            a = MFMA16(k0, qf[0], a); a = MFMA16(k1, qf[1], a);
#pragma unroll
            for (int rr = 0; rr < 4; ++rr) {
                const int j = 32 * (jt >> 1) + 8 * q + 4 * (jt & 1) + rr, diff = ii - j;
                const float d = diff >= 0 ? fast_exp2(lf * (float)diff) : fast_exp2(lb * (float)(-diff));
                a[rr] *= d;
            }
            sT[jt] = a;
        }
        f32x4 yT[4], uf[4], ub[4];
#pragma unroll
        for (int d = 0; d < 4; ++d) { yT[d] = (f32x4){0.f, 0.f, 0.f, 0.f}; uf[d] = yT[d]; ub[d] = yT[d]; }
#pragma unroll
        for (int ks = 0; ks < 4; ++ks) {
            u32x4 pw; pw.x = cvt_pk_bf16(sT[2 * ks][0], sT[2 * ks][1]); pw.y = cvt_pk_bf16(sT[2 * ks][2], sT[2 * ks][3]);
            pw.z = cvt_pk_bf16(sT[2 * ks + 1][0], sT[2 * ks + 1][1]); pw.w = cvt_pk_bf16(sT[2 * ks + 1][2], sT[2 * ks + 1][3]);
            const bf16x8 pf = __builtin_bit_cast(bf16x8, pw);
#pragma unroll
            for (int d = 0; d < 4; ++d) {
                const int vrow = 16 * d + li;
                const bf16x8 vf = *(const bf16x8*)(Vs + vrow * 256 + (((4 * ks + q) ^ li) << 4));
                yT[d] = MFMA16(vf, pf, yT[d]);
            }
        }
#pragma unroll
        for (int d = 0; d < 4; ++d)
#pragma unroll
            for (int ks = 0; ks < 2; ++ks) {
                const bf16x8 pfw = *(const bf16x8*)(lds + (16 * d + li) * PROW + ks * 64 + q * 16);
                const bf16x8 pbw = *(const bf16x8*)(lds + 64 * PROW + (16 * d + li) * PROW + ks * 64 + q * 16);
                uf[d] = MFMA16(pfw, qf[ks], uf[d]); ub[d] = MFMA16(pbw, qf[ks], ub[d]);
            }
        const float df = fast_exp2(lf * (float)(ii + 1)), db = fast_exp2(lb * (float)(128 - ii));
        float sum = 0.f;
#pragma unroll
        for (int d = 0; d < 4; ++d)
#pragma unroll
            for (int rr = 0; rr < 4; ++rr) { const float y = yT[d][rr] + df * uf[d][rr] + db * ub[d][rr]; yT[d][rr] = y; sum += y; }
        sum += __shfl_xor(sum, 16); sum += __shfl_xor(sum, 32);
        const float mu = sum * (1.0f / 64.0f);
        float var = 0.f;
#pragma unroll
        for (int d = 0; d < 4; ++d)
#pragma unroll
            for (int rr = 0; rr < 4; ++rr) { const float t = yT[d][rr] - mu; var += t * t; }
        var += __shfl_xor(var, 16); var += __shfl_xor(var, 32);
        const float rstd = rsqrtf(var * (1.0f / 64.0f) + 1e-6f);
        const size_t tg = (size_t)b * SEQ + c * 128 + ii;
#pragma unroll
        for (int d = 0; d < 4; ++d) {
            const int dv = 16 * d + 4 * q;
            const f32x4 gn = *(const f32x4*)(p.in[5] + h * 64 + dv);
            const u32x2 gw = *(const u32x2*)(Gt + tg * 512 + h * 64 + dv);
            const float o0 = (yT[d][0] - mu) * rstd * gn[0] * bflo(gw.x), o1 = (yT[d][1] - mu) * rstd * gn[1] * bfhi(gw.x);
            const float o2 = (yT[d][2] - mu) * rstd * gn[2] * bflo(gw.y), o3 = (yT[d][3] - mu) * rstd * gn[3] * bfhi(gw.y);
            *(unsigned*)(mix + tg * DM + h * 64 + dv) = pk4_fp8(o0 * MIX_SCALE, o1 * MIX_SCALE, o2 * MIX_SCALE, o3 * MIX_SCALE);
        }
    }
}

__device__ void phase4(const Params& p, unsigned char* lds, const int wv_) {
    unsigned char* ws = p.ws;
    const int lane = lane_id(), wid = WV, tid = wid * 64 + lane, q = lane >> 4, li = lane & 15;
    const unsigned char* A = ws + WS_MIX; const unsigned char* Bt = ws + WS_WOUTT;
    const float* x = p.in[0]; const float* g1 = p.in[8]; const float* b1 = p.in[9]; const float* rb = p.in[11];
    bf16_t* x1b = (bf16_t*)(ws + WS_X1B);
    unsigned* counts = (unsigned*)(ws + WS_CTRL);
    int* ltok = (int*)(ws + WS_LTOK); float2* lkw = (float2*)(ws + WS_LKW);
    float* pl = (float*)lds;
    float* red = (float*)(lds + 147456);
    unsigned* lcnt = (unsigned*)(lds + 147456 + 2048);
    for (int unit = blockIdx.x; unit < T_TOK / 64; unit += gridDim.x) {
        const int m0 = unit * 64;
        f32x4 acc[4][8];
        {
            int lane2 = lane_id(); asm volatile("" : "+v"(lane2)); const int li2 = lane2 & 15, q2 = lane2 >> 4;
            constexpr int GA = 64 * 128, GSTAGE = GA + 256 * 128;
            PG8_LAS unsigned char* L = (PG8_LAS unsigned char*)lds;
            const int prow = lane2 >> 3, pch = (lane2 & 7) ^ (lane2 >> 3);
            const char* asrc = (const char*)(A + (size_t)(m0 + 8 * wid + prow) * DM) + pch * 16;
            const char* bsrc = (const char*)(Bt + (size_t)(128 * wid + prow) * DM) + pch * 16;
            const unsigned rA = (unsigned)li2 * 128u, rB = (unsigned)GA + (unsigned)(wid * 32 + li2) * 128u;
            const unsigned c0_ = (unsigned)((q2 ^ (li2 & 7)) << 4), c1_ = (unsigned)(((4 + q2) ^ (li2 & 7)) << 4);
#define P4_ISSUE(T, ST) do { const int _ps = (T) >> 3, _kt = (T) & 7, _st = (ST); \
        __builtin_amdgcn_global_load_lds((const unsigned*)(asrc + _kt * 128), (PG8_LAS unsigned*)(L + _st * GSTAGE + wid * 1024), 16, 0, 0); \
        _Pragma("unroll") for (int _j = 0; _j < 4; ++_j) __builtin_amdgcn_global_load_lds((const unsigned*)(bsrc + (size_t)(32 * _ps + 8 * _j) * DM + _kt * 128), \
            (PG8_LAS unsigned*)(L + _st * GSTAGE + GA + (4 * wid + _j) * 1024), 16, 0, 0); } while (0)
            __syncthreads();
            P4_ISSUE(0, 0); P4_ISSUE(1, 1);
            int st_c = 0, st_n = 2;
            asm volatile("s_waitcnt vmcnt(5)" ::: "memory");
            __builtin_amdgcn_s_barrier(); asm volatile("" ::: "memory");
#pragma unroll
            for (int ps = 0; ps < 4; ++ps) {
#pragma unroll
                for (int m = 0; m < 4; ++m)
#pragma unroll
                    for (int n = 0; n < 2; ++n) acc[m][2 * ps + n] = (f32x4){0.f, 0.f, 0.f, 0.f};
#pragma unroll 1
                for (int kt = 0; kt < 8; ++kt) {
                    const int T = ps * 8 + kt;
                    if (T + 2 < 32) P4_ISSUE(T + 2, st_n);
                    const PG8_LAS unsigned char* cur = L + st_c * GSTAGE;
                    st_c = st_c == 2 ? 0 : st_c + 1; st_n = st_n == 2 ? 0 : st_n + 1;
                    {
                        bf16x8 af[4][2], bfr[2][2];
#pragma unroll
                        for (int m = 0; m < 4; ++m) { af[m][0] = *(const PG8_LAS bf16x8*)(cur + rA + m * 2048 + c0_); af[m][1] = *(const PG8_LAS bf16x8*)(cur + rA + m * 2048 + c1_); }
#pragma unroll
                        for (int n = 0; n < 2; ++n) { bfr[n][0] = *(const PG8_LAS bf16x8*)(cur + rB + n * 2048 + c0_); bfr[n][1] = *(const PG8_LAS bf16x8*)(cur + rB + n * 2048 + c1_); }
                        asm volatile("s_waitcnt lgkmcnt(0)" ::: "memory");
#pragma unroll
                        for (int m = 0; m < 4; ++m)
#pragma unroll
                            for (int n = 0; n < 2; ++n) { const pg8::i32x8_t _b8 = pg8::cat8(bfr[n][0], bfr[n][1]), _a8 = pg8::cat8(af[m][0], af[m][1]);
                                asm volatile("v_mfma_f32_16x16x128_f8f6f4 %0, %1, %2, %0" : "+v"(acc[m][2 * ps + n]) : "v"(_b8), "v"(_a8)); }
                    }
                    if (T + 2 < 32) asm volatile("s_waitcnt vmcnt(5) lgkmcnt(0)" ::: "memory");
                    else            asm volatile("s_waitcnt vmcnt(0) lgkmcnt(0)" ::: "memory");
                    __builtin_amdgcn_s_barrier(); asm volatile("" ::: "memory");
                }
            }
#undef P4_ISSUE
            asm volatile("s_nop 15" ::: "memory");
            __syncthreads();
        }
        int li_ = li, q_ = q, lane_ = lane; asm volatile("" : "+v"(li_), "+v"(q_), "+v"(lane_));
        {
            PG8_LAS unsigned char* XL = (PG8_LAS unsigned char*)lds;
#define P4_XISSUE(mm) do { _Pragma("unroll") for (int _j = 0; _j < 8; ++_j) { const int _pc = 8 * wid + _j, _rr = _pc >> 2, _qd = _pc & 3; \
        __builtin_amdgcn_global_load_lds((const unsigned*)((const char*)(x + (size_t)(m0 + 16 * (mm) + _rr) * DM) + (64 * _qd + (lane_ ^ _rr)) * 16), \
            (PG8_LAS unsigned*)(XL + ((mm) & 1) * 65536 + _rr * 4096 + _qd * 1024), 16, 0, 0); } } while (0)
            P4_XISSUE(0); P4_XISSUE(1);
#pragma unroll
            for (int m = 0; m < 4; ++m) {
                if (m < 3) asm volatile("s_waitcnt vmcnt(8)" ::: "memory"); else asm volatile("s_waitcnt vmcnt(0)" ::: "memory");
                __builtin_amdgcn_s_barrier(); asm volatile("" ::: "memory");
                const PG8_LAS unsigned char* xb_ = XL + (m & 1) * 65536 + li_ * 4096;
                float s = 0.f;
#pragma unroll
                for (int pr = 0; pr < 4; ++pr) {
                    const int lc = 32 * wid + 8 * pr + 2 * q_;
                    const f32x4 x0 = *(const PG8_LAS f32x4*)(xb_ + ((lc ^ li_) << 4)), x1v = *(const PG8_LAS f32x4*)(xb_ + (((lc + 1) ^ li_) << 4));
                    acc[m][2 * pr] = x0 * ALPHA + acc[m][2 * pr] * O_DESCALE; acc[m][2 * pr + 1] = x1v * ALPHA + acc[m][2 * pr + 1] * O_DESCALE;
                    s += (acc[m][2 * pr][0] + acc[m][2 * pr][1]) + (acc[m][2 * pr][2] + acc[m][2 * pr][3]) + (acc[m][2 * pr + 1][0] + acc[m][2 * pr + 1][1]) + (acc[m][2 * pr + 1][2] + acc[m][2 * pr + 1][3]);
                }
                s += shx(s, 16, lane_); s += shx(s, 32, lane_);
                if (q_ == 0) red[wid * 64 + 16 * m + li_] = s;
                if (m < 2) {
                    asm volatile("s_waitcnt lgkmcnt(0)" ::: "memory");
                    __builtin_amdgcn_s_barrier(); asm volatile("" ::: "memory");
                    if (m == 0) P4_XISSUE(2); else P4_XISSUE(3);
                }
            }
#undef P4_XISSUE
        }
        __syncthreads();
        float mu[4], rstd[4];
#pragma unroll
        for (int m = 0; m < 4; ++m) {
            float s = 0.f;
#pragma unroll
            for (int w = 0; w < 8; ++w) s += red[w * 64 + 16 * m + li_];
            mu[m] = s * (1.0f / 1024.0f);
        }
        __syncthreads();
#pragma unroll
        for (int m = 0; m < 4; ++m) {
            float qv = 0.f;
#pragma unroll
            for (int n = 0; n < 8; ++n)
#pragma unroll
                for (int r = 0; r < 4; ++r) { const float d = acc[m][n][r] - mu[m]; qv += d * d; }
            qv += shx(qv, 16, lane_); qv += shx(qv, 32, lane_);
            if (q_ == 0) red[wid * 64 + 16 * m + li_] = qv;
        }
        __syncthreads();
#pragma unroll
        for (int m = 0; m < 4; ++m) {
            float s = 0.f;
#pragma unroll
            for (int w = 0; w < 8; ++w) s += red[w * 64 + 16 * m + li_];
            rstd[m] = rsqrtf(s * (1.0f / 1024.0f) + 1e-5f);
#pragma unroll
            for (int n = 0; n < 8; ++n) acc[m][n] = (acc[m][n] - mu[m]) * rstd[m];
        }
        __syncthreads();
        const u32x4* wfp = (const u32x4*)(ws + WS_WRF) + (size_t)wid * 2048 + (q_ * 16 + li_);
#pragma unroll
        for (int mh = 0; mh < 2; ++mh) {
            f32x4 lg[2][4];
#pragma unroll
            for (int m = 0; m < 2; ++m)
#pragma unroll
                for (int n = 0; n < 4; ++n) lg[m][n] = (f32x4){0.f, 0.f, 0.f, 0.f};
#pragma unroll
            for (int pr = 0; pr < 4; ++pr) {
                const int c0 = 128 * wid + 32 * pr + 8 * q_;
                const f32x4 ga = *(const f32x4*)(g1 + c0), gb = *(const f32x4*)(g1 + c0 + 4), ba = *(const f32x4*)(b1 + c0), bb = *(const f32x4*)(b1 + c0 + 4);
                bf16x8 wfh[4], wfl[4];
                const u32x4* wp = wfp + pr * 512; asm volatile("" : "+v"(wp));
#pragma unroll
                for (int nt = 0; nt < 4; ++nt) { wfh[nt] = __builtin_bit_cast(bf16x8, wp[nt * 128]); wfl[nt] = __builtin_bit_cast(bf16x8, wp[nt * 128 + 64]); }
#pragma unroll
                for (int m2 = 0; m2 < 2; ++m2) {
                    const int m = 2 * mh + m2;
                    float o[8];
#pragma unroll
                    for (int r = 0; r < 4; ++r) { o[r] = acc[m][2 * pr][r] * ga[r] + ba[r]; o[4 + r] = acc[m][2 * pr + 1][r] * gb[r] + bb[r]; }
                    u32x4 hi, lo;
                    hi.x = cvt_pk_bf16(o[0], o[1]); hi.y = cvt_pk_bf16(o[2], o[3]); hi.z = cvt_pk_bf16(o[4], o[5]); hi.w = cvt_pk_bf16(o[6], o[7]);
                    lo.x = cvt_pk_bf16(o[0] - bflo(hi.x), o[1] - bfhi(hi.x)); lo.y = cvt_pk_bf16(o[2] - bflo(hi.y), o[3] - bfhi(hi.y));
                    lo.z = cvt_pk_bf16(o[4] - bflo(hi.z), o[5] - bfhi(hi.z)); lo.w = cvt_pk_bf16(o[6] - bflo(hi.w), o[7] - bfhi(hi.w));
                    *(u32x4*)(x1b + (size_t)(m0 + 16 * m + li_) * DM + c0) = hi;
                    { u32x2 f8; f8.x = pk4_fp8(o[0] * X1_SCALE, o[1] * X1_SCALE, o[2] * X1_SCALE, o[3] * X1_SCALE); f8.y = pk4_fp8(o[4] * X1_SCALE, o[5] * X1_SCALE, o[6] * X1_SCALE, o[7] * X1_SCALE);
                      *(u32x2*)(ws + WS_X1F8 + (size_t)(m0 + 16 * m + li_) * DM + c0) = f8; }
                    const bf16x8 xh = __builtin_bit_cast(bf16x8, hi), xl = __builtin_bit_cast(bf16x8, lo);
#pragma unroll
                    for (int nt = 0; nt < 4; ++nt) {
                        lg[m2][nt] = MFMA16(wfl[nt], xh, lg[m2][nt]);
                        lg[m2][nt] = MFMA16(wfh[nt], xl, lg[m2][nt]);
                        lg[m2][nt] = MFMA16(wfh[nt], xh, lg[m2][nt]);
                    }
                }
            }
#pragma unroll
            for (int m2 = 0; m2 < 2; ++m2)
#pragma unroll
                for (int nt = 0; nt < 4; ++nt) *(f32x4*)(pl + (wid * 64 + 16 * (2 * mh + m2) + li_) * 64 + 16 * nt + 4 * q_) = lg[m2][nt];
        }
        if (wid == 0) lcnt[lane_] = 0u;
        __syncthreads();
        const float rbias = rb[lane_];
        unsigned selmask = 0u; unsigned lpos[8]; float lw[8]; int lrank[8];
#pragma unroll
        for (int k = 0; k < 8; ++k) {
            const int tk = wid * 8 + k;
            float logit = 0.f;
#pragma unroll
            for (int w = 0; w < 8; ++w) logit += pl[(w * 64 + tk) * 64 + lane_];
            const float score = 1.0f / (1.0f + expf(-logit));
            const float biased = score + rbias;
            float m1 = biased;
            m1 = fmaxf(m1, shx(m1, 1, lane_)); m1 = fmaxf(m1, shx(m1, 2, lane_)); m1 = fmaxf(m1, shx(m1, 4, lane_));
            const unsigned long long eqm = __ballot(biased == m1);
            const int g = lane_ >> 3;
            const unsigned gbits = (unsigned)((eqm >> (8 * g)) & 0xffull);
            const int first = __builtin_ctz(gbits);
            float m2 = ((lane_ & 7) == first) ? -3.0e38f : biased;
            m2 = fmaxf(m2, shx(m2, 1, lane_)); m2 = fmaxf(m2, shx(m2, 2, lane_)); m2 = fmaxf(m2, shx(m2, 4, lane_));
            const float gs = m1 + m2;
            const unsigned gsu = __float_as_uint(gs), gkey = ((gsu ^ ((gsu >> 31) ? 0xffffffffu : 0x80000000u)) & ~7u) | (unsigned)(7 - g);
            int grank = 0;
#pragma unroll
            for (int g2 = 0; g2 < 8; ++g2) grank += ((unsigned)__builtin_amdgcn_readlane((int)gkey, 8 * g2) > gkey) ? 1 : 0;
            const bool gsel = grank < 4;
            const unsigned bu = __float_as_uint(biased), vkey = gsel ? (((bu ^ ((bu >> 31) ? 0xffffffffu : 0x80000000u)) & ~63u) | (unsigned)(63 - lane_)) : 0u;
            int rank = 0;
            const unsigned long long gm = __ballot(gsel);
#pragma unroll
            for (int g2 = 0; g2 < 8; ++g2)
                if ((gm >> (8 * g2)) & 1ull) {
#pragma unroll
                    for (int i2 = 0; i2 < 8; ++i2) rank += ((unsigned)__builtin_amdgcn_readlane((int)vkey, 8 * g2 + i2) > vkey) ? 1 : 0;
                }
            const bool sel = gsel && rank < 8;
            const float wsum = wave_sum_l(sel ? score : 0.f, lane_);
            lw[k] = score / wsum * 2.5f; lrank[k] = rank; lpos[k] = 0u;
            if (sel) { selmask |= 1u << k; lpos[k] = atomicAdd(&lcnt[lane_], 1u); }
        }
        __syncthreads();
        if (wid == 0) lcnt[64 + lane_] = atomicAdd(&counts[lane_ * 64], lcnt[lane_]);
        __syncthreads();
        {
            const unsigned gbase = lcnt[64 + lane_];
#pragma unroll
            for (int k = 0; k < 8; ++k)
                if (selmask & (1u << k)) {
                    const unsigned pos = gbase + lpos[k];
                    ltok[(size_t)lane_ * T_TOK + pos] = m0 + wid * 8 + k;
                    float2 kw; kw.x = __int_as_float(lrank[k]); kw.y = lw[k];
                    lkw[(size_t)lane_ * T_TOK + pos] = kw;
                }
        }
    }
}

struct BlkTab { int start[65]; int total; };
__device__ __forceinline__ void build_blktab(const unsigned* counts, int* tab  , const int wv_) {
    if (WV == 0) {
        const int lane = lane_id();
        const int nb = ((int)counts[lane * 64] + 255) >> 8;
        int incl = nb;
#pragma unroll
        for (int o = 1; o < 64; o <<= 1) { const int v = __shfl_up(incl, o); if (lane >= o) incl += v; }
        tab[lane] = incl - nb;
        if (lane == 63) tab[64] = incl;
    }
    __syncthreads();
}
__device__ __forceinline__ int find_expert(const int* tab, int blk) {
    int e = 0;
#pragma unroll 1
    for (int s = 32; s >= 1; s >>= 1) if (e + s < 64 && tab[e + s] <= blk) e += s;
    return e;
}

constexpr int P6_TAB_OFF = pg8::STAGE_BYTES;
constexpr int P6_UT_OFF = P6_TAB_OFF + 512;
__device__ __forceinline__ int unit_index(int i) { const int G_ = gridDim.x, c_ = blockIdx.x; return i * G_ + ((G_ & 7) == 0 ? (c_ & 7) * (G_ >> 3) + (c_ >> 3) : c_); }
struct Sched6a {
    static constexpr bool VARK = false;
    unsigned char* ws; const int* ut;
    __device__ static void build(const unsigned char* ws, const int* tab, int* ut, const int wv_) {
        if (WV == 0) {
            const int i = lane_id();
            if (i < 16) {
                const int nbr = tab[64], L = unit_index(i), n_r = 2 * nbr, n_s = 2 * NBLK_S;
                int e = -1, pm = 0, pn = 0, bin = 0, cnt = 0;
                if (L < n_r + n_s) {
                    const int blk = L >> 1; pn = L & 1;
                    if (L < n_r) { e = find_expert(tab, blk); bin = blk - tab[e]; cnt = (int)((const unsigned*)(ws + WS_CTRL))[e * 64]; pm = blk; }
                    else { e = 64; bin = blk - nbr; cnt = T_TOK; pm = MAXBLK_R + bin; }
                } else { const int x = L - n_r - n_s; if (x < 256) { e = 65; pm = x >> 2; pn = x & 3; bin = x >> 2; cnt = T_TOK; } }
                int* d = ut + 8 * i; d[0] = e; d[1] = pm; d[2] = pn; d[3] = bin; d[4] = cnt;
            }
        }
        __syncthreads();
    }
    __device__ bool next(int i, pg8::Unit& u) const {
        const pg8::i32x4_t a = *(const pg8::i32x4_t*)(ut + 8 * i); const int cnt = ut[8 * i + 4];
        const int e = rfl(a.x);
        if (e < 0) return false;
        u.pm = rfl(a.y); u.pn = rfl(a.z); u.x0 = e; u.x1 = rfl(a.w); u.x2 = rfl(cnt); u.x3 = 0;
        u.A = (const char*)(ws + WS_X1F8);
        u.B = e == 65 ? (const char*)(ws + WS_WGATE) + (size_t)(u.pn * 256) * DM : (const char*)(ws + WS_WGUT) + ((size_t)e * 512 + 256 * u.pn) * DM;
        return true;
    }
    __device__ int arow(const pg8::Unit& u, int r) const {
        const int pos = u.x1 * 256 + r;
        if (u.x0 >= 64) return pos;
        return pos < u.x2 ? ((const int*)(ws + WS_LTOK))[(size_t)u.x0 * T_TOK + pos] : 0;
    }
    __device__ int arow_lds(const pg8::Unit& u, int r, const PG8_LAS unsigned char* meta) const {
        const int pos = u.x1 * 256 + r;
        if (u.x0 >= 64) return pos;
        return pos < u.x2 ? ((const PG8_LAS int*)(meta + 2048))[r] : 0;
    }
};
struct Epi6a {
    static constexpr bool PERM = false; static constexpr int NMETA = 3;
    unsigned char* ws;
    __device__ const char* meta_src(const pg8::Unit& u, int i) const {
        const size_t base = (size_t)(u.x0 & 63) * T_TOK + (size_t)u.x1 * 256;
        return i < 2 ? (const char*)(ws + WS_LKW) + base * 8 + i * 1024 : (const char*)(ws + WS_LTOK) + base * 4;
    }
    __device__ __forceinline__ void operator()(const f32x4 (&acc)[2][2][4][2], const pg8::Unit& u, int wr, int wc, int fr_, int fq_, const PG8_LAS unsigned char* meta) const {
        int fr = fr_, fq = fq_; asm volatile("" : "+v"(fr), "+v"(fq));
        if (u.x0 == 65) {
            const bf16_t* proj = (const bf16_t*)(ws + WS_PLE); unsigned char* ple8 = ws + WS_PLE8;
#pragma unroll
            for (int ai = 0; ai < 2; ++ai)
#pragma unroll
                for (int m = 0; m < 4; ++m) {
                    const size_t t = u.pm * 256 + 128 * ai + 64 * wr + 16 * m + fr;
                    const int c0 = u.pn * 256 + 64 * wc + 16 * fq;
                    const u32x4 p0 = *(const u32x4*)(proj + t * DM + c0), p1 = *(const u32x4*)(proj + t * DM + c0 + 8);
                    const unsigned pj[8] = {p0.x, p0.y, p0.z, p0.w, p1.x, p1.y, p1.z, p1.w};
                    unsigned o[4];
#pragma unroll
                    for (int bj = 0; bj < 2; ++bj)
#pragma unroll
                        for (int n = 0; n < 2; ++n) {
                            const f32x4 a = acc[ai][bj][m][n] * GU_DESCALE;
                            const unsigned q0 = pj[4 * bj + 2 * n], q1 = pj[4 * bj + 2 * n + 1];
                            o[2 * bj + n] = pk4_fp8(sigmoidf_(a[0]) * bflo(q0) * PLE_SCALE, sigmoidf_(a[1]) * bfhi(q0) * PLE_SCALE, sigmoidf_(a[2]) * bflo(q1) * PLE_SCALE, sigmoidf_(a[3]) * bfhi(q1) * PLE_SCALE);
                        }
                    u32x4 w; w.x = o[0]; w.y = o[1]; w.z = o[2]; w.w = o[3];
                    *(u32x4*)(ple8 + t * DM + c0) = w;
                    asm volatile("" ::: "memory");
                }
        } else {
            unsigned char* Hb = ws + WS_HBUF;
#pragma unroll
            for (int ai = 0; ai < 2; ++ai)
#pragma unroll
                for (int m = 0; m < 4; ++m) {
                    const int row = 128 * ai + 64 * wr + 16 * m + fr, pos = u.x1 * 256 + row;
                    float w = 1.0f;
                    if (u.x0 < 64) w = pos < u.x2 ? ((const PG8_LAS float*)meta)[2 * row + 1] : 0.f;
                    unsigned char* dst = Hb + ((size_t)u.pm * 256 + row) * EDIM + 128 * u.pn + 32 * wc + 8 * fq;
                    u32x2 wv; w *= H_SCALE * GU_DESCALE;
                    {
                        const f32x4 g = acc[ai][0][m][0] * GU_DESCALE, uu = acc[ai][1][m][0];
                        wv.x = pk4_fp8(siluf_(g[0]) * uu[0] * w, siluf_(g[1]) * uu[1] * w, siluf_(g[2]) * uu[2] * w, siluf_(g[3]) * uu[3] * w);
                    }
                    {
                        const f32x4 g = acc[ai][0][m][1] * GU_DESCALE, uu = acc[ai][1][m][1];
                        wv.y = pk4_fp8(siluf_(g[0]) * uu[0] * w, siluf_(g[1]) * uu[1] * w, siluf_(g[2]) * uu[2] * w, siluf_(g[3]) * uu[3] * w);
                    }
                    *(u32x2*)dst = wv;
                    asm volatile("" ::: "memory");
                }
        }
    }
};
__device__ void phase6a(const Params& p, unsigned char* lds, const int wv_) {
    int* tab = (int*)(lds + P6_TAB_OFF);
    build_blktab((const unsigned*)(p.ws + WS_CTRL), tab, wv_);
    int* ut = (int*)(lds + P6_UT_OFF);
    Sched6a::build(p.ws, tab, ut, wv_);
    Sched6a S; S.ws = p.ws; S.ut = ut;
    Epi6a E; E.ws = p.ws;
    pg8::gemm_phase<Epi6a, Sched6a, true, true, true, true>((PG8_LAS unsigned char*)lds, DM / 2, S, E, wv_);
}

struct Sched6b {
    static constexpr bool VARK = false;
    unsigned char* ws; const int* ut;
    __device__ static void build(const unsigned char* ws, const int* tab, int* ut, const int wv_) {
        if (WV == 0) {
            const int i = lane_id();
            if (i < 16) {
                const int nbr = tab[64], L = unit_index(i), n_r = 4 * nbr, n_s = 4 * NBLK_S;
                int e = -1, hblk = 0, pn = 0, bin = 0, cnt = 0;
                if (L < n_r + n_s) {
                    const int blk = L >> 2; pn = L & 3;
                    if (L < n_r) { e = find_expert(tab, blk); bin = blk - tab[e]; cnt = (int)((const unsigned*)(ws + WS_CTRL))[e * 64]; hblk = blk; }
                    else { e = 64; bin = blk - nbr; cnt = T_TOK; hblk = MAXBLK_R + bin; }
                }
                int* d = ut + 8 * i; d[0] = e; d[1] = hblk; d[2] = pn; d[3] = bin; d[4] = cnt;
            }
        }
        __syncthreads();
    }
    __device__ bool next(int i, pg8::Unit& u) const {
        const pg8::i32x4_t a = *(const pg8::i32x4_t*)(ut + 8 * i); const int cnt = ut[8 * i + 4];
        const int e = rfl(a.x);
        if (e < 0) return false;
        u.pm = rfl(a.y); u.pn = rfl(a.z); u.x0 = e; u.x1 = rfl(a.w); u.x2 = rfl(cnt); u.x3 = 0;
        u.A = (const char*)(ws + WS_HBUF) + (size_t)u.pm * 256 * EDIM; u.B = (const char*)(ws + WS_WDT) + ((size_t)e * 1024 + 256 * u.pn) * EDIM;
        return true;
    }
    __device__ int arow(const pg8::Unit&, int r) const { return r; }
};
struct Epi6b {
    static constexpr bool PERM = false;
    static constexpr int NMETA = 3;
    unsigned char* ws;
    __device__ const char* meta_src(const pg8::Unit& u, int i) const {
        const size_t base = (size_t)(u.x0 & 63) * T_TOK + (size_t)u.x1 * 256;
        return i < 2 ? (const char*)(ws + WS_LKW) + base * 8 + i * 1024 : (const char*)(ws + WS_LTOK) + base * 4;
    }
    __device__ __forceinline__ void operator()(const f32x4 (&acc)[2][2][4][2], const pg8::Unit& u, int wr, int wc, int fr_, int fq_, const PG8_LAS unsigned char* meta) const {
        int fr = fr_, fq = fq_; asm volatile("" : "+v"(fr), "+v"(fq));
        unsigned char* part = ws + WS_PART; unsigned char* sho = ws + WS_SHO;
#pragma unroll
        for (int ai = 0; ai < 2; ++ai)
#pragma unroll
            for (int m = 0; m < 4; ++m) {
                const int row = 128 * ai + 64 * wr + 16 * m + fr, pos = u.x1 * 256 + row;
                const int c0 = u.pn * 256 + 64 * wc + 16 * fq;
                if (u.x0 == 64) {
                    u32x4 w; unsigned wq[4];
#pragma unroll
                    for (int bj = 0; bj < 2; ++bj)
#pragma unroll
                        for (int n = 0; n < 2; ++n) {
                            const f32x4 a = acc[ai][bj][m][n] * (PART_SCALE * D_DESCALE);
                            unsigned x = (unsigned)__builtin_amdgcn_cvt_pk_fp8_f32(a[0], a[1], 0, false); x = (unsigned)__builtin_amdgcn_cvt_pk_fp8_f32(a[2], a[3], (int)x, true);
                            wq[2 * bj + n] = x;
                        }
                    w.x = wq[0]; w.y = wq[1]; w.z = wq[2]; w.w = wq[3];
                    *(u32x4*)(sho + (size_t)pos * DM + c0) = w;
                } else if (pos < u.x2) {
                    const int d = ((const PG8_LAS int*)(meta + 2048))[row] * 8 + ((const PG8_LAS int*)meta)[2 * row];
                    u32x4 w; unsigned wq[4];
#pragma unroll
                    for (int bj = 0; bj < 2; ++bj)
#pragma unroll
                        for (int n = 0; n < 2; ++n) {
                            const f32x4 a = acc[ai][bj][m][n] * (PART_SCALE * D_DESCALE);
                            unsigned x = (unsigned)__builtin_amdgcn_cvt_pk_fp8_f32(a[0], a[1], 0, false); x = (unsigned)__builtin_amdgcn_cvt_pk_fp8_f32(a[2], a[3], (int)x, true);
                            wq[2 * bj + n] = x;
                        }
                    w.x = wq[0]; w.y = wq[1]; w.z = wq[2]; w.w = wq[3];
                    *(u32x4*)(part + (size_t)d * DM + c0) = w;
                }
            }
    }
};
__device__ void phase6b(const Params& p, unsigned char* lds, const int wv_) {
    int* tab = (int*)(lds + P6_TAB_OFF);
    build_blktab((const unsigned*)(p.ws + WS_CTRL), tab, wv_);
    int* ut = (int*)(lds + P6_UT_OFF);
    Sched6b::build(p.ws, tab, ut, wv_);
    Sched6b S; S.ws = p.ws; S.ut = ut;
    Epi6b E; E.ws = p.ws;
    int kk = EDIM / 2; asm volatile("" : "+s"(kk));
    pg8::gemm_phase<Epi6b, Sched6b, false, true, true, true>((PG8_LAS unsigned char*)lds, kk, S, E, wv_);
}

__device__ void phase7(const Params& p, unsigned char* lds, const int wv_) {
    unsigned char* ws = p.ws;
    const int lane = lane_id(), wid = WV;
    const bf16_t* x1b = (const bf16_t*)(ws + WS_X1B); const unsigned char* ple = ws + WS_PLE8; const unsigned char* sho = ws + WS_SHO;
    const unsigned char* part = ws + WS_PART;
    const float* g2 = p.in[18]; const float* b2 = p.in[19];
    typedef float f32x2v __attribute__((ext_vector_type(2)));
    float* rowL = (float*)(lds + wid * 4096);
    for (int t0 = (blockIdx.x * 8 + wid) * 2; t0 < T_TOK; t0 += gridDim.x * 16) {
        u32x4 xr[2][2]; u32x2 pr[2][2], ar[2][2][9];
#pragma unroll
        for (int tt = 0; tt < 2; ++tt)
#pragma unroll
            for (int hf = 0; hf < 2; ++hf) {
                const size_t t = t0 + tt; const int c0 = 512 * hf + 8 * lane;
                xr[tt][hf] = *(const u32x4*)(x1b + t * DM + c0); pr[tt][hf] = *(const u32x2*)(ple + t * DM + c0); ar[tt][hf][8] = *(const u32x2*)(sho + t * DM + c0);
#pragma unroll
                for (int k = 0; k < 8; ++k) ar[tt][hf][k] = *(const u32x2*)(part + (t * 8 + k) * DM + c0);
            }
#pragma unroll
        for (int tt = 0; tt < 2; ++tt) {
            const size_t t = t0 + tt;
            float v[16];
#pragma unroll
            for (int hf = 0; hf < 2; ++hf) {
                float rsum[8];
#pragma unroll
                for (int i = 0; i < 8; ++i) rsum[i] = 0.f;
#pragma unroll
                for (int k = 0; k < 9; ++k) {
                    const u32x2 a = ar[tt][hf][k];
                    const f32x2v l0 = __builtin_amdgcn_cvt_pk_f32_fp8((int)a.x, false), h0 = __builtin_amdgcn_cvt_pk_f32_fp8((int)a.x, true);
                    const f32x2v l1 = __builtin_amdgcn_cvt_pk_f32_fp8((int)a.y, false), h1 = __builtin_amdgcn_cvt_pk_f32_fp8((int)a.y, true);
                    rsum[0] += l0[0]; rsum[1] += l0[1]; rsum[2] += h0[0]; rsum[3] += h0[1]; rsum[4] += l1[0]; rsum[5] += l1[1]; rsum[6] += h1[0]; rsum[7] += h1[1];
                }
                const u32x4 xv = xr[tt][hf]; const u32x2 pv = pr[tt][hf];
                const unsigned xw[4] = {xv.x, xv.y, xv.z, xv.w};
                const f32x2v pl0 = __builtin_amdgcn_cvt_pk_f32_fp8((int)pv.x, false), ph0 = __builtin_amdgcn_cvt_pk_f32_fp8((int)pv.x, true);
                const f32x2v pl1 = __builtin_amdgcn_cvt_pk_f32_fp8((int)pv.y, false), ph1 = __builtin_amdgcn_cvt_pk_f32_fp8((int)pv.y, true);
                const float pf[8] = {pl0[0], pl0[1], ph0[0], ph0[1], pl1[0], pl1[1], ph1[0], ph1[1]};
#pragma unroll
                for (int j = 0; j < 4; ++j) {
                    v[8 * hf + 2 * j]     = ALPHA * bflo(xw[j]) + pf[2 * j] * (1.0f / PLE_SCALE) + rsum[2 * j] * (1.0f / PART_SCALE);
                    v[8 * hf + 2 * j + 1] = ALPHA * bfhi(xw[j]) + pf[2 * j + 1] * (1.0f / PLE_SCALE) + rsum[2 * j + 1] * (1.0f / PART_SCALE);
                }
            }
            float s = 0.f;
#pragma unroll
            for (int i = 0; i < 16; ++i) s += v[i];
            const float mu = wave_sum(s) * (1.0f / 1024.0f);
            float qv = 0.f;
#pragma unroll
            for (int i = 0; i < 16; ++i) { const float d = v[i] - mu; qv += d * d; }
            const float rstd = rsqrtf(wave_sum(qv) * (1.0f / 1024.0f) + 1e-5f);
#pragma unroll
            for (int hf = 0; hf < 2; ++hf)
#pragma unroll
                for (int j = 0; j < 2; ++j) {
                    f32x4 o;
#pragma unroll
                    for (int r = 0; r < 4; ++r) o[r] = (v[8 * hf + 4 * j + r] - mu) * rstd;
                    *(f32x4*)(rowL + 512 * hf + 8 * lane + 4 * j) = o;
                }
#pragma unroll
            for (int i = 0; i < 4; ++i) {
                const int c = 256 * i + 4 * lane;
                const f32x4 y = *(const f32x4*)(rowL + c), gg = *(const f32x4*)(g2 + c), bb = *(const f32x4*)(b2 + c);
                *(f32x4*)(p.out + t * DM + c) = y * gg + bb;
            }
        }
    }
}

#define XB_TMO      128
#define XB_XCNT(j)  (256  + 64 * (j))
#define XB_XSUB(j)  (1280 + 64 * (j))
#define XB_XGEN(j)  (2304 + 64 * (j))
#define XB_TOP      3328
#define XB_TOPGEN   3392
#define XCD_BAR_WORDS 3456
#define XB_SPIN_CAP (1u << 18)
#define LAS __attribute__((address_space(3)))
__device__ __forceinline__ unsigned xb_ld(unsigned* p)              { return __hip_atomic_load(p, __ATOMIC_RELAXED, __HIP_MEMORY_SCOPE_AGENT); }
__device__ __forceinline__ unsigned xb_add(unsigned* p, unsigned v) { return __hip_atomic_fetch_add(p, v, __ATOMIC_RELAXED, __HIP_MEMORY_SCOPE_AGENT); }
__device__ __forceinline__ unsigned xb_xcc_id() { return (unsigned)__builtin_amdgcn_s_getreg((3 << 11) | 20) & 0xFu; }
#define XB_SPIN(cond, bar) do { unsigned _sp = 0; while (cond) { __builtin_amdgcn_s_sleep(1); \
    if ((++_sp & 255u) == 0u) { if (xb_ld(&(bar)[XB_TMO])) break; if (_sp > XB_SPIN_CAP) { atomicAdd(&(bar)[XB_TMO], 1u); break; } } } } while (0)
struct XcdBarrier { unsigned* bar; unsigned x; volatile LAS unsigned* st; };
__device__ __forceinline__ XcdBarrier xcd_barrier_post(unsigned* bar, volatile LAS unsigned* st, const int wv_) {
    XcdBarrier b; b.bar = bar; b.x = xb_xcc_id(); b.st = st;
    if (WV == 0 && lane_id() == 0) (void)xb_add(&bar[XB_XCNT(b.x)], 1u);
    return b;
}
__device__ __forceinline__ void xcd_barrier_complete(unsigned* bar, unsigned x, unsigned& nloc, unsigned& nx) {
    const unsigned G = gridDim.x * gridDim.y * gridDim.z;
    unsigned sum, cnt, mine, sp = 0u;
    for (;;) {
        sum = 0u; cnt = 0u; mine = 0u;
#pragma unroll
        for (unsigned j = 0; j < 16; ++j) { const unsigned c = xb_ld(&bar[XB_XCNT(j)]); sum += c; cnt += (c > 0u) ? 1u : 0u; mine = (j == x) ? c : mine; }
        if (sum == G) break;
        __builtin_amdgcn_s_sleep(1);
        if ((++sp & 255u) == 0u) { if (xb_ld(&bar[XB_TMO])) break; if (sp > XB_SPIN_CAP) { atomicAdd(&bar[XB_TMO], 1u); break; } }
    }
    nloc = mine > 0u ? mine : 1u; nx = cnt > 0u ? cnt : 1u;
}
__device__ __forceinline__ void xcd_barrier(const XcdBarrier& b, const int wv_) {
    asm volatile("s_waitcnt vmcnt(0)" ::: "memory");
    __syncthreads();
    if (WV == 0 && lane_id() == 0) {
        unsigned* bar = b.bar;
        __builtin_amdgcn_s_waitcnt(0);
        unsigned nloc = b.st[0], nx = b.st[1];
        if (nloc == 0u) { xcd_barrier_complete(bar, b.x, nloc, nx); b.st[0] = nloc; b.st[1] = nx; }
        const unsigned old = xb_add(&bar[XB_XSUB(b.x)], 1u);
        const unsigned gen = old / nloc;
        if (old + 1u == (gen + 1u) * nloc) {
            __builtin_amdgcn_fence(__ATOMIC_RELEASE, "agent");
            asm volatile("s_waitcnt vmcnt(0)" ::: "memory");
            const unsigned og = xb_add(&bar[XB_TOP], 1u);
            const unsigned tg = og / nx;
            if (og + 1u == (tg + 1u) * nx) xb_add(&bar[XB_TOPGEN], 1u);
            else XB_SPIN(xb_ld(&bar[XB_TOPGEN]) == tg, bar);
            __builtin_amdgcn_fence(__ATOMIC_ACQUIRE, "agent");
            xb_add(&bar[XB_XGEN(b.x)], 1u);
            asm volatile("s_waitcnt vmcnt(0)" ::: "memory");
        } else {
            XB_SPIN(xb_ld(&bar[XB_XGEN(b.x)]) == gen, bar);
            __builtin_amdgcn_fence(__ATOMIC_ACQUIRE, "agent");
            asm volatile("s_waitcnt vmcnt(0)" ::: "memory");
        }
    }
    __syncthreads();
}

constexpr int LDS_TOTAL = 152 * 1024;
constexpr int NPHASE = 8;

constexpr size_t CTRL_BAR_OFF = 65536;
constexpr size_t CTRL_ZERO_BYTES = 131072;

__global__ void __launch_bounds__(NTHREADS) mega_kernel(Params p) {
    extern __shared__ __attribute__((aligned(16))) unsigned char smem[];
    const int wv_ = __builtin_amdgcn_readfirstlane((int)(threadIdx.x >> 6));
    volatile LAS unsigned* bst = (volatile LAS unsigned*)(smem + LDS_TOTAL - 16);
    XcdBarrier xb;
    if (p.sync) {
        if (WV == 0 && lane_id() == 0) { bst[0] = 0u; bst[1] = 0u; }
        __syncthreads();
        xb = xcd_barrier_post((unsigned*)(p.ws + WS_CTRL + CTRL_BAR_OFF), bst, wv_);
    }
#define RUN_PHASE(i, call) if (p.ph_lo <= (i) && (i) < p.ph_hi) { call; if (p.sync && (i) + 1 < p.ph_hi) { xcd_barrier(xb, wv_); } }
    RUN_PHASE(0, phase0(p, smem, wv_))
    RUN_PHASE(1, phase1(p, smem, wv_))
    RUN_PHASE(2, phase2(p, smem, wv_))
    RUN_PHASE(3, phase3(p, smem, wv_))
    RUN_PHASE(4, phase4(p, smem, wv_))
    RUN_PHASE(5, phase6a(p, smem, wv_))
    RUN_PHASE(6, phase6b(p, smem, wv_))
    RUN_PHASE(7, phase7(p, smem, wv_))
#undef RUN_PHASE
}

extern "C" void kernel_launch(void* const* d_in, const int* in_sizes, int n_in, void* d_out, int out_size, void* d_ws, size_t ws_size, hipStream_t stream) {
    static int grid_blocks = 0;
    if (grid_blocks == 0) {
        if (n_in != 20 || ws_size < WS_END) { fprintf(stderr, "kernel_launch: unexpected n_in %d / ws_size %zu (need %zu)\n", n_in, ws_size, (size_t)WS_END); grid_blocks = -1; return; }
        int dev = 0, cus = 0, per_cu = 0;
        hipGetDevice(&dev);
        hipDeviceGetAttribute(&cus, hipDeviceAttributeMultiprocessorCount, dev);
        if (hipFuncSetAttribute((const void*)mega_kernel, hipFuncAttributeMaxDynamicSharedMemorySize, LDS_TOTAL) != hipSuccess) { fprintf(stderr, "kernel_launch: hipFuncSetAttribute failed\n"); grid_blocks = -1; return; }
        if (hipOccupancyMaxActiveBlocksPerMultiprocessor(&per_cu, (const void*)mega_kernel, NTHREADS, LDS_TOTAL) != hipSuccess || per_cu < 1) { fprintf(stderr, "kernel_launch: occupancy query failed (%d)\n", per_cu); per_cu = 1; }
        (void)hipGetLastError();
        if (per_cu > 1) per_cu = 1;
        grid_blocks = cus * per_cu;
    }
    if (grid_blocks < 0) return;
    (void)hipMemsetAsync((char*)d_ws + WS_CTRL, 0, CTRL_ZERO_BYTES, stream);
    Params p{};
    for (int i = 0; i < 20; ++i) p.in[i] = (const float*)d_in[i];
    p.out = (float*)d_out; p.ws = (unsigned char*)d_ws;
#if MK_SINGLE
    p.ph_lo = 0; p.ph_hi = NPHASE; p.sync = 1;
    void* args[] = {&p};
    hipError_t e = hipLaunchCooperativeKernel((const void*)mega_kernel, dim3(grid_blocks), dim3(NTHREADS), args, LDS_TOTAL, stream);
    if (e != hipSuccess) fprintf(stderr, "cooperative launch failed: %s (grid %d)\n", hipGetErrorString(e), grid_blocks);
#else
    for (int ph = 0; ph < NPHASE; ++ph) {
        p.ph_lo = ph; p.ph_hi = ph + 1; p.sync = 0;
        hipLaunchKernelGGL(mega_kernel, dim3(grid_blocks), dim3(NTHREADS), LDS_TOTAL, stream, p);
#ifdef PROBE_REPEAT
        if (ph == PROBE_REPEAT) {
            for (int rep = 0; rep < 2; ++rep) {
                if (ph == 4 || ph == 2) (void)hipMemsetAsync((char*)d_ws + WS_CTRL, 0, 16384, stream);
                hipLaunchKernelGGL(mega_kernel, dim3(grid_blocks), dim3(NTHREADS), LDS_TOTAL, stream, p);
            }
        }
#endif
    }
#endif
}
```

```cpp
#include <hip/hip_runtime.h>
#include <hip/hip_cooperative_groups.h>
#include <cstdio>
#include <cstdint>
#include <cmath>
namespace cg = cooperative_groups;

#ifndef MK_SINGLE
#define MK_SINGLE 1
#endif

typedef unsigned short bf16_t;
typedef short bf16x8 __attribute__((ext_vector_type(8)));
typedef short bf16x4 __attribute__((ext_vector_type(4)));
typedef float f32x4 __attribute__((ext_vector_type(4)));
typedef unsigned u32x4 __attribute__((ext_vector_type(4)));
typedef unsigned u32x2 __attribute__((ext_vector_type(2)));

constexpr int T_TOK = 16384, DM = 1024, SEQ = 4096, NB_ = 4, PLE = 256;
constexpr int NPROJ = 3584, NEXP = 64, EDIM = 256, TOPK = 8;
constexpr int NTHREADS = 512;
constexpr float ALPHA = 1.189207115002721f;
constexpr float LOG2E = 1.4426950408889634f;
constexpr float PART_SCALE = 8.0f;
constexpr float WGU_SCALE = 32.0f, X1_SCALE = 4.0f, GU_DESCALE = 1.0f / (32.0f * 4.0f);
constexpr float H_SCALE = 8.0f, WD_SCALE = 32.0f, D_DESCALE = 1.0f / (8.0f * 32.0f);
constexpr float MIX_SCALE = 16.0f, WO_SCALE = 64.0f, O_DESCALE = 1.0f / (16.0f * 64.0f);
constexpr float PLE_SCALE = 16.0f;
constexpr float X8_SCALE = 8.0f, WIN8_SCALE = 32.0f, NA_DESCALE = 1.0f / (8.0f * 32.0f);
constexpr float P8_SCALE = 8.0f, WP8_SCALE = 32.0f, PLEP_DESCALE = 1.0f / (8.0f * 32.0f);
constexpr int MAXBLK_R = 576;
constexpr int NBLK_S = 64;

constexpr size_t MiB = 1024ull * 1024ull;
constexpr size_t WS_WDT   = 0;
constexpr size_t WS_CTRL  = 33 * MiB;
constexpr size_t WS_WRF   = 33 * MiB + 262144;
constexpr size_t WS_LGT   = 33 * MiB + 61440;
constexpr size_t WS_LTOK  = 34 * MiB;
constexpr size_t WS_LKW   = 38 * MiB;
constexpr size_t WS_ROPE  = 46 * MiB;
constexpr size_t WS_X1B   = 48 * MiB;
constexpr size_t WS_PLE   = 80 * MiB;
constexpr size_t WS_WPT   = 112 * MiB;
constexpr size_t WS_PB    = 113 * MiB;
constexpr size_t WS_HBUF  = 121 * MiB;
constexpr size_t WS_PART  = 201 * MiB;
constexpr size_t WS_SHO   = 329 * MiB;
constexpr size_t WS_PLE8  = 345 * MiB;
constexpr size_t WS_WGUT  = 201 * MiB;
constexpr size_t WS_WGATE = 266 * MiB;
constexpr size_t WS_WINT  = 268 * MiB;
constexpr size_t WS_WOUTT = 275 * MiB;
constexpr size_t WS_XB    = 277 * MiB;
constexpr size_t WS_X1F8  = 277 * MiB;
constexpr size_t WS_Q     = 309 * MiB;
constexpr size_t WS_K     = 325 * MiB;
constexpr size_t WS_KT    = 341 * MiB;
constexpr size_t WS_VT    = 357 * MiB;
constexpr size_t WS_G     = 373 * MiB;
constexpr size_t WS_NQ    = 389 * MiB;
constexpr size_t WS_NK    = 405 * MiB;
constexpr size_t WS_NVT   = 421 * MiB;
constexpr size_t WS_SST   = 437 * MiB;
constexpr size_t WS_MIX   = 469 * MiB;
constexpr size_t WS_X8    = 469 * MiB;
constexpr size_t WS_WIN8  = 485 * MiB;
constexpr size_t WS_END   = 501 * MiB;

__constant__ double INV_FREQ[32] = {1.0, 0.7498942093324559, 0.5623413251903491, 0.4216965034285822, 0.31622776601683794, 0.23713737056616552, 0.1778279410038923, 0.1333521432163324, 0.1, 0.07498942093324558, 0.05623413251903491, 0.042169650342858224, 0.03162277660168379, 0.023713737056616554, 0.01778279410038923, 0.01333521432163324, 0.01, 0.007498942093324558, 0.005623413251903491, 0.004216965034285823, 0.0031622776601683794, 0.0023713737056616554, 0.0017782794100389228, 0.001333521432163324, 0.001, 0.0007498942093324559, 0.0005623413251903491, 0.00042169650342858224, 0.00031622776601683794, 0.00023713737056616554, 0.00017782794100389227, 0.0001333521432163324};
struct Params {
    const float* in[20];
    float* out;
    unsigned char* ws;
    int ph_lo, ph_hi, sync, pad;
};

__device__ __forceinline__ unsigned cvt_pk_bf16(float lo, float hi) { unsigned r; asm volatile("v_cvt_pk_bf16_f32 %0, %1, %2" : "=v"(r) : "v"(lo), "v"(hi)); return r; }
__device__ __forceinline__ float bf2f(unsigned short v) { return __uint_as_float(((unsigned)v) << 16); }
__device__ __forceinline__ float bflo(unsigned v) { return __uint_as_float(v << 16); }
__device__ __forceinline__ float bfhi(unsigned v) { return __uint_as_float(v & 0xffff0000u); }
__device__ __forceinline__ unsigned short f2bf(float f) { return (unsigned short)(cvt_pk_bf16(f, 0.f) & 0xffffu); }
__device__ __forceinline__ float fast_exp2(float x) { return __builtin_amdgcn_exp2f(x); }
__device__ __forceinline__ float sigmoidf_(float x) { return __builtin_amdgcn_rcpf(1.0f + __expf(-x)); }
__device__ __forceinline__ float siluf_(float x) { return x * __builtin_amdgcn_rcpf(1.0f + __expf(-x)); }
__device__ __forceinline__ float wave_sum(float v) {
#pragma unroll
    for (int o = 32; o >= 1; o >>= 1) v += __shfl_xor(v, o);
    return v;
}
__device__ __forceinline__ int rfl(int v) { return __builtin_amdgcn_readfirstlane(v); }
__device__ __forceinline__ size_t rfl64(size_t v) { return ((size_t)(unsigned)__builtin_amdgcn_readfirstlane((int)(v >> 32)) << 32) | (size_t)(unsigned)__builtin_amdgcn_readfirstlane((int)(unsigned)v); }
#define WV wv_
__device__ __forceinline__ int lane_id() { return (int)__builtin_amdgcn_mbcnt_hi(~0u, __builtin_amdgcn_mbcnt_lo(~0u, 0u)); }
__device__ __forceinline__ float readlane_f(float v, int l) { return __uint_as_float((unsigned)__builtin_amdgcn_readlane((int)__float_as_uint(v), l)); }
__device__ __forceinline__ float shx(float v, int m, int lane_) { return __uint_as_float((unsigned)__builtin_amdgcn_ds_bpermute((lane_ ^ m) << 2, (int)__float_as_uint(v))); }
__device__ __forceinline__ float wave_sum_l(float v, int lane_) {
#pragma unroll
    for (int o = 32; o >= 1; o >>= 1) v += shx(v, o, lane_);
    return v;
}
#define MFMA16(a, b, c) __builtin_amdgcn_mfma_f32_16x16x32_bf16((a), (b), (c), 0, 0, 0)

namespace pg8 {
#define PG8_LAS __attribute__((address_space(3)))
constexpr int BM = 256, BK = 64, HALF = 128, HTB = HALF * BK * 2, STAGE_BYTES = 8 * HTB, NXCD = 8, WGM = 8;
constexpr int PG8_META_OFF = STAGE_BYTES + 2048;
__host__ __device__ __forceinline__ int lds_byte(int r, int c) { const int st = (r >> 4) * 2 + (c >> 5), rr = r & 15, cc = c & 31, ob = rr * 64 + cc * 2; return st * 1024 + (ob ^ (((ob >> 9) & 1) << 5)); }
__host__ __device__ __forceinline__ void stage_rc(int b, int& R, int& C) { const int st = b / 1024, sb = b % 1024, swz = sb ^ (((sb >> 9) & 1) << 5); R = (st >> 1) * 16 + swz / 64; C = (st & 1) * 32 + (swz % 64) / 2; }
__host__ __device__ __forceinline__ int perm32(int rho) { const int n = rho >> 4, i = rho & 15; return 8 * (i >> 2) + 4 * n + (i & 3); }

typedef int i32x4_t __attribute__((ext_vector_type(4)));
typedef int i32x8_t __attribute__((ext_vector_type(8)));
__device__ __forceinline__ i32x8_t cat8(const bf16x8& a, const bf16x8& b) { return __builtin_shufflevector(__builtin_bit_cast(i32x4_t, a), __builtin_bit_cast(i32x4_t, b), 0, 1, 2, 3, 4, 5, 6, 7); }
struct Unit { const char* A; const char* B; int pm, pn, x0, x1, x2, x3; };

struct TileOrder {
    int nM, nN, nwg;
    __device__ void init(int M, int N) { nM = M / BM; nN = N / BM; nwg = nM * nN; }
    __device__ bool map(long L, int& pm, int& pn) const {
        if (L >= nwg) return false;
        int wgid = (int)L; { const int q = nwg / NXCD, r = nwg % NXCD, xcd = wgid % NXCD, off = wgid / NXCD; wgid = (xcd < r ? xcd * (q + 1) : r * (q + 1) + (xcd - r) * q) + off; }
        const int nig = WGM * nN, gid = wgid / nig, fm = gid * WGM, gsz = (nM - fm) < WGM ? (nM - fm) : WGM;
        pm = fm + ((wgid % nig) % gsz); pn = (wgid % nig) / gsz; return true;
    }
};

template <class Epi, class Sched, bool GATHER, bool ALIGN_EPI, bool SP2, bool FP8 = false>
__device__ __forceinline__ void gemm_phase(PG8_LAS unsigned char* lds, const int K, const Sched& S, const Epi& E, const int wv_) {
    const int wid = WV, lane = lane_id(), tid = wid * 64 + lane, wr = wid >> 2, wc = wid & 3, fr = lane & 15, fq = lane >> 4;
    unsigned vA[2][2], vN[2][2], vB[2][2];
#pragma unroll
    for (int i = 0; i < 2; ++i) { int R, C; stage_rc(tid * 16 + i * 8192, R, C); const int Rb = Epi::PERM ? ((R & ~31) + perm32(R & 31)) : R;
#pragma unroll
        for (int h = 0; h < 2; ++h) { vA[h][i] = (unsigned)((R + 128 * h) * K + C) * 2u; vN[h][i] = vA[h][i]; vB[h][i] = (unsigned)((Rb + 128 * h) * K + C) * 2u; } }
    const size_t kstep = (size_t)(BK * 2);
    const unsigned ldsw = (unsigned)wid * 1024u;
    const int aoff = lds_byte(wr * 64 + fr, fq * 8), boff = lds_byte(wc * 32 + fr, fq * 8);
#define PG8_SA(b, h) (((b) * 2 + (h)) * HTB)
#define PG8_SB(b, h) ((4 + (b) * 2 + (h)) * HTB)
#define PG8_STAGE(bufoff, gbase, voff) do { _Pragma("unroll") for (int _i = 0; _i < 2; ++_i) \
        __builtin_amdgcn_global_load_lds((const unsigned*)((const char*)(gbase) + (voff)[_i]), (PG8_LAS unsigned*)(lds + (bufoff) + ldsw + _i * 8192), 16, 0, 0); } while (0)
#define PG8_LDA(dst, b, h) do { _Pragma("unroll") for (int m = 0; m < 4; ++m) _Pragma("unroll") for (int k = 0; k < 2; ++k) dst[m][k] = *(const PG8_LAS bf16x8*)(lds + PG8_SA(b, h) + aoff + m * 2048 + k * 1024); } while (0)
#define PG8_LDB(dst, b, h) do { _Pragma("unroll") for (int n = 0; n < 2; ++n) _Pragma("unroll") for (int k = 0; k < 2; ++k) dst[n][k] = *(const PG8_LAS bf16x8*)(lds + PG8_SB(b, h) + boff + n * 2048 + k * 1024); } while (0)
#define PG8_MMA(ai, bj, At, Bt) do { __builtin_amdgcn_s_setprio(1); _Pragma("unroll") for (int m = 0; m < 4; ++m) _Pragma("unroll") for (int n = 0; n < 2; ++n) { \
        if constexpr (FP8) { const i32x8_t _b8 = cat8(Bt[n][0], Bt[n][1]), _a8 = cat8(At[m][0], At[m][1]); asm volatile("v_mfma_f32_16x16x128_f8f6f4 %0, %1, %2, %0" : "+v"(acc[ai][bj][m][n]) : "v"(_b8), "v"(_a8)); } \
        else { _Pragma("unroll") for (int k = 0; k < 2; ++k) acc[ai][bj][m][n] = __builtin_amdgcn_mfma_f32_16x16x32_bf16(Bt[n][k], At[m][k], acc[ai][bj][m][n], 0, 0, 0); } } __builtin_amdgcn_s_setprio(0); } while (0)
#define PG8_MMA0(ai, bj, At, Bt) do { __builtin_amdgcn_s_setprio(1); _Pragma("unroll") for (int m = 0; m < 4; ++m) _Pragma("unroll") for (int n = 0; n < 2; ++n) { \
        const i32x8_t _b8 = cat8(Bt[n][0], Bt[n][1]), _a8 = cat8(At[m][0], At[m][1]); asm volatile("v_mfma_f32_16x16x128_f8f6f4 %0, %1, %2, 0" : "=&v"(acc[ai][bj][m][n]) : "v"(_b8), "v"(_a8)); } __builtin_amdgcn_s_setprio(0); } while (0)
#define PG8_WAIT_V(n) asm volatile("s_waitcnt vmcnt(" #n ")" ::: "memory")
#define PG8_WAIT_L(n) asm volatile("s_waitcnt lgkmcnt(" #n ")" ::: "memory")
#define PG8_BAR __builtin_amdgcn_s_barrier()
#define PG8_SCHED __builtin_amdgcn_sched_barrier(0)
#define PG8_ROWS(dst, unit) do { if constexpr (GATHER) { _Pragma("unroll") for (int _i = 0; _i < 2; ++_i) { int _R, _C; stage_rc(tid * 16 + _i * 8192, _R, _C); \
        _Pragma("unroll") for (int _h = 0; _h < 2; ++_h) dst[_h][_i] = (unsigned)(S.arow(unit, _R + 128 * _h) * K + _C) * 2u; } } } while (0)
    Unit cur, nxt; int ui = 0;
    if (!S.next(0, cur)) return;
    PG8_ROWS(vA, cur);
    if constexpr (Sched::VARK) { const int _K = cur.x3;
#pragma unroll
        for (int _i = 0; _i < 2; ++_i) { int _R, _C; stage_rc(tid * 16 + _i * 8192, _R, _C); const int _Rb = Epi::PERM ? ((_R & ~31) + perm32(_R & 31)) : _R;
#pragma unroll
            for (int _h = 0; _h < 2; ++_h) { vA[_h][_i] = (unsigned)((_R + 128 * _h) * _K + _C) * 2u; vB[_h][_i] = (unsigned)((_Rb + 128 * _h) * _K + _C) * 2u; } } }
#define PG8_META(unit, slot) do { if constexpr (Epi::NMETA > 0) { if (wid < Epi::NMETA) \
        __builtin_amdgcn_global_load_lds((const unsigned*)(E.meta_src(unit, wid) + lane * 16), (PG8_LAS unsigned*)(lds + PG8_META_OFF + (slot) * 4096 + wid * 1024), 16, 0, 0); } } while (0)
    PG8_META(cur, 0);
    f32x4 acc[2][2][4][2];
    if constexpr (!(FP8 && SP2))
#pragma unroll
    for (int a = 0; a < 2; ++a)
#pragma unroll
        for (int b = 0; b < 2; ++b)
#pragma unroll
            for (int m = 0; m < 4; ++m)
#pragma unroll
                for (int n = 0; n < 2; ++n) acc[a][b][m][n] = (f32x4){0.f, 0.f, 0.f, 0.f};
    bf16x8 At[4][2], B0[2][2], B1[2][2];
    const char* cA = cur.A; const char* cB = cur.B;
    if constexpr (SP2) {
        PG8_STAGE(PG8_SB(0, 0), cB, vB[0]); PG8_STAGE(PG8_SB(0, 1), cB, vB[1]); PG8_STAGE(PG8_SA(0, 0), cA, vA[0]); PG8_STAGE(PG8_SA(0, 1), cA, vA[1]);
        if (wr == 1) PG8_BAR;
        PG8_WAIT_V(2); PG8_BAR;
        PG8_STAGE(PG8_SB(1, 0), cB + kstep, vB[0]); PG8_STAGE(PG8_SA(1, 0), cA + kstep, vA[0]); PG8_STAGE(PG8_SB(1, 1), cB + kstep, vB[1]);
        PG8_WAIT_V(6); PG8_BAR;
    } else {
        PG8_STAGE(PG8_SB(0, 0), cB, vB[0]); PG8_STAGE(PG8_SA(0, 0), cA, vA[0]); PG8_STAGE(PG8_SB(0, 1), cB, vB[1]); PG8_STAGE(PG8_SA(0, 1), cA, vA[1]);
        if (wr == 1) PG8_BAR;
        PG8_WAIT_V(4); PG8_BAR;
        PG8_STAGE(PG8_SB(1, 0), cB + kstep, vB[0]); PG8_STAGE(PG8_SA(1, 0), cA + kstep, vA[0]); PG8_STAGE(PG8_SB(1, 1), cB + kstep, vB[1]);
        PG8_WAIT_V(6); PG8_BAR;
    }
    for (;;) {
        const bool has_next = S.next(ui + 1, nxt);
        if (has_next) { PG8_META(nxt, (ui + 1) % 3); }
        const char* nA = has_next ? nxt.A : cA; const char* nB = has_next ? nxt.B : cB;
        const int nt = (Sched::VARK ? cur.x3 : K) / BK;
#pragma unroll 1
        for (int t = 0; t < nt; t += 2) {
            const bool last = (t == nt - 2);
            const char* a1 = cA + (size_t)(t + 1) * kstep;
            const char* a2 = last ? nA : cA + (size_t)(t + 2) * kstep; const char* b2 = last ? nB : cB + (size_t)(t + 2) * kstep;
            const char* a3 = a2 + kstep; const char* b3 = b2 + kstep;
            if constexpr (SP2) {
            PG8_LDB(B0, 0, 0); PG8_LDB(B1, 0, 1); PG8_SCHED; PG8_LDA(At, 0, 0); PG8_STAGE(PG8_SA(1, 1), a1, vA[1]);
            if constexpr (GATHER) { if (last && has_next) { const PG8_LAS unsigned char* _mt = (const PG8_LAS unsigned char*)(lds + PG8_META_OFF + ((ui + 1) % 3) * 4096); \
                _Pragma("unroll") for (int _i = 0; _i < 2; ++_i) { int _R, _C; stage_rc(tid * 16 + _i * 8192, _R, _C); \
                _Pragma("unroll") for (int _h = 0; _h < 2; ++_h) vA[_h][_i] = (unsigned)(S.arow_lds(nxt, _R + 128 * _h, _mt) * K + _C) * 2u; } } } \
            if constexpr (Sched::VARK) { if (last && has_next) { const int _K = nxt.x3; \
                _Pragma("unroll") for (int _i = 0; _i < 2; ++_i) { int _R, _C; stage_rc(tid * 16 + _i * 8192, _R, _C); const int _Rb = Epi::PERM ? ((_R & ~31) + perm32(_R & 31)) : _R; \
                _Pragma("unroll") for (int _h = 0; _h < 2; ++_h) { vA[_h][_i] = (unsigned)((_R + 128 * _h) * _K + _C) * 2u; vB[_h][_i] = (unsigned)((_Rb + 128 * _h) * _K + _C) * 2u; } } } }
            PG8_WAIT_V(8); PG8_WAIT_L(0); PG8_BAR; if (FP8 && t == 0) { PG8_MMA0(0, 0, At, B0); PG8_MMA0(0, 1, At, B1); } else { PG8_MMA(0, 0, At, B0); PG8_MMA(0, 1, At, B1); } PG8_BAR; PG8_SCHED;
            PG8_LDA(At, 0, 1); PG8_STAGE(PG8_SB(0, 0), b2, vB[0]); PG8_STAGE(PG8_SB(0, 1), b2, vB[1]); PG8_STAGE(PG8_SA(0, 0), a2, vA[0]);
            PG8_WAIT_V(8); PG8_WAIT_L(0); PG8_BAR; if (FP8 && t == 0) { PG8_MMA0(1, 0, At, B0); PG8_MMA0(1, 1, At, B1); } else { PG8_MMA(1, 0, At, B0); PG8_MMA(1, 1, At, B1); } PG8_BAR; PG8_SCHED;
            PG8_LDB(B0, 1, 0); PG8_LDB(B1, 1, 1); PG8_SCHED; PG8_LDA(At, 1, 0); PG8_STAGE(PG8_SA(0, 1), a2, vA[1]);
            PG8_WAIT_V(8); PG8_WAIT_L(0); PG8_BAR; PG8_MMA(0, 0, At, B0); PG8_MMA(0, 1, At, B1); PG8_BAR; PG8_SCHED;
            PG8_LDA(At, 1, 1); PG8_STAGE(PG8_SB(1, 0), b3, vB[0]); PG8_STAGE(PG8_SB(1, 1), b3, vB[1]); PG8_STAGE(PG8_SA(1, 0), a3, vA[0]);
            PG8_WAIT_V(8); PG8_WAIT_L(0); PG8_BAR; PG8_MMA(1, 0, At, B0); PG8_MMA(1, 1, At, B1); PG8_BAR; PG8_SCHED;
            } else {
            PG8_LDB(B0, 0, 0); PG8_SCHED; PG8_LDA(At, 0, 0); PG8_STAGE(PG8_SA(1, 1), a1, vA[1]);
            if constexpr (GATHER) { if (last && has_next) { const PG8_LAS unsigned char* _mt = (const PG8_LAS unsigned char*)(lds + PG8_META_OFF + ((ui + 1) % 3) * 4096); \
                _Pragma("unroll") for (int _i = 0; _i < 2; ++_i) { int _R, _C; stage_rc(tid * 16 + _i * 8192, _R, _C); \
                _Pragma("unroll") for (int _h = 0; _h < 2; ++_h) vA[_h][_i] = (unsigned)(S.arow_lds(nxt, _R + 128 * _h, _mt) * K + _C) * 2u; } } } \
            if constexpr (Sched::VARK) { if (last && has_next) { const int _K = nxt.x3; \
                _Pragma("unroll") for (int _i = 0; _i < 2; ++_i) { int _R, _C; stage_rc(tid * 16 + _i * 8192, _R, _C); const int _Rb = Epi::PERM ? ((_R & ~31) + perm32(_R & 31)) : _R; \
                _Pragma("unroll") for (int _h = 0; _h < 2; ++_h) { vA[_h][_i] = (unsigned)((_R + 128 * _h) * _K + _C) * 2u; vB[_h][_i] = (unsigned)((_Rb + 128 * _h) * _K + _C) * 2u; } } } }
            PG8_WAIT_L(8); PG8_BAR; PG8_WAIT_L(0); PG8_MMA(0, 0, At, B0); PG8_BAR; PG8_SCHED;
            PG8_LDB(B1, 0, 1); PG8_STAGE(PG8_SB(0, 0), b2, vB[0]);
            PG8_BAR; PG8_WAIT_L(0); PG8_MMA(0, 1, At, B1); PG8_BAR;
            PG8_LDA(At, 0, 1); PG8_STAGE(PG8_SA(0, 0), a2, vA[0]);
            PG8_BAR; PG8_WAIT_L(0); PG8_MMA(1, 0, At, B0); PG8_BAR; PG8_SCHED;
            PG8_STAGE(PG8_SB(0, 1), b2, vB[1]);
            PG8_WAIT_V(6); PG8_BAR; PG8_MMA(1, 1, At, B1); PG8_BAR;
            PG8_LDB(B0, 1, 0); PG8_SCHED; PG8_LDA(At, 1, 0); PG8_STAGE(PG8_SA(0, 1), a2, vA[1]);
            PG8_WAIT_L(8); PG8_BAR; PG8_WAIT_L(0); PG8_MMA(0, 0, At, B0); PG8_BAR; PG8_SCHED;
            PG8_LDB(B1, 1, 1); PG8_STAGE(PG8_SB(1, 0), b3, vB[0]);
            PG8_BAR; PG8_WAIT_L(0); PG8_MMA(0, 1, At, B1); PG8_BAR;
            PG8_LDA(At, 1, 1); PG8_STAGE(PG8_SA(1, 0), a3, vA[0]);
            PG8_BAR; PG8_WAIT_L(0); PG8_MMA(1, 0, At, B0); PG8_BAR; PG8_SCHED;
            PG8_STAGE(PG8_SB(1, 1), b3, vB[1]);
            PG8_WAIT_V(6); PG8_BAR; PG8_MMA(1, 1, At, B1); PG8_BAR;
            }
        }
        if constexpr (FP8) asm volatile("s_nop 15" ::: "memory");
        if constexpr (ALIGN_EPI) { if (wr == 0) PG8_BAR; }
        E(acc, cur, wr, wc, fr, fq, (const PG8_LAS unsigned char*)(lds + PG8_META_OFF + (ui % 3) * 4096));
        if (!has_next) break;
        if constexpr (!(FP8 && SP2))
#pragma unroll
        for (int a = 0; a < 2; ++a)
#pragma unroll
            for (int b = 0; b < 2; ++b)
#pragma unroll
                for (int m = 0; m < 4; ++m)
#pragma unroll
                    for (int n = 0; n < 2; ++n) acc[a][b][m][n] = (f32x4){0.f, 0.f, 0.f, 0.f};
        cur = nxt; cA = nA; cB = nB; ++ui;
        if constexpr (ALIGN_EPI) { if (wr == 1) PG8_BAR; }
    }
    PG8_WAIT_V(0);
    if constexpr (!ALIGN_EPI) { if (wr == 0) PG8_BAR; }
    PG8_BAR;
#undef PG8_SA
#undef PG8_SB
#undef PG8_STAGE
#undef PG8_LDA
#undef PG8_LDB
#undef PG8_MMA
#undef PG8_WAIT_V
#undef PG8_WAIT_L
#undef PG8_BAR
#undef PG8_SCHED
#undef PG8_ROWS
#undef PG8_META
}
}

__device__ __forceinline__ int rowmap(int mode, int col) {
    if (mode == 1) {
        const int l = col & 255, hl = l >> 6, d = l & 63;
        return (col & ~255) + 128 * (hl >> 1) + 32 * (2 * (hl & 1) + ((d >> 4) & 1)) + 16 * (d >> 5) + (d & 15);
    } else if (mode == 2) {
        const int isU = col >> 8, j = col & 255, pn = j >> 7, jl = j & 127;
        return 256 * pn + 128 * isU + 32 * (jl >> 5) + 16 * ((jl >> 2) & 1) + 4 * ((jl >> 3) & 3) + (jl & 3);
    } else if (mode == 4) {
        const int l = col & 255, wc = l >> 6, fq = (l >> 4) & 3, bj = (l >> 3) & 1, n = (l >> 2) & 1, r = l & 3;
        return (col & ~255) + 128 * bj + 32 * wc + 16 * n + 4 * fq + r;
    } else if (mode == 3) {
        const int x = col & 127, pair = x >> 5, y = x & 31;
        return (col & ~127) + 16 * (2 * pair + ((y >> 2) & 1)) + 4 * (y >> 3) + (y & 3);
    }
    return col;
}
__device__ __forceinline__ unsigned pk4_fp8(float a, float b, float c, float d) {
    a = fminf(fmaxf(a, -448.f), 448.f); b = fminf(fmaxf(b, -448.f), 448.f); c = fminf(fmaxf(c, -448.f), 448.f); d = fminf(fmaxf(d, -448.f), 448.f);
    unsigned x = (unsigned)__builtin_amdgcn_cvt_pk_fp8_f32(a, b, 0, false); return (unsigned)__builtin_amdgcn_cvt_pk_fp8_f32(c, d, (int)x, true);
}
template <bool F8>
__device__ void transpose_tile(const float* __restrict__ src, bf16_t* __restrict__ dst, int R, int C, int r0, int c0, float* tile  , int mode, float scale, const int wv_) {
    const int tid = WV * 64 + lane_id();
    f32x4 v[8];
#pragma unroll
    for (int i = 0; i < 8; ++i) v[i] = *(const f32x4*)(src + (size_t)(r0 + (tid >> 6) + 8 * i) * C + c0 + (tid & 63) * 4);
#pragma unroll
    for (int i = 0; i < 8; ++i) {
        float* tp = tile + ((tid >> 6) + 8 * i) * 257 + (tid & 63) * 4;
        tp[0] = v[i][0]; tp[1] = v[i][1]; tp[2] = v[i][2]; tp[3] = v[i][3];
    }
    __syncthreads();
    if constexpr (F8) {
        unsigned char* d8 = (unsigned char*)dst;
#pragma unroll
        for (int k = 0; k < 2; ++k) {
            const int id = tid + 512 * k, c = id >> 2, rr = (id & 3) * 16;
            float x[16];
#pragma unroll
            for (int j = 0; j < 16; ++j) x[j] = tile[(rr + j) * 257 + c] * scale;
            u32x4 w; w.x = pk4_fp8(x[0], x[1], x[2], x[3]); w.y = pk4_fp8(x[4], x[5], x[6], x[7]); w.z = pk4_fp8(x[8], x[9], x[10], x[11]); w.w = pk4_fp8(x[12], x[13], x[14], x[15]);
            *(u32x4*)(d8 + (size_t)rowmap(mode, c0 + c) * R + r0 + rr) = w;
        }
        __syncthreads();
        return;
    }
#pragma unroll
    for (int k = 0; k < 4; ++k) {
        const int id = tid + 512 * k, c = id >> 3, rr = (id & 7) * 8;
        float x[8];
#pragma unroll
        for (int j = 0; j < 8; ++j) x[j] = tile[(rr + j) * 257 + c];
        u32x4 w; w.x = cvt_pk_bf16(x[0], x[1]); w.y = cvt_pk_bf16(x[2], x[3]); w.z = cvt_pk_bf16(x[4], x[5]); w.w = cvt_pk_bf16(x[6], x[7]);
        *(u32x4*)(dst + (size_t)rowmap(mode, c0 + c) * R + r0 + rr) = w;
    }
    __syncthreads();
}

template <bool F8 = false>
__device__ __forceinline__ int transpose_job(const float* src, bf16_t* dst, int batch, int R, int C, int base, float* tile, int mode, const int wv_, float scale = 1.0f, int tj0 = 0, int tjn = 0) {
    const int nb = gridDim.x, bid = blockIdx.x;
    const int tr = R / 64, tc = tjn ? tjn : C / 256, per = tr * tc, tot = per * batch;
    const int first = (bid - (base % nb) + nb) % nb;
    for (int t = first; t < tot; t += nb) {
        const int e = t / per, r = t % per, ti = r / tc, tj = r % tc;
        transpose_tile<F8>(src + (size_t)e * R * C, F8 ? (bf16_t*)((unsigned char*)dst + (size_t)e * R * C) : dst + (size_t)e * R * C, R, C, ti * 64, (tj0 + tj) * 256, tile, mode, scale, wv_);
    }
    return base + tot;
}

__device__ __forceinline__ float log2_sigmoid(float x) {
    const float ax = fabsf(x);
    const float sp = fmaxf(-x, 0.f) + log1pf(__expf(-ax));
    return -sp * LOG2E;
}

__device__ void phase0(const Params& p, unsigned char* lds, const int wv_) {
    unsigned char* ws = p.ws;
    const int tid = WV * 64 + lane_id(), nb = gridDim.x, bid = blockIdx.x;
    for (int idx = bid * NTHREADS + tid; idx < SEQ * 32; idx += nb * NTHREADS) {
        const int s = idx >> 5, i = idx & 31;
        const double ang = (double)s * INV_FREQ[i];
        const double rev = ang * 0.15915494309189535;
        const double fr = rev - floor(rev);
        const float ff = (float)fr;
        float2 cs; cs.x = __builtin_amdgcn_cosf(ff); cs.y = __builtin_amdgcn_sinf(ff);
        ((float2*)(ws + WS_ROPE))[idx] = cs;
    }
    if (bid == 0 && tid < 16) ((float*)(ws + WS_LGT))[tid] = log2_sigmoid(tid < 8 ? p.in[3][tid] : p.in[4][tid - 8]);
    for (int idx = bid * NTHREADS + tid; idx < 8 * 4 * 4 * 64; idx += nb * NTHREADS) {
        const int ln = idx & 63, nt = (idx >> 6) & 3, ks = (idx >> 8) & 3, w = idx >> 10, li = ln & 15, q = ln >> 4;
        float wv[8];
#pragma unroll
        for (int j = 0; j < 8; ++j) wv[j] = p.in[10][(size_t)(128 * w + 32 * ks + 8 * q + j) * 64 + 16 * nt + li];
        u32x4 hi, lo;
        hi.x = cvt_pk_bf16(wv[0], wv[1]); hi.y = cvt_pk_bf16(wv[2], wv[3]); hi.z = cvt_pk_bf16(wv[4], wv[5]); hi.w = cvt_pk_bf16(wv[6], wv[7]);
        lo.x = cvt_pk_bf16(wv[0] - bflo(hi.x), wv[1] - bfhi(hi.x)); lo.y = cvt_pk_bf16(wv[2] - bflo(hi.y), wv[3] - bfhi(hi.y));
        lo.z = cvt_pk_bf16(wv[4] - bflo(hi.z), wv[5] - bfhi(hi.z)); lo.w = cvt_pk_bf16(wv[6] - bflo(hi.w), wv[7] - bfhi(hi.w));
        u32x4* dst = (u32x4*)(ws + WS_WRF) + (size_t)(((w * 4 + ks) * 4 + nt) * 2) * 64 + ln;
        dst[0] = hi; dst[64] = lo;
    }
    {
        const float* x = p.in[0]; bf16_t* xb = (bf16_t*)(ws + WS_XB); unsigned char* x8 = ws + WS_X8;
        const size_t n8 = (size_t)T_TOK * DM / 8;
        for (size_t i = (size_t)bid * NTHREADS + tid; i < n8; i += (size_t)nb * NTHREADS) {
            const f32x4 a = *(const f32x4*)(x + i * 8), b = *(const f32x4*)(x + i * 8 + 4);
            u32x4 w; w.x = cvt_pk_bf16(a[0], a[1]); w.y = cvt_pk_bf16(a[2], a[3]); w.z = cvt_pk_bf16(b[0], b[1]); w.w = cvt_pk_bf16(b[2], b[3]);
            *(u32x4*)(xb + i * 8) = w;
            u32x2 f; f.x = pk4_fp8(a[0] * X8_SCALE, a[1] * X8_SCALE, a[2] * X8_SCALE, a[3] * X8_SCALE); f.y = pk4_fp8(b[0] * X8_SCALE, b[1] * X8_SCALE, b[2] * X8_SCALE, b[3] * X8_SCALE);
            *(u32x2*)(x8 + i * 8) = f;
        }
        const float* pp = p.in[1]; unsigned char* p8 = ws + WS_PB;
        const size_t m8 = (size_t)T_TOK * PLE / 8;
        for (size_t i = (size_t)bid * NTHREADS + tid; i < m8; i += (size_t)nb * NTHREADS) {
            const f32x4 a = *(const f32x4*)(pp + i * 8), b = *(const f32x4*)(pp + i * 8 + 4);
            u32x2 f; f.x = pk4_fp8(a[0] * P8_SCALE, a[1] * P8_SCALE, a[2] * P8_SCALE, a[3] * P8_SCALE); f.y = pk4_fp8(b[0] * P8_SCALE, b[1] * P8_SCALE, b[2] * P8_SCALE, b[3] * P8_SCALE);
            *(u32x2*)(p8 + i * 8) = f;
        }
    }
    float* tile = (float*)lds;
    int base = 0;
    base = transpose_job(p.in[2],  (bf16_t*)(ws + WS_WINT), 1, 1024, 3584, base, tile, 1, wv_, 1.0f, 0, 8);
    base = transpose_job<true>(p.in[2], (bf16_t*)(ws + WS_WIN8 - (size_t)2048 * 1024), 1, 1024, 3584, base, tile, 1, wv_, WIN8_SCALE, 8, 6);
    base = transpose_job<true>(p.in[7],  (bf16_t*)(ws + WS_WOUTT), 1, 1024, 1024, base, tile, 3, wv_, WO_SCALE);
    base = transpose_job<true>(p.in[12], (bf16_t*)(ws + WS_WGUT), 64, 1024, 512, base, tile, 2, wv_, WGU_SCALE);
    base = transpose_job<true>(p.in[14], (bf16_t*)(ws + WS_WGUT + (size_t)64 * 512 * 1024), 1, 1024, 512, base, tile, 2, wv_, WGU_SCALE);
    base = transpose_job<true>(p.in[13], (bf16_t*)(ws + WS_WDT), 64, 256, 1024, base, tile, 4, wv_, WD_SCALE);
    base = transpose_job<true>(p.in[15], (bf16_t*)(ws + WS_WDT + (size_t)64 * 1024 * 256), 1, 256, 1024, base, tile, 4, wv_, WD_SCALE);
    base = transpose_job<true>(p.in[17], (bf16_t*)(ws + WS_WGATE), 1, 1024, 1024, base, tile, 4, wv_, WGU_SCALE);
    base = transpose_job<true>(p.in[16], (bf16_t*)(ws + WS_WPT), 1, 256, 1024, base, tile, 0, wv_, WP8_SCALE);
}

struct SchedDense {
    static constexpr bool VARK = false;
    const char* A; const char* B; int K; pg8::TileOrder ord;
    __device__ bool next(int i, pg8::Unit& u) const {
        int pm, pn; if (!ord.map((long)i * gridDim.x + blockIdx.x, pm, pn)) return false;
        u.pm = pm; u.pn = pn; u.A = A + (size_t)pm * 256 * K * 2; u.B = B + (size_t)pn * 256 * K * 2; u.x0 = u.x1 = u.x2 = u.x3 = 0; return true;
    }
    __device__ int arow(const pg8::Unit&, int r) const { return r; }
};
template <bool F8>
struct EpiInProjT {
    static constexpr bool PERM = false; static constexpr int NMETA = 0;
    __device__ const char* meta_src(const pg8::Unit&, int) const { return nullptr; }
    unsigned char* ws;
    __device__ __forceinline__ void operator()(const f32x4 (&acc)[2][2][4][2], const pg8::Unit& u, int wr, int wc, int fr_, int fq_, const PG8_LAS unsigned char* meta) const {
        int fr = fr_, fq = fq_; asm volatile("" : "+v"(fr), "+v"(fq));
        if constexpr (F8) {
        if (u.x0 == 1) {
            bf16_t* ple = (bf16_t*)(ws + WS_PLE);
#pragma unroll
            for (int ai = 0; ai < 2; ++ai)
#pragma unroll
                for (int m = 0; m < 4; ++m) {
                    const size_t t = u.pm * 256 + 128 * ai + 64 * wr + 16 * m + fr;
#pragma unroll
                    for (int bj = 0; bj < 2; ++bj)
#pragma unroll
                        for (int n = 0; n < 2; ++n) {
                            const f32x4 a = acc[ai][bj][m][n] * PLEP_DESCALE;
                            u32x2 w; w.x = cvt_pk_bf16(a[0], a[1]); w.y = cvt_pk_bf16(a[2], a[3]);
                            *(u32x2*)(ple + t * DM + u.pn * 256 + 128 * bj + 32 * wc + 16 * n + 4 * fq) = w;
                        }
                }
            return;
        }
        }
        const float2* rope = (const float2*)(ws + WS_ROPE);
        const int region = u.pn >> 1, d0 = 16 * (wc & 1) + 4 * fq;
#pragma unroll
        for (int ai = 0; ai < 2; ++ai)
#pragma unroll
            for (int m = 0; m < 4; ++m) {
                const int t = u.pm * 256 + 128 * ai + 64 * wr + 16 * m + fr, b = t >> 12, s = t & 4095;
                f32x4 cs0, cs1;
                if constexpr (!F8) { if (region <= 1) { cs0 = *(const f32x4*)(rope + (size_t)s * 32 + d0); cs1 = *(const f32x4*)(rope + (size_t)s * 32 + d0 + 2); } }
#pragma unroll
                for (int bj = 0; bj < 2; ++bj) {
                    const int head = 4 * (u.pn & 1) + 2 * bj + (wc >> 1), bh = b * 8 + head;
                    const f32x4 a0 = acc[ai][bj][m][0], a1 = acc[ai][bj][m][1];
                    if constexpr (!F8) {
                    if (region <= 1) {
                        const float sc = region == 1 ? 0.125f : 1.0f;
                        const float co[4] = {cs0[0], cs0[2], cs1[0], cs1[2]}, si[4] = {cs0[1], cs0[3], cs1[1], cs1[3]};
                        float o1[4], o2[4];
#pragma unroll
                        for (int r = 0; r < 4; ++r) { o1[r] = (a0[r] * co[r] - a1[r] * si[r]) * sc; o2[r] = (a0[r] * si[r] + a1[r] * co[r]) * sc; }
                        u32x2 w1, w2; w1.x = cvt_pk_bf16(o1[0], o1[1]); w1.y = cvt_pk_bf16(o1[2], o1[3]); w2.x = cvt_pk_bf16(o2[0], o2[1]); w2.y = cvt_pk_bf16(o2[2], o2[3]);
                        bf16_t* dst = (bf16_t*)(ws + (region == 0 ? WS_Q : WS_K)) + ((size_t)bh * SEQ + s) * 64;
                        *(u32x2*)(dst + d0) = w1; *(u32x2*)(dst + d0 + 32) = w2;
                        if (region == 1) {
                            bf16_t* dstT = (bf16_t*)(ws + WS_KT) + (size_t)bh * 64 * SEQ + s;
                            dstT[(size_t)(d0 + 0) * SEQ] = (bf16_t)(w1.x & 0xffff); dstT[(size_t)(d0 + 1) * SEQ] = (bf16_t)(w1.x >> 16);
                            dstT[(size_t)(d0 + 2) * SEQ] = (bf16_t)(w1.y & 0xffff); dstT[(size_t)(d0 + 3) * SEQ] = (bf16_t)(w1.y >> 16);
                            dstT[(size_t)(d0 + 32) * SEQ] = (bf16_t)(w2.x & 0xffff); dstT[(size_t)(d0 + 33) * SEQ] = (bf16_t)(w2.x >> 16);
                            dstT[(size_t)(d0 + 34) * SEQ] = (bf16_t)(w2.y & 0xffff); dstT[(size_t)(d0 + 35) * SEQ] = (bf16_t)(w2.y >> 16);
                        }
                    } else if (region == 2) {
                        bf16_t* dstT = (bf16_t*)(ws + WS_VT) + (size_t)bh * 64 * SEQ + s;
#pragma unroll
                        for (int r = 0; r < 4; ++r) { dstT[(size_t)(d0 + r) * SEQ] = f2bf(a0[r]); dstT[(size_t)(d0 + 32 + r) * SEQ] = f2bf(a1[r]); }
                    } else {
                        bf16_t* dst = (bf16_t*)(ws + WS_G) + (size_t)t * 512 + head * 64;
                        u32x2 w1, w2; w1.x = cvt_pk_bf16(siluf_(a0[0]), siluf_(a0[1])); w1.y = cvt_pk_bf16(siluf_(a0[2]), siluf_(a0[3]));
                        w2.x = cvt_pk_bf16(siluf_(a1[0]), siluf_(a1[1])); w2.y = cvt_pk_bf16(siluf_(a1[2]), siluf_(a1[3]));
                        *(u32x2*)(dst + d0) = w1; *(u32x2*)(dst + d0 + 32) = w2;
                    }
                    } else {
                    if (region == 6) {
                        bf16_t* dstT = (bf16_t*)(ws + WS_NVT) + (size_t)bh * 64 * SEQ + s;
#pragma unroll
                        for (int r = 0; r < 4; ++r) { dstT[(size_t)(d0 + r) * SEQ] = f2bf(a0[r] * NA_DESCALE); dstT[(size_t)(d0 + 32 + r) * SEQ] = f2bf(a1[r] * NA_DESCALE); }
                    } else {
                        const float sc = (region == 4 ? 0.125f : 1.0f) * NA_DESCALE;
                        bf16_t* dst = (bf16_t*)(ws + (region == 4 ? WS_NQ : WS_NK)) + ((size_t)bh * SEQ + s) * 64;
                        u32x2 w1, w2; w1.x = cvt_pk_bf16(a0[0] * sc, a0[1] * sc); w1.y = cvt_pk_bf16(a0[2] * sc, a0[3] * sc);
                        w2.x = cvt_pk_bf16(a1[0] * sc, a1[1] * sc); w2.y = cvt_pk_bf16(a1[2] * sc, a1[3] * sc);
                        *(u32x2*)(dst + d0) = w1; *(u32x2*)(dst + d0 + 32) = w2;
                    }
                    }
                }
            }
    }
};
struct SchedP1a {
    static constexpr bool VARK = false;
    unsigned char* ws; pg8::TileOrder ord;
    __device__ bool next(int i, pg8::Unit& u) const {
        const long L = (long)i * gridDim.x + blockIdx.x;
        int pm, pn;
        if (!ord.map(L, pm, pn)) return false;
        u.pm = pm; u.pn = pn; u.x0 = 0; u.x1 = u.x2 = 0; u.x3 = DM;
        u.A = (const char*)(ws + WS_XB) + (size_t)pm * 256 * DM * 2; u.B = (const char*)(ws + WS_WINT) + (size_t)pn * 256 * DM * 2; return true;
    }
    __device__ int arow(const pg8::Unit&, int r) const { return r; }
};
struct SchedP1b {
    static constexpr bool VARK = true;
    unsigned char* ws; pg8::TileOrder ord;
    __device__ bool next(int i, pg8::Unit& u) const {
        const long L = (long)i * gridDim.x + blockIdx.x;
        int pm, pn;
        if (ord.map(L, pm, pn)) {
            u.pm = pm; u.pn = 8 + pn; u.x0 = 0; u.x1 = u.x2 = 0; u.x3 = DM / 2;
            u.A = (const char*)(ws + WS_X8) + (size_t)pm * 256 * DM; u.B = (const char*)(ws + WS_WIN8) + (size_t)pn * 256 * DM; return true;
        }
        const int lastr = ord.nwg / (int)gridDim.x, c = (int)blockIdx.x, nfree = (int)gridDim.x - ord.nwg % (int)gridDim.x, cf = c - ord.nwg % (int)gridDim.x;
        if (cf < 0 || i < lastr) return false;
        const int per = (256 + nfree - 1) / nfree, j = i - lastr;
        if (j >= per) return false;
        const int x = cf * per + j;
        if (x >= 256) return false;
        u.pm = x >> 2; u.pn = x & 3; u.x0 = 1; u.x1 = u.x2 = 0; u.x3 = PLE / 2;
        u.A = (const char*)(ws + WS_PB) + (size_t)u.pm * 256 * PLE; u.B = (const char*)(ws + WS_WPT) + (size_t)u.pn * 256 * PLE; return true;
    }
    __device__ int arow(const pg8::Unit&, int r) const { return r; }
};
__device__ void phase1(const Params& p, unsigned char* lds, const int wv_) {
    {
        SchedP1a S; S.ws = p.ws; S.ord.init(T_TOK, 2048);
        EpiInProjT<false> E; E.ws = p.ws;
        pg8::gemm_phase<EpiInProjT<false>, SchedP1a, false, true, true>((PG8_LAS unsigned char*)lds, DM, S, E, wv_);
    }
    {
        SchedP1b S; S.ws = p.ws; S.ord.init(T_TOK, 1536);
        EpiInProjT<true> E; E.ws = p.ws;
        pg8::gemm_phase<EpiInProjT<true>, SchedP1b, false, true, true, true>((PG8_LAS unsigned char*)lds, DM / 2, S, E, wv_);
    }
}


__device__ void phase2(const Params& p, unsigned char* lds, const int wv_) {
    unsigned char* ws = p.ws;
    const int lane = lane_id(), wid = WV, tid = wid * 64 + lane, q = lane >> 4, li = lane & 15;
    const bf16_t* KT = (const bf16_t*)(ws + WS_KT); const bf16_t* VT = (const bf16_t*)(ws + WS_VT);
    const bf16_t* NQ = (const bf16_t*)(ws + WS_NQ); const bf16_t* NK = (const bf16_t*)(ws + WS_NK); const bf16_t* NVT = (const bf16_t*)(ws + WS_NVT);
    float* SST = (float*)(ws + WS_SST);
    unsigned char* mix = ws + WS_MIX;
    constexpr int KS_BYTES = 576 * 128, VROW = 1168, VS_BYTES = 64 * VROW;
    unsigned char* Ks = lds; unsigned char* Vs = lds + KS_BYTES; float* biasL = (float*)(lds + KS_BYTES + VS_BYTES);
    bf16_t* PS = (bf16_t*)(ws + WS_SST);
    const int G_ = gridDim.x, c_ = blockIdx.x, cswz = (G_ & 7) == 0 ? (c_ & 7) * (G_ >> 3) + (c_ >> 3) : c_;
    for (int u = cswz; u < 256; u += gridDim.x) {
        const int bh = u >> 3, dir = (u >> 2) & 1, dvt = u & 3, h = bh & 7;
        const float lg = ((const float*)(ws + WS_LGT))[8 * dir + h];
        const float gC = fast_exp2(lg * 128.f);
        constexpr int SLOT = 80 * 256;
        const bf16_t* src[3]; unsigned ldso[3];
#pragma unroll
        for (int k = 0; k < 3; ++k) {
            const int id = tid + 512 * k, r = (id >> 4) < 80 ? (id >> 4) : 0, ch = id & 15;
            src[k] = (r < 16 ? VT + ((size_t)bh * 64 + 16 * dvt + r) * SEQ : KT + ((size_t)bh * 64 + (r - 16)) * SEQ) + ch * 8;
            ldso[k] = (unsigned)(r * 256 + ((ch ^ (r & 15)) << 4));
        }
        const bool has3 = tid < 256;
        u32x4 rg[3][3];
#define SCAN_LOAD(slot, c) do { _Pragma("unroll") for (int k = 0; k < 2; ++k) rg[slot][k] = *(const u32x4*)(src[k] + (c) * 128); if (has3) rg[slot][2] = *(const u32x4*)(src[2] + (c) * 128); } while (0)
#define SCAN_STORE(slot, ls) do { _Pragma("unroll") for (int k = 0; k < 2; ++k) *(u32x4*)(lds + (ls) * SLOT + ldso[k]) = rg[slot][k]; if (has3) *(u32x4*)(lds + (ls) * SLOT + ldso[2]) = rg[slot][2]; } while (0)
#define SCAN_CH(step) (dir == 0 ? (step) : 31 - (step))
        SCAN_LOAD(0, SCAN_CH(0)); SCAN_LOAD(1, SCAN_CH(1)); SCAN_LOAD(2, SCAN_CH(2));
        float wg[4][8];
#pragma unroll
        for (int ks = 0; ks < 4; ++ks)
#pragma unroll
            for (int j = 0; j < 8; ++j) { const int jl = 32 * ks + 8 * q + j; wg[ks][j] = fast_exp2(lg * (float)(dir == 0 ? (127 - jl) : jl)); }
        f32x4 st = (f32x4){0.f, 0.f, 0.f, 0.f};
        __syncthreads();
        SCAN_STORE(0, 0);
#pragma unroll 1
        for (int s3 = 0; s3 < 33; s3 += 3) {
#pragma unroll
            for (int j = 0; j < 3; ++j) {
                const int step = s3 + j;
                if (step < 32) {
                    if (step + 3 < 32) SCAN_LOAD(j, SCAN_CH(step + 3));
                    __syncthreads();
                    if (step + 1 < 32) SCAN_STORE((j + 1) % 3, (step + 1) & 1);
                    if (wid < 4) {
                        const int c = SCAN_CH(step);
                        bf16_t* dst = PS + ((size_t)(bh * 32 + c) * 2 + dir) * 4096;
#pragma unroll
                        for (int r = 0; r < 4; ++r) dst[(16 * dvt + 4 * q + r) * 64 + 16 * wid + li] = f2bf(st[r]);
                        st = st * gC;
                        const unsigned char* sl = lds + (step & 1) * SLOT;
#pragma unroll
                        for (int ks = 0; ks < 4; ++ks) {
                            const u32x4 vr = *(const u32x4*)(sl + li * 256 + (((4 * ks + q) ^ li) << 4));
                            const u32x4 kr = *(const u32x4*)(sl + (16 + 16 * wid + li) * 256 + (((4 * ks + q) ^ li) << 4));
                            u32x4 kw;
                            kw.x = cvt_pk_bf16(bflo(kr.x) * wg[ks][0], bfhi(kr.x) * wg[ks][1]); kw.y = cvt_pk_bf16(bflo(kr.y) * wg[ks][2], bfhi(kr.y) * wg[ks][3]);
                            kw.z = cvt_pk_bf16(bflo(kr.z) * wg[ks][4], bfhi(kr.z) * wg[ks][5]); kw.w = cvt_pk_bf16(bflo(kr.w) * wg[ks][6], bfhi(kr.w) * wg[ks][7]);
                            st = MFMA16(__builtin_bit_cast(bf16x8, vr), __builtin_bit_cast(bf16x8, kw), st);
                        }
                    }
                }
            }
        }
#undef SCAN_LOAD
#undef SCAN_STORE
#undef SCAN_CH
    }
    u32x4 kreg[9], vreg[9]; float breg = 0.f;
#define NA_DECODE(xx) const int rp = (xx) & 31, h = ((xx) >> 5) & 7, b = (xx) >> 8, bh = b * 8 + h; const int r0 = 2 * rp, base_r = min(min(max(r0 - 4, 0), 56), 55)
#define NA_LOAD(xx) do { NA_DECODE(xx); const u32x4* ksrc = (const u32x4*)(NK + ((size_t)bh * SEQ + base_r * 64) * 64); \
        _Pragma("unroll") for (int i = 0; i < 9; ++i) kreg[i] = ksrc[tid + 512 * i]; \
        _Pragma("unroll") for (int i = 0; i < 9; ++i) { const int id = tid + 512 * i, row = id / 72, ch = id % 72; vreg[i] = *(const u32x4*)(NVT + ((size_t)bh * 64 + row) * SEQ + base_r * 64 + ch * 8); } \
        if (tid < 15 * 31) breg = p.in[6][h * 15 * 31 + tid]; } while (0)
    if (cswz < 1024) NA_LOAD(cswz);
    for (int x = cswz; x < 1024; x += gridDim.x) {
        {
            NA_DECODE(x);
            __syncthreads();
            if (tid < 15 * 31) biasL[tid] = breg;
#pragma unroll
            for (int i = 0; i < 9; ++i) { const int id = tid + 512 * i, row = id >> 3, ch = id & 7; *(u32x4*)(Ks + row * 128 + ((ch ^ (row & 7)) << 4)) = kreg[i]; }
#pragma unroll
            for (int i = 0; i < 9; ++i) { const int id = tid + 512 * i, row = id / 72, ch = id % 72; *(u32x4*)(Vs + row * VROW + ch * 16) = vreg[i]; }
            __syncthreads();
            if (x + (int)gridDim.x < 1024) NA_LOAD(x + (int)gridDim.x);
            const int r = r0 + (wid >> 2), cblk = wid & 3;
            const int rs = min(max(r - 4, 0), 56), kr0 = rs - base_r;
            const int cw = cblk == 0 ? 0 : (cblk == 1 ? 8 : (cblk == 2 ? 24 : 32));
            const int c = 16 * cblk + li, cs = min(max(c - 8, 0), 48);
            const size_t qtok = (size_t)bh * SEQ + r * 64 + c;
            bf16x8 qf[2];
            qf[0] = *(const bf16x8*)(NQ + qtok * 64 + 8 * q); qf[1] = *(const bf16x8*)(NQ + qtok * 64 + 32 + 8 * q);
            f32x4 sT[16];
            const int wcol_l = 8 * (li >> 2) + (li & 3);
#pragma unroll
            for (int kt = 0; kt < 16; ++kt) {
                const int krow = (kr0 + (kt >> 1)) * 64 + cw + wcol_l + 4 * (kt & 1);
                const bf16x8 k0 = *(const bf16x8*)(Ks + krow * 128 + ((q ^ (krow & 7)) << 4));
                const bf16x8 k1 = *(const bf16x8*)(Ks + krow * 128 + (((4 + q) ^ (krow & 7)) << 4));
                f32x4 a = (f32x4){0.f, 0.f, 0.f, 0.f};
                a = MFMA16(k0, qf[0], a); a = MFMA16(k1, qf[1], a);
                sT[kt] = a;
            }
            float mx = -3.0e38f;
#pragma unroll
            for (int kt = 0; kt < 16; ++kt) {
                const float* brow = biasL + (rs + (kt >> 1) - r + 7) * 31;
#pragma unroll
                for (int rr = 0; rr < 4; ++rr) {
                    const int kc = cw + 8 * q + 4 * (kt & 1) + rr;
                    const bool valid = (kc >= cs) && (kc <= cs + 15);
                    const int bi = min(max(kc - c + 15, 0), 30);
                    float bv = brow[bi]; asm volatile("" : "+v"(bv));
                    const float sv = valid ? (sT[kt][rr] + bv) : -3.0e38f;
                    sT[kt][rr] = sv; mx = fmaxf(mx, sv);
                }
            }
            mx = fmaxf(mx, __shfl_xor(mx, 16)); mx = fmaxf(mx, __shfl_xor(mx, 32));
            float sum = 0.f;
#pragma unroll
            for (int kt = 0; kt < 16; ++kt)
#pragma unroll
                for (int rr = 0; rr < 4; ++rr) { const float e = fast_exp2((sT[kt][rr] - mx) * LOG2E); sT[kt][rr] = e; sum += e; }
            sum += __shfl_xor(sum, 16); sum += __shfl_xor(sum, 32);
            const float inv = 1.0f / sum;
            f32x4 oT[4];
#pragma unroll
            for (int d = 0; d < 4; ++d) oT[d] = (f32x4){0.f, 0.f, 0.f, 0.f};
#pragma unroll
            for (int ks = 0; ks < 8; ++ks) {
                u32x4 pw; pw.x = cvt_pk_bf16(sT[2 * ks][0], sT[2 * ks][1]); pw.y = cvt_pk_bf16(sT[2 * ks][2], sT[2 * ks][3]);
                pw.z = cvt_pk_bf16(sT[2 * ks + 1][0], sT[2 * ks + 1][1]); pw.w = cvt_pk_bf16(sT[2 * ks + 1][2], sT[2 * ks + 1][3]);
                const bf16x8 pf = __builtin_bit_cast(bf16x8, pw);
                const int vtok = (kr0 + ks) * 64 + cw + 8 * q;
#pragma unroll
                for (int d = 0; d < 4; ++d) {
                    const bf16x8 vf = *(const bf16x8*)(Vs + (16 * d + li) * VROW + vtok * 2);
                    oT[d] = MFMA16(vf, pf, oT[d]);
                }
            }
            unsigned char* dst = mix + ((size_t)b * SEQ + r * 64 + c) * DM + 512 + h * 64 + 4 * q;
            const float invs = inv * MIX_SCALE;
#pragma unroll
            for (int d = 0; d < 4; ++d) *(unsigned*)(dst + 16 * d) = pk4_fp8(oT[d][0] * invs, oT[d][1] * invs, oT[d][2] * invs, oT[d][3] * invs);
        }
    }
}

__device__ void phase3(const Params& p, unsigned char* lds, const int wv_) {
    unsigned char* ws = p.ws;
    const int lane = lane_id(), wid = WV, tid = wid * 64 + lane, q = lane >> 4, li = lane & 15;
    const bf16_t* Q = (const bf16_t*)(ws + WS_Q); const bf16_t* Kp = (const bf16_t*)(ws + WS_K); const bf16_t* VT = (const bf16_t*)(ws + WS_VT);
    const bf16_t* Gt = (const bf16_t*)(ws + WS_G);
    const bf16_t* PS = (const bf16_t*)(ws + WS_SST);
    unsigned char* mix = ws + WS_MIX;
    constexpr int PROW = 144;
    unsigned char* Ks = lds + 2 * 64 * PROW;
    unsigned char* Vs = Ks + 128 * 128;
    for (int u = blockIdx.x; u < 1024; u += gridDim.x) {
        const int bh = u >> 5, c = u & 31, h = bh & 7, b = bh >> 3;
        const float lf = ((const float*)(ws + WS_LGT))[h], lb = ((const float*)(ws + WS_LGT))[8 + h];
        __syncthreads();
        u32x4 kreg[2], vreg[2];
#pragma unroll
        for (int i = 0; i < 2; ++i) {
            const int id = tid + 512 * i;
            kreg[i] = *(const u32x4*)(Kp + ((size_t)bh * SEQ + c * 128) * 64 + id * 8);
            vreg[i] = *(const u32x4*)(VT + ((size_t)bh * 64 + (id >> 4)) * SEQ + c * 128 + (id & 15) * 8);
        }
        u32x4 preg[2];
#pragma unroll
        for (int rep = 0; rep < 2; ++rep) preg[rep] = *(const u32x4*)(PS + (size_t)(bh * 32 + c) * 2 * 4096 + (size_t)(tid + 512 * rep) * 8);
#pragma unroll
        for (int rep = 0; rep < 2; ++rep) {
            const int id = tid + 512 * rep, dir = id >> 9, dv = (id >> 3) & 63, ch = id & 7;
            *(u32x4*)(lds + dir * (64 * PROW) + dv * PROW + ch * 16) = preg[rep];
        }
#pragma unroll
        for (int i = 0; i < 2; ++i) {
            const int id = tid + 512 * i;
            { const int row = id >> 3, ch = id & 7; *(u32x4*)(Ks + row * 128 + ((ch ^ (row & 7)) << 4)) = kreg[i]; }
            { const int row = id >> 4, ch = id & 15; *(u32x4*)(Vs + row * 256 + ((ch ^ (row & 15)) << 4)) = vreg[i]; }
        }
        __syncthreads();
        const int ii = 16 * wid + li;
        const size_t qrow = (size_t)bh * SEQ + c * 128 + ii;
        bf16x8 qf[2];
        qf[0] = *(const bf16x8*)(Q + qrow * 64 + 8 * q); qf[1] = *(const bf16x8*)(Q + qrow * 64 + 32 + 8 * q);
        f32x4 sT[8];
        const int kl = 8 * (li >> 2) + (li & 3);
#pragma unroll
        for (int jt = 0; jt < 8; ++jt) {
            const int krow = 32 * (jt >> 1) + kl + 4 * (jt & 1);
            const bf16x8 k0 = *(const bf16x8*)(Ks + krow * 128 + ((q ^ (krow & 7)) << 4));
            const bf16x8 k1 = *(const bf16x8*)(Ks + krow * 128 + (((4 + q) ^ (krow & 7)) << 4));
            f32x4 a = (f32x4){0.f, 0.f, 0.f, 0.f};
            a = MFMA16(k0, qf[0], a); a = MFMA16(k1, qf[1], a);
#pragma unroll
            for (int rr = 0; rr < 4; ++rr) {
                const int j = 32 * (jt >> 1) + 8 * q + 4 * (jt & 1) + rr, diff = ii - j;
                const float d = diff >= 0 ? fast_exp2(lf * (float)diff) : fast_exp2(lb * (float)(-diff));
                a[rr] *= d;
            }
            sT[jt] = a;
        }
        f32x4 yT[4], uf[4], ub[4];
#pragma unroll
        for (int d = 0; d < 4; ++d) { yT[d] = (f32x4){0.f, 0.f, 0.f, 0.f}; uf[d] = yT[d]; ub[d] = yT[d]; }
#pragma unroll
        for (int ks = 0; ks < 4; ++ks) {
            u32x4 pw; pw.x = cvt_pk_bf16(sT[2 * ks][0], sT[2 * ks][1]); pw.y = cvt_pk_bf16(sT[2 * ks][2], sT[2 * ks][3]);
            pw.z = cvt_pk_bf16(sT[2 * ks + 1][0], sT[2 * ks + 1][1]); pw.w = cvt_pk_bf16(sT[2 * ks + 1][2], sT[2 * ks + 1][3]);
            const bf16x8 pf = __builtin_bit_cast(bf16x8, pw);
#pragma unroll
            for (int d = 0; d < 4; ++d) {
                const int vrow = 16 * d + li;
                const bf16x8 vf = *(const bf16x8*)(Vs + vrow * 256 + (((4 * ks + q) ^ li) << 4));
                yT[d] = MFMA16(vf, pf, yT[d]);
            }
        }
#pragma unroll
        for (int d = 0; d < 4; ++d)
#pragma unroll
            for (int ks = 0; ks < 2; ++ks) {
                const bf16x8 pfw = *(const bf16x8*)(lds + (16 * d + li) * PROW + ks * 64 + q * 16);
                const bf16x8 pbw = *(const bf16x8*)(lds + 64 * PROW + (16 * d + li) * PROW + ks * 64 + q * 16);
                uf[d] = MFMA16(pfw, qf[ks], uf[d]); ub[d] = MFMA16(pbw, qf[ks], ub[d]);
            }
        const float df = fast_exp2(lf * (float)(ii + 1)), db = fast_exp2(lb * (float)(128 - ii));
        float sum = 0.f;
#pragma unroll
        for (int d = 0; d < 4; ++d)
#pragma unroll
            for (int rr = 0; rr < 4; ++rr) { const float y = yT[d][rr] + df * uf[d][rr] + db * ub[d][rr]; yT[d][rr] = y; sum += y; }
        sum += __shfl_xor(sum, 16); sum += __shfl_xor(sum, 32);
        const float mu = sum * (1.0f / 64.0f);
        float var = 0.f;
#pragma unroll
        for (int d = 0; d < 4; ++d)
#pragma unroll
            for (int rr = 0; rr < 4; ++rr) { const float t = yT[d][rr] - mu; var += t * t; }
        var += __shfl_xor(var, 16); var += __shfl_xor(var, 32);
        const float rstd = rsqrtf(var * (1.0f / 64.0f) + 1e-6f);
        const size_t tg = (size_t)b * SEQ + c * 128 + ii;
#pragma unroll
        for (int d = 0; d < 4; ++d) {
            const int dv = 16 * d + 4 * q;
            const f32x4 gn = *(const f32x4*)(p.in[5] + h * 64 + dv);
            const u32x2 gw = *(const u32x2*)(Gt + tg * 512 + h * 64 + dv);
            const float o0 = (yT[d][0] - mu) * rstd * gn[0] * bflo(gw.x), o1 = (yT[d][1] - mu) * rstd * gn[1] * bfhi(gw.x);
            const float o2 = (yT[d][2] - mu) * rstd * gn[2] * bflo(gw.y), o3 = (yT[d][3] - mu) * rstd * gn[3] * bfhi(gw.y);
            *(unsigned*)(mix + tg * DM + h * 64 + dv) = pk4_fp8(o0 * MIX_SCALE, o1 * MIX_SCALE, o2 * MIX_SCALE, o3 * MIX_SCALE);
        }
    }
}

__device__ void phase4(const Params& p, unsigned char* lds, const int wv_) {
    unsigned char* ws = p.ws;
    const int lane = lane_id(), wid = WV, tid = wid * 64 + lane, q = lane >> 4, li = lane & 15;
    const unsigned char* A = ws + WS_MIX; const unsigned char* Bt = ws + WS_WOUTT;
    const float* x = p.in[0]; const float* g1 = p.in[8]; const float* b1 = p.in[9]; const float* rb = p.in[11];
    bf16_t* x1b = (bf16_t*)(ws + WS_X1B);
    unsigned* counts = (unsigned*)(ws + WS_CTRL);
    int* ltok = (int*)(ws + WS_LTOK); float2* lkw = (float2*)(ws + WS_LKW);
    float* pl = (float*)lds;
    float* red = (float*)(lds + 147456);
    unsigned* lcnt = (unsigned*)(lds + 147456 + 2048);
    for (int unit = blockIdx.x; unit < T_TOK / 64; unit += gridDim.x) {
        const int m0 = unit * 64;
        f32x4 acc[4][8];
        {
            int lane2 = lane_id(); asm volatile("" : "+v"(lane2)); const int li2 = lane2 & 15, q2 = lane2 >> 4;
            constexpr int GA = 64 * 128, GSTAGE = GA + 256 * 128;
            PG8_LAS unsigned char* L = (PG8_LAS unsigned char*)lds;
            const int prow = lane2 >> 3, pch = (lane2 & 7) ^ (lane2 >> 3);
            const char* asrc = (const char*)(A + (size_t)(m0 + 8 * wid + prow) * DM) + pch * 16;
            const char* bsrc = (const char*)(Bt + (size_t)(128 * wid + prow) * DM) + pch * 16;
            const unsigned rA = (unsigned)li2 * 128u, rB = (unsigned)GA + (unsigned)(wid * 32 + li2) * 128u;
            const unsigned c0_ = (unsigned)((q2 ^ (li2 & 7)) << 4), c1_ = (unsigned)(((4 + q2) ^ (li2 & 7)) << 4);
#define P4_ISSUE(T, ST) do { const int _ps = (T) >> 3, _kt = (T) & 7, _st = (ST); \
        __builtin_amdgcn_global_load_lds((const unsigned*)(asrc + _kt * 128), (PG8_LAS unsigned*)(L + _st * GSTAGE + wid * 1024), 16, 0, 0); \
        _Pragma("unroll") for (int _j = 0; _j < 4; ++_j) __builtin_amdgcn_global_load_lds((const unsigned*)(bsrc + (size_t)(32 * _ps + 8 * _j) * DM + _kt * 128), \
            (PG8_LAS unsigned*)(L + _st * GSTAGE + GA + (4 * wid + _j) * 1024), 16, 0, 0); } while (0)
            __syncthreads();
            P4_ISSUE(0, 0); P4_ISSUE(1, 1);
            int st_c = 0, st_n = 2;
            asm volatile("s_waitcnt vmcnt(5)" ::: "memory");
            __builtin_amdgcn_s_barrier(); asm volatile("" ::: "memory");
#pragma unroll
            for (int ps = 0; ps < 4; ++ps) {
#pragma unroll
                for (int m = 0; m < 4; ++m)
#pragma unroll
                    for (int n = 0; n < 2; ++n) acc[m][2 * ps + n] = (f32x4){0.f, 0.f, 0.f, 0.f};
#pragma unroll 1
                for (int kt = 0; kt < 8; ++kt) {
                    const int T = ps * 8 + kt;
                    if (T + 2 < 32) P4_ISSUE(T + 2, st_n);
                    const PG8_LAS unsigned char* cur = L + st_c * GSTAGE;
                    st_c = st_c == 2 ? 0 : st_c + 1; st_n = st_n == 2 ? 0 : st_n + 1;
                    {
                        bf16x8 af[4][2], bfr[2][2];
#pragma unroll
                        for (int m = 0; m < 4; ++m) { af[m][0] = *(const PG8_LAS bf16x8*)(cur + rA + m * 2048 + c0_); af[m][1] = *(const PG8_LAS bf16x8*)(cur + rA + m * 2048 + c1_); }
#pragma unroll
                        for (int n = 0; n < 2; ++n) { bfr[n][0] = *(const PG8_LAS bf16x8*)(cur + rB + n * 2048 + c0_); bfr[n][1] = *(const PG8_LAS bf16x8*)(cur + rB + n * 2048 + c1_); }
                        asm volatile("s_waitcnt lgkmcnt(0)" ::: "memory");
#pragma unroll
                        for (int m = 0; m < 4; ++m)
#pragma unroll
                            for (int n = 0; n < 2; ++n) { const pg8::i32x8_t _b8 = pg8::cat8(bfr[n][0], bfr[n][1]), _a8 = pg8::cat8(af[m][0], af[m][1]);
                                asm volatile("v_mfma_f32_16x16x128_f8f6f4 %0, %1, %2, %0" : "+v"(acc[m][2 * ps + n]) : "v"(_b8), "v"(_a8)); }
                    }
                    if (T + 2 < 32) asm volatile("s_waitcnt vmcnt(5) lgkmcnt(0)" ::: "memory");
                    else            asm volatile("s_waitcnt vmcnt(0) lgkmcnt(0)" ::: "memory");
                    __builtin_amdgcn_s_barrier(); asm volatile("" ::: "memory");
                }
            }
#undef P4_ISSUE
            asm volatile("s_nop 15" ::: "memory");
            __syncthreads();
        }
        int li_ = li, q_ = q, lane_ = lane; asm volatile("" : "+v"(li_), "+v"(q_), "+v"(lane_));
        {
            PG8_LAS unsigned char* XL = (PG8_LAS unsigned char*)lds;
#define P4_XISSUE(mm) do { _Pragma("unroll") for (int _j = 0; _j < 8; ++_j) { const int _pc = 8 * wid + _j, _rr = _pc >> 2, _qd = _pc & 3; \
        __builtin_amdgcn_global_load_lds((const unsigned*)((const char*)(x + (size_t)(m0 + 16 * (mm) + _rr) * DM) + (64 * _qd + (lane_ ^ _rr)) * 16), \
            (PG8_LAS unsigned*)(XL + ((mm) & 1) * 65536 + _rr * 4096 + _qd * 1024), 16, 0, 0); } } while (0)
            P4_XISSUE(0); P4_XISSUE(1);
#pragma unroll
            for (int m = 0; m < 4; ++m) {
                if (m < 3) asm volatile("s_waitcnt vmcnt(8)" ::: "memory"); else asm volatile("s_waitcnt vmcnt(0)" ::: "memory");
                __builtin_amdgcn_s_barrier(); asm volatile("" ::: "memory");
                const PG8_LAS unsigned char* xb_ = XL + (m & 1) * 65536 + li_ * 4096;
                float s = 0.f;
#pragma unroll
                for (int pr = 0; pr < 4; ++pr) {
                    const int lc = 32 * wid + 8 * pr + 2 * q_;
                    const f32x4 x0 = *(const PG8_LAS f32x4*)(xb_ + ((lc ^ li_) << 4)), x1v = *(const PG8_LAS f32x4*)(xb_ + (((lc + 1) ^ li_) << 4));
                    acc[m][2 * pr] = x0 * ALPHA + acc[m][2 * pr] * O_DESCALE; acc[m][2 * pr + 1] = x1v * ALPHA + acc[m][2 * pr + 1] * O_DESCALE;
                    s += (acc[m][2 * pr][0] + acc[m][2 * pr][1]) + (acc[m][2 * pr][2] + acc[m][2 * pr][3]) + (acc[m][2 * pr + 1][0] + acc[m][2 * pr + 1][1]) + (acc[m][2 * pr + 1][2] + acc[m][2 * pr + 1][3]);
                }
                s += shx(s, 16, lane_); s += shx(s, 32, lane_);
                if (q_ == 0) red[wid * 64 + 16 * m + li_] = s;
                if (m < 2) {
                    asm volatile("s_waitcnt lgkmcnt(0)" ::: "memory");
                    __builtin_amdgcn_s_barrier(); asm volatile("" ::: "memory");
                    if (m == 0) P4_XISSUE(2); else P4_XISSUE(3);
                }
            }
#undef P4_XISSUE
        }
        __syncthreads();
        float mu[4], rstd[4];
#pragma unroll
        for (int m = 0; m < 4; ++m) {
            float s = 0.f;
#pragma unroll
            for (int w = 0; w < 8; ++w) s += red[w * 64 + 16 * m + li_];
            mu[m] = s * (1.0f / 1024.0f);
        }
        __syncthreads();
#pragma unroll
        for (int m = 0; m < 4; ++m) {
            float qv = 0.f;
#pragma unroll
            for (int n = 0; n < 8; ++n)
#pragma unroll
                for (int r = 0; r < 4; ++r) { const float d = acc[m][n][r] - mu[m]; qv += d * d; }
            qv += shx(qv, 16, lane_); qv += shx(qv, 32, lane_);
            if (q_ == 0) red[wid * 64 + 16 * m + li_] = qv;
        }
        __syncthreads();
#pragma unroll
        for (int m = 0; m < 4; ++m) {
            float s = 0.f;
#pragma unroll
            for (int w = 0; w < 8; ++w) s += red[w * 64 + 16 * m + li_];
            rstd[m] = rsqrtf(s * (1.0f / 1024.0f) + 1e-5f);
#pragma unroll
            for (int n = 0; n < 8; ++n) acc[m][n] = (acc[m][n] - mu[m]) * rstd[m];
        }
        __syncthreads();
        const u32x4* wfp = (const u32x4*)(ws + WS_WRF) + (size_t)wid * 2048 + (q_ * 16 + li_);
#pragma unroll
        for (int mh = 0; mh < 2; ++mh) {
            f32x4 lg[2][4];
#pragma unroll
            for (int m = 0; m < 2; ++m)
#pragma unroll
                for (int n = 0; n < 4; ++n) lg[m][n] = (f32x4){0.f, 0.f, 0.f, 0.f};
#pragma unroll
            for (int pr = 0; pr < 4; ++pr) {
                const int c0 = 128 * wid + 32 * pr + 8 * q_;
                const f32x4 ga = *(const f32x4*)(g1 + c0), gb = *(const f32x4*)(g1 + c0 + 4), ba = *(const f32x4*)(b1 + c0), bb = *(const f32x4*)(b1 + c0 + 4);
                bf16x8 wfh[4], wfl[4];
                const u32x4* wp = wfp + pr * 512; asm volatile("" : "+v"(wp));
#pragma unroll
                for (int nt = 0; nt < 4; ++nt) { wfh[nt] = __builtin_bit_cast(bf16x8, wp[nt * 128]); wfl[nt] = __builtin_bit_cast(bf16x8, wp[nt * 128 + 64]); }
#pragma unroll
                for (int m2 = 0; m2 < 2; ++m2) {
                    const int m = 2 * mh + m2;
                    float o[8];
#pragma unroll
                    for (int r = 0; r < 4; ++r) { o[r] = acc[m][2 * pr][r] * ga[r] + ba[r]; o[4 + r] = acc[m][2 * pr + 1][r] * gb[r] + bb[r]; }
                    u32x4 hi, lo;
                    hi.x = cvt_pk_bf16(o[0], o[1]); hi.y = cvt_pk_bf16(o[2], o[3]); hi.z = cvt_pk_bf16(o[4], o[5]); hi.w = cvt_pk_bf16(o[6], o[7]);
                    lo.x = cvt_pk_bf16(o[0] - bflo(hi.x), o[1] - bfhi(hi.x)); lo.y = cvt_pk_bf16(o[2] - bflo(hi.y), o[3] - bfhi(hi.y));
                    lo.z = cvt_pk_bf16(o[4] - bflo(hi.z), o[5] - bfhi(hi.z)); lo.w = cvt_pk_bf16(o[6] - bflo(hi.w), o[7] - bfhi(hi.w));
                    *(u32x4*)(x1b + (size_t)(m0 + 16 * m + li_) * DM + c0) = hi;
                    { u32x2 f8; f8.x = pk4_fp8(o[0] * X1_SCALE, o[1] * X1_SCALE, o[2] * X1_SCALE, o[3] * X1_SCALE); f8.y = pk4_fp8(o[4] * X1_SCALE, o[5] * X1_SCALE, o[6] * X1_SCALE, o[7] * X1_SCALE);
                      *(u32x2*)(ws + WS_X1F8 + (size_t)(m0 + 16 * m + li_) * DM + c0) = f8; }
                    const bf16x8 xh = __builtin_bit_cast(bf16x8, hi), xl = __builtin_bit_cast(bf16x8, lo);
#pragma unroll
                    for (int nt = 0; nt < 4; ++nt) {
                        lg[m2][nt] = MFMA16(wfl[nt], xh, lg[m2][nt]);
                        lg[m2][nt] = MFMA16(wfh[nt], xl, lg[m2][nt]);
                        lg[m2][nt] = MFMA16(wfh[nt], xh, lg[m2][nt]);
                    }
                }
            }
#pragma unroll
            for (int m2 = 0; m2 < 2; ++m2)
#pragma unroll
                for (int nt = 0; nt < 4; ++nt) *(f32x4*)(pl + (wid * 64 + 16 * (2 * mh + m2) + li_) * 64 + 16 * nt + 4 * q_) = lg[m2][nt];
        }
        if (wid == 0) lcnt[lane_] = 0u;
        __syncthreads();
        const float rbias = rb[lane_];
        unsigned selmask = 0u; unsigned lpos[8]; float lw[8]; int lrank[8];
#pragma unroll
        for (int k = 0; k < 8; ++k) {
            const int tk = wid * 8 + k;
            float logit = 0.f;
#pragma unroll
            for (int w = 0; w < 8; ++w) logit += pl[(w * 64 + tk) * 64 + lane_];
            const float score = 1.0f / (1.0f + expf(-logit));
            const float biased = score + rbias;
            float m1 = biased;
            m1 = fmaxf(m1, shx(m1, 1, lane_)); m1 = fmaxf(m1, shx(m1, 2, lane_)); m1 = fmaxf(m1, shx(m1, 4, lane_));
            const unsigned long long eqm = __ballot(biased == m1);
            const int g = lane_ >> 3;
            const unsigned gbits = (unsigned)((eqm >> (8 * g)) & 0xffull);
            const int first = __builtin_ctz(gbits);
            float m2 = ((lane_ & 7) == first) ? -3.0e38f : biased;
            m2 = fmaxf(m2, shx(m2, 1, lane_)); m2 = fmaxf(m2, shx(m2, 2, lane_)); m2 = fmaxf(m2, shx(m2, 4, lane_));
            const float gs = m1 + m2;
            const unsigned gsu = __float_as_uint(gs), gkey = ((gsu ^ ((gsu >> 31) ? 0xffffffffu : 0x80000000u)) & ~7u) | (unsigned)(7 - g);
            int grank = 0;
#pragma unroll
            for (int g2 = 0; g2 < 8; ++g2) grank += ((unsigned)__builtin_amdgcn_readlane((int)gkey, 8 * g2) > gkey) ? 1 : 0;
            const bool gsel = grank < 4;
            const unsigned bu = __float_as_uint(biased), vkey = gsel ? (((bu ^ ((bu >> 31) ? 0xffffffffu : 0x80000000u)) & ~63u) | (unsigned)(63 - lane_)) : 0u;
            int rank = 0;
            const unsigned long long gm = __ballot(gsel);
#pragma unroll
            for (int g2 = 0; g2 < 8; ++g2)
                if ((gm >> (8 * g2)) & 1ull) {
#pragma unroll
                    for (int i2 = 0; i2 < 8; ++i2) rank += ((unsigned)__builtin_amdgcn_readlane((int)vkey, 8 * g2 + i2) > vkey) ? 1 : 0;
                }
            const bool sel = gsel && rank < 8;
            const float wsum = wave_sum_l(sel ? score : 0.f, lane_);
            lw[k] = score / wsum * 2.5f; lrank[k] = rank; lpos[k] = 0u;
            if (sel) { selmask |= 1u << k; lpos[k] = atomicAdd(&lcnt[lane_], 1u); }
        }
        __syncthreads();
        if (wid == 0) lcnt[64 + lane_] = atomicAdd(&counts[lane_ * 64], lcnt[lane_]);
        __syncthreads();
        {
            const unsigned gbase = lcnt[64 + lane_];
#pragma unroll
            for (int k = 0; k < 8; ++k)
                if (selmask & (1u << k)) {
                    const unsigned pos = gbase + lpos[k];
                    ltok[(size_t)lane_ * T_TOK + pos] = m0 + wid * 8 + k;
                    float2 kw; kw.x = __int_as_float(lrank[k]); kw.y = lw[k];
                    lkw[(size_t)lane_ * T_TOK + pos] = kw;
                }
        }
    }
}

struct BlkTab { int start[65]; int total; };
__device__ __forceinline__ void build_blktab(const unsigned* counts, int* tab  , const int wv_) {
    if (WV == 0) {
        const int lane = lane_id();
        const int nb = ((int)counts[lane * 64] + 255) >> 8;
        int incl = nb;
#pragma unroll
        for (int o = 1; o < 64; o <<= 1) { const int v = __shfl_up(incl, o); if (lane >= o) incl += v; }
        tab[lane] = incl - nb;
        if (lane == 63) tab[64] = incl;
    }
    __syncthreads();
}
__device__ __forceinline__ int find_expert(const int* tab, int blk) {
    int e = 0;
#pragma unroll 1
    for (int s = 32; s >= 1; s >>= 1) if (e + s < 64 && tab[e + s] <= blk) e += s;
    return e;
}

constexpr int P6_TAB_OFF = pg8::STAGE_BYTES;
constexpr int P6_UT_OFF = P6_TAB_OFF + 512;
__device__ __forceinline__ int unit_index(int i) { const int G_ = gridDim.x, c_ = blockIdx.x; return i * G_ + ((G_ & 7) == 0 ? (c_ & 7) * (G_ >> 3) + (c_ >> 3) : c_); }
struct Sched6a {
    static constexpr bool VARK = false;
    unsigned char* ws; const int* ut;
    __device__ static void build(const unsigned char* ws, const int* tab, int* ut, const int wv_) {
        if (WV == 0) {
            const int i = lane_id();
            if (i < 16) {
                const int nbr = tab[64], L = unit_index(i), n_r = 2 * nbr, n_s = 2 * NBLK_S;
                int e = -1, pm = 0, pn = 0, bin = 0, cnt = 0;
                if (L < n_r + n_s) {
                    const int blk = L >> 1; pn = L & 1;
                    if (L < n_r) { e = find_expert(tab, blk); bin = blk - tab[e]; cnt = (int)((const unsigned*)(ws + WS_CTRL))[e * 64]; pm = blk; }
                    else { e = 64; bin = blk - nbr; cnt = T_TOK; pm = MAXBLK_R + bin; }
                } else { const int x = L - n_r - n_s; if (x < 256) { e = 65; pm = x >> 2; pn = x & 3; bin = x >> 2; cnt = T_TOK; } }
                int* d = ut + 8 * i; d[0] = e; d[1] = pm; d[2] = pn; d[3] = bin; d[4] = cnt;
            }
        }
        __syncthreads();
    }
    __device__ bool next(int i, pg8::Unit& u) const {
        const pg8::i32x4_t a = *(const pg8::i32x4_t*)(ut + 8 * i); const int cnt = ut[8 * i + 4];
        const int e = rfl(a.x);
        if (e < 0) return false;
        u.pm = rfl(a.y); u.pn = rfl(a.z); u.x0 = e; u.x1 = rfl(a.w); u.x2 = rfl(cnt); u.x3 = 0;
        u.A = (const char*)(ws + WS_X1F8);
        u.B = e == 65 ? (const char*)(ws + WS_WGATE) + (size_t)(u.pn * 256) * DM : (const char*)(ws + WS_WGUT) + ((size_t)e * 512 + 256 * u.pn) * DM;
        return true;
    }
    __device__ int arow(const pg8::Unit& u, int r) const {
        const int pos = u.x1 * 256 + r;
        if (u.x0 >= 64) return pos;
        return pos < u.x2 ? ((const int*)(ws + WS_LTOK))[(size_t)u.x0 * T_TOK + pos] : 0;
    }
    __device__ int arow_lds(const pg8::Unit& u, int r, const PG8_LAS unsigned char* meta) const {
        const int pos = u.x1 * 256 + r;
        if (u.x0 >= 64) return pos;
        return pos < u.x2 ? ((const PG8_LAS int*)(meta + 2048))[r] : 0;
    }
};
struct Epi6a {
    static constexpr bool PERM = false; static constexpr int NMETA = 3;
    unsigned char* ws;
    __device__ const char* meta_src(const pg8::Unit& u, int i) const {
        const size_t base = (size_t)(u.x0 & 63) * T_TOK + (size_t)u.x1 * 256;
        return i < 2 ? (const char*)(ws + WS_LKW) + base * 8 + i * 1024 : (const char*)(ws + WS_LTOK) + base * 4;
    }
    __device__ __forceinline__ void operator()(const f32x4 (&acc)[2][2][4][2], const pg8::Unit& u, int wr, int wc, int fr_, int fq_, const PG8_LAS unsigned char* meta) const {
        int fr = fr_, fq = fq_; asm volatile("" : "+v"(fr), "+v"(fq));
        if (u.x0 == 65) {
            const bf16_t* proj = (const bf16_t*)(ws + WS_PLE); unsigned char* ple8 = ws + WS_PLE8;
#pragma unroll
            for (int ai = 0; ai < 2; ++ai)
#pragma unroll
                for (int m = 0; m < 4; ++m) {
                    const size_t t = u.pm * 256 + 128 * ai + 64 * wr + 16 * m + fr;
                    const int c0 = u.pn * 256 + 64 * wc + 16 * fq;
                    const u32x4 p0 = *(const u32x4*)(proj + t * DM + c0), p1 = *(const u32x4*)(proj + t * DM + c0 + 8);
                    const unsigned pj[8] = {p0.x, p0.y, p0.z, p0.w, p1.x, p1.y, p1.z, p1.w};
                    unsigned o[4];
#pragma unroll
                    for (int bj = 0; bj < 2; ++bj)
#pragma unroll
                        for (int n = 0; n < 2; ++n) {
                            const f32x4 a = acc[ai][bj][m][n] * GU_DESCALE;
                            const unsigned q0 = pj[4 * bj + 2 * n], q1 = pj[4 * bj + 2 * n + 1];
                            o[2 * bj + n] = pk4_fp8(sigmoidf_(a[0]) * bflo(q0) * PLE_SCALE, sigmoidf_(a[1]) * bfhi(q0) * PLE_SCALE, sigmoidf_(a[2]) * bflo(q1) * PLE_SCALE, sigmoidf_(a[3]) * bfhi(q1) * PLE_SCALE);
                        }
                    u32x4 w; w.x = o[0]; w.y = o[1]; w.z = o[2]; w.w = o[3];
                    *(u32x4*)(ple8 + t * DM + c0) = w;
                    asm volatile("" ::: "memory");
                }
        } else {
            unsigned char* Hb = ws + WS_HBUF;
#pragma unroll
            for (int ai = 0; ai < 2; ++ai)
#pragma unroll
                for (int m = 0; m < 4; ++m) {
                    const int row = 128 * ai + 64 * wr + 16 * m + fr, pos = u.x1 * 256 + row;
                    float w = 1.0f;
                    if (u.x0 < 64) w = pos < u.x2 ? ((const PG8_LAS float*)meta)[2 * row + 1] : 0.f;
                    unsigned char* dst = Hb + ((size_t)u.pm * 256 + row) * EDIM + 128 * u.pn + 32 * wc + 8 * fq;
                    u32x2 wv; w *= H_SCALE * GU_DESCALE;
                    {
                        const f32x4 g = acc[ai][0][m][0] * GU_DESCALE, uu = acc[ai][1][m][0];
                        wv.x = pk4_fp8(siluf_(g[0]) * uu[0] * w, siluf_(g[1]) * uu[1] * w, siluf_(g[2]) * uu[2] * w, siluf_(g[3]) * uu[3] * w);
                    }
                    {
                        const f32x4 g = acc[ai][0][m][1] * GU_DESCALE, uu = acc[ai][1][m][1];
                        wv.y = pk4_fp8(siluf_(g[0]) * uu[0] * w, siluf_(g[1]) * uu[1] * w, siluf_(g[2]) * uu[2] * w, siluf_(g[3]) * uu[3] * w);
                    }
                    *(u32x2*)dst = wv;
                    asm volatile("" ::: "memory");
                }
        }
    }
};
__device__ void phase6a(const Params& p, unsigned char* lds, const int wv_) {
    int* tab = (int*)(lds + P6_TAB_OFF);
    build_blktab((const unsigned*)(p.ws + WS_CTRL), tab, wv_);
    int* ut = (int*)(lds + P6_UT_OFF);
    Sched6a::build(p.ws, tab, ut, wv_);
    Sched6a S; S.ws = p.ws; S.ut = ut;
    Epi6a E; E.ws = p.ws;
    pg8::gemm_phase<Epi6a, Sched6a, true, true, true, true>((PG8_LAS unsigned char*)lds, DM / 2, S, E, wv_);
}

struct Sched6b {
    static constexpr bool VARK = false;
    unsigned char* ws; const int* ut;
    __device__ static void build(const unsigned char* ws, const int* tab, int* ut, const int wv_) {
        if (WV == 0) {
            const int i = lane_id();
            if (i < 16) {
                const int nbr = tab[64], L = unit_index(i), n_r = 4 * nbr, n_s = 4 * NBLK_S;
                int e = -1, hblk = 0, pn = 0, bin = 0, cnt = 0;
                if (L < n_r + n_s) {
                    const int blk = L >> 2; pn = L & 3;
                    if (L < n_r) { e = find_expert(tab, blk); bin = blk - tab[e]; cnt = (int)((const unsigned*)(ws + WS_CTRL))[e * 64]; hblk = blk; }
                    else { e = 64; bin = blk - nbr; cnt = T_TOK; hblk = MAXBLK_R + bin; }
                }
                int* d = ut + 8 * i; d[0] = e; d[1] = hblk; d[2] = pn; d[3] = bin; d[4] = cnt;
            }
        }
        __syncthreads();
    }
    __device__ bool next(int i, pg8::Unit& u) const {
        const pg8::i32x4_t a = *(const pg8::i32x4_t*)(ut + 8 * i); const int cnt = ut[8 * i + 4];
        const int e = rfl(a.x);
        if (e < 0) return false;
        u.pm = rfl(a.y); u.pn = rfl(a.z); u.x0 = e; u.x1 = rfl(a.w); u.x2 = rfl(cnt); u.x3 = 0;
        u.A = (const char*)(ws + WS_HBUF) + (size_t)u.pm * 256 * EDIM; u.B = (const char*)(ws + WS_WDT) + ((size_t)e * 1024 + 256 * u.pn) * EDIM;
        return true;
    }
    __device__ int arow(const pg8::Unit&, int r) const { return r; }
};
struct Epi6b {
    static constexpr bool PERM = false;
    static constexpr int NMETA = 3;
    unsigned char* ws;
    __device__ const char* meta_src(const pg8::Unit& u, int i) const {
        const size_t base = (size_t)(u.x0 & 63) * T_TOK + (size_t)u.x1 * 256;
        return i < 2 ? (const char*)(ws + WS_LKW) + base * 8 + i * 1024 : (const char*)(ws + WS_LTOK) + base * 4;
    }
    __device__ __forceinline__ void operator()(const f32x4 (&acc)[2][2][4][2], const pg8::Unit& u, int wr, int wc, int fr_, int fq_, const PG8_LAS unsigned char* meta) const {
        int fr = fr_, fq = fq_; asm volatile("" : "+v"(fr), "+v"(fq));
        unsigned char* part = ws + WS_PART; unsigned char* sho = ws + WS_SHO;
#pragma unroll
        for (int ai = 0; ai < 2; ++ai)
#pragma unroll
            for (int m = 0; m < 4; ++m) {
                const int row = 128 * ai + 64 * wr + 16 * m + fr, pos = u.x1 * 256 + row;
                const int c0 = u.pn * 256 + 64 * wc + 16 * fq;
                if (u.x0 == 64) {
                    u32x4 w; unsigned wq[4];
#pragma unroll
                    for (int bj = 0; bj < 2; ++bj)
#pragma unroll
                        for (int n = 0; n < 2; ++n) {
                            const f32x4 a = acc[ai][bj][m][n] * (PART_SCALE * D_DESCALE);
                            unsigned x = (unsigned)__builtin_amdgcn_cvt_pk_fp8_f32(a[0], a[1], 0, false); x = (unsigned)__builtin_amdgcn_cvt_pk_fp8_f32(a[2], a[3], (int)x, true);
                            wq[2 * bj + n] = x;
                        }
                    w.x = wq[0]; w.y = wq[1]; w.z = wq[2]; w.w = wq[3];
                    *(u32x4*)(sho + (size_t)pos * DM + c0) = w;
                } else if (pos < u.x2) {
                    const int d = ((const PG8_LAS int*)(meta + 2048))[row] * 8 + ((const PG8_LAS int*)meta)[2 * row];
                    u32x4 w; unsigned wq[4];
#pragma unroll
                    for (int bj = 0; bj < 2; ++bj)
#pragma unroll
                        for (int n = 0; n < 2; ++n) {
                            const f32x4 a = acc[ai][bj][m][n] * (PART_SCALE * D_DESCALE);
                            unsigned x = (unsigned)__builtin_amdgcn_cvt_pk_fp8_f32(a[0], a[1], 0, false); x = (unsigned)__builtin_amdgcn_cvt_pk_fp8_f32(a[2], a[3], (int)x, true);
                            wq[2 * bj + n] = x;
                        }
                    w.x = wq[0]; w.y = wq[1]; w.z = wq[2]; w.w = wq[3];
                    *(u32x4*)(part + (size_t)d * DM + c0) = w;
                }
            }
    }
};
__device__ void phase6b(const Params& p, unsigned char* lds, const int wv_) {
    int* tab = (int*)(lds + P6_TAB_OFF);
    build_blktab((const unsigned*)(p.ws + WS_CTRL), tab, wv_);
    int* ut = (int*)(lds + P6_UT_OFF);
    Sched6b::build(p.ws, tab, ut, wv_);
    Sched6b S; S.ws = p.ws; S.ut = ut;
    Epi6b E; E.ws = p.ws;
    int kk = EDIM / 2; asm volatile("" : "+s"(kk));
    pg8::gemm_phase<Epi6b, Sched6b, false, true, true, true>((PG8_LAS unsigned char*)lds, kk, S, E, wv_);
}

__device__ void phase7(const Params& p, unsigned char* lds, const int wv_) {
    unsigned char* ws = p.ws;
    const int lane = lane_id(), wid = WV;
    const bf16_t* x1b = (const bf16_t*)(ws + WS_X1B); const unsigned char* ple = ws + WS_PLE8; const unsigned char* sho = ws + WS_SHO;
    const unsigned char* part = ws + WS_PART;
    const float* g2 = p.in[18]; const float* b2 = p.in[19];
    typedef float f32x2v __attribute__((ext_vector_type(2)));
    float* rowL = (float*)(lds + wid * 4096);
    for (int t0 = (blockIdx.x * 8 + wid) * 2; t0 < T_TOK; t0 += gridDim.x * 16) {
        u32x4 xr[2][2]; u32x2 pr[2][2], ar[2][2][9];
#pragma unroll
        for (int tt = 0; tt < 2; ++tt)
#pragma unroll
            for (int hf = 0; hf < 2; ++hf) {
                const size_t t = t0 + tt; const int c0 = 512 * hf + 8 * lane;
                xr[tt][hf] = *(const u32x4*)(x1b + t * DM + c0); pr[tt][hf] = *(const u32x2*)(ple + t * DM + c0); ar[tt][hf][8] = *(const u32x2*)(sho + t * DM + c0);
#pragma unroll
                for (int k = 0; k < 8; ++k) ar[tt][hf][k] = *(const u32x2*)(part + (t * 8 + k) * DM + c0);
            }
#pragma unroll
        for (int tt = 0; tt < 2; ++tt) {
            const size_t t = t0 + tt;
            float v[16];
#pragma unroll
            for (int hf = 0; hf < 2; ++hf) {
                float rsum[8];
#pragma unroll
                for (int i = 0; i < 8; ++i) rsum[i] = 0.f;
#pragma unroll
                for (int k = 0; k < 9; ++k) {
                    const u32x2 a = ar[tt][hf][k];
                    const f32x2v l0 = __builtin_amdgcn_cvt_pk_f32_fp8((int)a.x, false), h0 = __builtin_amdgcn_cvt_pk_f32_fp8((int)a.x, true);
                    const f32x2v l1 = __builtin_amdgcn_cvt_pk_f32_fp8((int)a.y, false), h1 = __builtin_amdgcn_cvt_pk_f32_fp8((int)a.y, true);
                    rsum[0] += l0[0]; rsum[1] += l0[1]; rsum[2] += h0[0]; rsum[3] += h0[1]; rsum[4] += l1[0]; rsum[5] += l1[1]; rsum[6] += h1[0]; rsum[7] += h1[1];
                }
                const u32x4 xv = xr[tt][hf]; const u32x2 pv = pr[tt][hf];
                const unsigned xw[4] = {xv.x, xv.y, xv.z, xv.w};
                const f32x2v pl0 = __builtin_amdgcn_cvt_pk_f32_fp8((int)pv.x, false), ph0 = __builtin_amdgcn_cvt_pk_f32_fp8((int)pv.x, true);
                const f32x2v pl1 = __builtin_amdgcn_cvt_pk_f32_fp8((int)pv.y, false), ph1 = __builtin_amdgcn_cvt_pk_f32_fp8((int)pv.y, true);
                const float pf[8] = {pl0[0], pl0[1], ph0[0], ph0[1], pl1[0], pl1[1], ph1[0], ph1[1]};
#pragma unroll
                for (int j = 0; j < 4; ++j) {
                    v[8 * hf + 2 * j]     = ALPHA * bflo(xw[j]) + pf[2 * j] * (1.0f / PLE_SCALE) + rsum[2 * j] * (1.0f / PART_SCALE);
                    v[8 * hf + 2 * j + 1] = ALPHA * bfhi(xw[j]) + pf[2 * j + 1] * (1.0f / PLE_SCALE) + rsum[2 * j + 1] * (1.0f / PART_SCALE);
                }
            }
            float s = 0.f;
#pragma unroll
            for (int i = 0; i < 16; ++i) s += v[i];
            const float mu = wave_sum(s) * (1.0f / 1024.0f);
            float qv = 0.f;
#pragma unroll
            for (int i = 0; i < 16; ++i) { const float d = v[i] - mu; qv += d * d; }
            const float rstd = rsqrtf(wave_sum(qv) * (1.0f / 1024.0f) + 1e-5f);
#pragma unroll
            for (int hf = 0; hf < 2; ++hf)
#pragma unroll
                for (int j = 0; j < 2; ++j) {
                    f32x4 o;
#pragma unroll
                    for (int r = 0; r < 4; ++r) o[r] = (v[8 * hf + 4 * j + r] - mu) * rstd;
                    *(f32x4*)(rowL + 512 * hf + 8 * lane + 4 * j) = o;
                }
#pragma unroll
            for (int i = 0; i < 4; ++i) {
                const int c = 256 * i + 4 * lane;
                const f32x4 y = *(const f32x4*)(rowL + c), gg = *(const f32x4*)(g2 + c), bb = *(const f32x4*)(b2 + c);
                *(f32x4*)(p.out + t * DM + c) = y * gg + bb;
            }
        }
    }
}

#define XB_TMO      128
#define XB_XCNT(j)  (256  + 64 * (j))
#define XB_XSUB(j)  (1280 + 64 * (j))
#define XB_XGEN(j)  (2304 + 64 * (j))
#define XB_TOP      3328
#define XB_TOPGEN   3392
#define XCD_BAR_WORDS 3456
#define XB_SPIN_CAP (1u << 18)
#define LAS __attribute__((address_space(3)))
__device__ __forceinline__ unsigned xb_ld(unsigned* p)              { return __hip_atomic_load(p, __ATOMIC_RELAXED, __HIP_MEMORY_SCOPE_AGENT); }
__device__ __forceinline__ unsigned xb_add(unsigned* p, unsigned v) { return __hip_atomic_fetch_add(p, v, __ATOMIC_RELAXED, __HIP_MEMORY_SCOPE_AGENT); }
__device__ __forceinline__ unsigned xb_xcc_id() { return (unsigned)__builtin_amdgcn_s_getreg((3 << 11) | 20) & 0xFu; }
#define XB_SPIN(cond, bar) do { unsigned _sp = 0; while (cond) { __builtin_amdgcn_s_sleep(1); \
    if ((++_sp & 255u) == 0u) { if (xb_ld(&(bar)[XB_TMO])) break; if (_sp > XB_SPIN_CAP) { atomicAdd(&(bar)[XB_TMO], 1u); break; } } } } while (0)
struct XcdBarrier { unsigned* bar; unsigned x; volatile LAS unsigned* st; };
__device__ __forceinline__ XcdBarrier xcd_barrier_post(unsigned* bar, volatile LAS unsigned* st, const int wv_) {
    XcdBarrier b; b.bar = bar; b.x = xb_xcc_id(); b.st = st;
    if (WV == 0 && lane_id() == 0) (void)xb_add(&bar[XB_XCNT(b.x)], 1u);
    return b;
}
__device__ __forceinline__ void xcd_barrier_complete(unsigned* bar, unsigned x, unsigned& nloc, unsigned& nx) {
    const unsigned G = gridDim.x * gridDim.y * gridDim.z;
    unsigned sum, cnt, mine, sp = 0u;
    for (;;) {
        sum = 0u; cnt = 0u; mine = 0u;
#pragma unroll
        for (unsigned j = 0; j < 16; ++j) { const unsigned c = xb_ld(&bar[XB_XCNT(j)]); sum += c; cnt += (c > 0u) ? 1u : 0u; mine = (j == x) ? c : mine; }
        if (sum == G) break;
        __builtin_amdgcn_s_sleep(1);
        if ((++sp & 255u) == 0u) { if (xb_ld(&bar[XB_TMO])) break; if (sp > XB_SPIN_CAP) { atomicAdd(&bar[XB_TMO], 1u); break; } }
    }
    nloc = mine > 0u ? mine : 1u; nx = cnt > 0u ? cnt : 1u;
}
__device__ __forceinline__ void xcd_barrier(const XcdBarrier& b, const int wv_) {
    asm volatile("s_waitcnt vmcnt(0)" ::: "memory");
    __syncthreads();
    if (WV == 0 && lane_id() == 0) {
        unsigned* bar = b.bar;
        __builtin_amdgcn_s_waitcnt(0);
        unsigned nloc = b.st[0], nx = b.st[1];
        if (nloc == 0u) { xcd_barrier_complete(bar, b.x, nloc, nx); b.st[0] = nloc; b.st[1] = nx; }
        const unsigned old = xb_add(&bar[XB_XSUB(b.x)], 1u);
        const unsigned gen = old / nloc;
        if (old + 1u == (gen + 1u) * nloc) {
            __builtin_amdgcn_fence(__ATOMIC_RELEASE, "agent");
            asm volatile("s_waitcnt vmcnt(0)" ::: "memory");
            const unsigned og = xb_add(&bar[XB_TOP], 1u);
            const unsigned tg = og / nx;
            if (og + 1u == (tg + 1u) * nx) xb_add(&bar[XB_TOPGEN], 1u);
            else XB_SPIN(xb_ld(&bar[XB_TOPGEN]) == tg, bar);
            __builtin_amdgcn_fence(__ATOMIC_ACQUIRE, "agent");
            xb_add(&bar[XB_XGEN(b.x)], 1u);
            asm volatile("s_waitcnt vmcnt(0)" ::: "memory");
        } else {
            XB_SPIN(xb_ld(&bar[XB_XGEN(b.x)]) == gen, bar);
            __builtin_amdgcn_fence(__ATOMIC_ACQUIRE, "agent");
            asm volatile("s_waitcnt vmcnt(0)" ::: "memory");
        }
    }
    __syncthreads();
}

constexpr int LDS_TOTAL = 152 * 1024;
constexpr int NPHASE = 8;

constexpr size_t CTRL_BAR_OFF = 65536;
constexpr size_t CTRL_ZERO_BYTES = 131072;

__global__ void __launch_bounds__(NTHREADS) mega_kernel(Params p) {
    extern __shared__ __attribute__((aligned(16))) unsigned char smem[];
    const int wv_ = __builtin_amdgcn_readfirstlane((int)(threadIdx.x >> 6));
    volatile LAS unsigned* bst = (volatile LAS unsigned*)(smem + LDS_TOTAL - 16);
    XcdBarrier xb;
    if (p.sync) {
        if (WV == 0 && lane_id() == 0) { bst[0] = 0u; bst[1] = 0u; }
        __syncthreads();
        xb = xcd_barrier_post((unsigned*)(p.ws + WS_CTRL + CTRL_BAR_OFF), bst, wv_);
    }
#define RUN_PHASE(i, call) if (p.ph_lo <= (i) && (i) < p.ph_hi) { call; if (p.sync && (i) + 1 < p.ph_hi) { xcd_barrier(xb, wv_); } }
    RUN_PHASE(0, phase0(p, smem, wv_))
    RUN_PHASE(1, phase1(p, smem, wv_))
    RUN_PHASE(2, phase2(p, smem, wv_))
    RUN_PHASE(3, phase3(p, smem, wv_))
    RUN_PHASE(4, phase4(p, smem, wv_))
    RUN_PHASE(5, phase6a(p, smem, wv_))
    RUN_PHASE(6, phase6b(p, smem, wv_))
    RUN_PHASE(7, phase7(p, smem, wv_))
#undef RUN_PHASE
}

extern "C" void kernel_launch(void* const* d_in, const int* in_sizes, int n_in, void* d_out, int out_size, void* d_ws, size_t ws_size, hipStream_t stream) {
    static int grid_blocks = 0;
    if (grid_blocks == 0) {
        if (n_in != 20 || ws_size < WS_END) { fprintf(stderr, "kernel_launch: unexpected n_in %d / ws_size %zu (need %zu)\n", n_in, ws_size, (size_t)WS_END); grid_blocks = -1; return; }
        int dev = 0, cus = 0, per_cu = 0;
        hipGetDevice(&dev);
        hipDeviceGetAttribute(&cus, hipDeviceAttributeMultiprocessorCount, dev);
        if (hipFuncSetAttribute((const void*)mega_kernel, hipFuncAttributeMaxDynamicSharedMemorySize, LDS_TOTAL) != hipSuccess) { fprintf(stderr, "kernel_launch: hipFuncSetAttribute failed\n"); grid_blocks = -1; return; }
        if (hipOccupancyMaxActiveBlocksPerMultiprocessor(&per_cu, (const void*)mega_kernel, NTHREADS, LDS_TOTAL) != hipSuccess || per_cu < 1) { fprintf(stderr, "kernel_launch: occupancy query failed (%d)\n", per_cu); per_cu = 1; }
        (void)hipGetLastError();
        if (per_cu > 1) per_cu = 1;
        grid_blocks = cus * per_cu;
    }
    if (grid_blocks < 0) return;
    (void)hipMemsetAsync((char*)d_ws + WS_CTRL, 0, CTRL_ZERO_BYTES, stream);
    Params p{};
    for (int i = 0; i < 20; ++i) p.in[i] = (const float*)d_in[i];
    p.out = (float*)d_out; p.ws = (unsigned char*)d_ws;
#if MK_SINGLE
    p.ph_lo = 0; p.ph_hi = NPHASE; p.sync = 1;
    void* args[] = {&p};
    hipError_t e = hipLaunchCooperativeKernel((const void*)mega_kernel, dim3(grid_blocks), dim3(NTHREADS), args, LDS_TOTAL, stream);
    if (e != hipSuccess) fprintf(stderr, "cooperative launch failed: %s (grid %d)\n", hipGetErrorString(e), grid_blocks);
#else
    for (int ph = 0; ph < NPHASE; ++ph) {
        p.ph_lo = ph; p.ph_hi = ph + 1; p.sync = 0;
        hipLaunchKernelGGL(mega_kernel, dim3(grid_blocks), dim3(NTHREADS), LDS_TOTAL, stream, p);
#ifdef PROBE_REPEAT
        if (ph == PROBE_REPEAT) {
            for (int rep = 0; rep < 2; ++rep) {
                if (ph == 4 || ph == 2) (void)hipMemsetAsync((char*)d_ws + WS_CTRL, 0, 16384, stream);
                hipLaunchKernelGGL(mega_kernel, dim3(grid_blocks), dim3(NTHREADS), LDS_TOTAL, stream, p);
            }
        }
#endif
    }
#endif
}
```

```cpp
#include <hip/hip_runtime.h>
#include <hip/hip_cooperative_groups.h>
#include <cstdio>
#include <cstdint>
#include <cmath>
namespace cg = cooperative_groups;

#ifndef MK_SINGLE
#define MK_SINGLE 1
#endif

typedef unsigned short bf16_t;
typedef short bf16x8 __attribute__((ext_vector_type(8)));
typedef short bf16x4 __attribute__((ext_vector_type(4)));
typedef float f32x4 __attribute__((ext_vector_type(4)));
typedef unsigned u32x4 __attribute__((ext_vector_type(4)));
typedef unsigned u32x2 __attribute__((ext_vector_type(2)));

constexpr int T_TOK = 16384, DM = 1024, SEQ = 4096, NB_ = 4, PLE = 256;
constexpr int NPROJ = 3584, NEXP = 64, EDIM = 256, TOPK = 8;
constexpr int NTHREADS = 512;
constexpr float ALPHA = 1.189207115002721f;
constexpr float LOG2E = 1.4426950408889634f;
constexpr float PART_SCALE = 128.0f;
constexpr float WGU_SCALE = 32.0f, X1_SCALE = 4.0f, GU_DESCALE = 1.0f / (32.0f * 4.0f);
constexpr float H_SCALE = 4.0f, WD_SCALE = 32.0f, D_DESCALE = 1.0f / (4.0f * 32.0f);
constexpr float MIX_SCALE = 16.0f, WO_SCALE = 64.0f, O_DESCALE = 1.0f / (16.0f * 64.0f);
constexpr float PLE_SCALE = 16.0f;
constexpr float X8_SCALE = 8.0f, WIN8_SCALE = 32.0f, NA_DESCALE = 1.0f / (8.0f * 32.0f);
constexpr float P8_SCALE = 8.0f, WP8_SCALE = 32.0f, PLEP_DESCALE = 1.0f / (8.0f * 32.0f);
constexpr int MAXBLK_R = 576;
constexpr int NBLK_S = 64;

constexpr size_t MiB = 1024ull * 1024ull;
constexpr size_t WS_WDT   = 0;
constexpr size_t WS_CTRL  = 33 * MiB;
constexpr size_t WS_WRF   = 33 * MiB + 262144;
constexpr size_t WS_LGT   = 33 * MiB + 61440;
constexpr size_t WS_LTOK  = 34 * MiB;
constexpr size_t WS_LKW   = 38 * MiB;
constexpr size_t WS_ROPE  = 46 * MiB;
constexpr size_t WS_X1B   = 48 * MiB;
constexpr size_t WS_PLE   = 80 * MiB;
constexpr size_t WS_WPT   = 112 * MiB;
constexpr size_t WS_PB    = 113 * MiB;
constexpr size_t WS_HBUF  = 121 * MiB;
constexpr size_t WS_PART  = 201 * MiB;
constexpr size_t WS_SHO   = 329 * MiB;
constexpr size_t WS_PLE8  = 345 * MiB;
constexpr size_t WS_WGUT  = 201 * MiB;
constexpr size_t WS_WGATE = 266 * MiB;
constexpr size_t WS_WINT  = 268 * MiB;
constexpr size_t WS_WOUTT = 275 * MiB;
constexpr size_t WS_XB    = 277 * MiB;
constexpr size_t WS_X1F8  = 17 * MiB;
constexpr size_t WS_Q     = 309 * MiB;
constexpr size_t WS_K     = 325 * MiB;
constexpr size_t WS_KT    = 341 * MiB;
constexpr size_t WS_VT    = 357 * MiB;
constexpr size_t WS_G     = 373 * MiB;
constexpr size_t WS_NQ    = 389 * MiB;
constexpr size_t WS_NK    = 405 * MiB;
constexpr size_t WS_NVT   = 421 * MiB;
constexpr size_t WS_SST   = 437 * MiB;
constexpr size_t WS_MIX   = 469 * MiB;
constexpr size_t WS_X8    = 234 * MiB;
constexpr size_t WS_WIN8  = 485 * MiB;
constexpr size_t WS_END   = 501 * MiB;

__constant__ double INV_FREQ[32] = {1.0, 0.7498942093324559, 0.5623413251903491, 0.4216965034285822, 0.31622776601683794, 0.23713737056616552, 0.1778279410038923, 0.1333521432163324, 0.1, 0.07498942093324558, 0.05623413251903491, 0.042169650342858224, 0.03162277660168379, 0.023713737056616554, 0.01778279410038923, 0.01333521432163324, 0.01, 0.007498942093324558, 0.005623413251903491, 0.004216965034285823, 0.0031622776601683794, 0.0023713737056616554, 0.0017782794100389228, 0.001333521432163324, 0.001, 0.0007498942093324559, 0.0005623413251903491, 0.00042169650342858224, 0.00031622776601683794, 0.00023713737056616554, 0.00017782794100389227, 0.0001333521432163324};
struct Params {
    const float* in[20];
    float* out;
    unsigned char* ws;
    int ph_lo, ph_hi, sync, pad;
};

__device__ __forceinline__ unsigned cvt_pk_bf16(float lo, float hi) { unsigned r; asm volatile("v_cvt_pk_bf16_f32 %0, %1, %2" : "=v"(r) : "v"(lo), "v"(hi)); return r; }
__device__ __forceinline__ float bf2f(unsigned short v) { return __uint_as_float(((unsigned)v) << 16); }
__device__ __forceinline__ float bflo(unsigned v) { return __uint_as_float(v << 16); }
__device__ __forceinline__ float bfhi(unsigned v) { return __uint_as_float(v & 0xffff0000u); }
__device__ __forceinline__ unsigned short f2bf(float f) { return (unsigned short)(cvt_pk_bf16(f, 0.f) & 0xffffu); }
__device__ __forceinline__ float fast_exp2(float x) { return __builtin_amdgcn_exp2f(x); }
__device__ __forceinline__ float sigmoidf_(float x) { return __builtin_amdgcn_rcpf(1.0f + __expf(-x)); }
__device__ __forceinline__ float siluf_(float x) { return x * __builtin_amdgcn_rcpf(1.0f + __expf(-x)); }
__device__ __forceinline__ float wave_sum(float v) {
#pragma unroll
    for (int o = 32; o >= 1; o >>= 1) v += __shfl_xor(v, o);
    return v;
}
__device__ __forceinline__ int rfl(int v) { return __builtin_amdgcn_readfirstlane(v); }
__device__ __forceinline__ size_t rfl64(size_t v) { return ((size_t)(unsigned)__builtin_amdgcn_readfirstlane((int)(v >> 32)) << 32) | (size_t)(unsigned)__builtin_amdgcn_readfirstlane((int)(unsigned)v); }
#define WV wv_
__device__ __forceinline__ int lane_id() { return (int)__builtin_amdgcn_mbcnt_hi(~0u, __builtin_amdgcn_mbcnt_lo(~0u, 0u)); }
__device__ __forceinline__ float readlane_f(float v, int l) { return __uint_as_float((unsigned)__builtin_amdgcn_readlane((int)__float_as_uint(v), l)); }
__device__ __forceinline__ float shx(float v, int m, int lane_) { return __uint_as_float((unsigned)__builtin_amdgcn_ds_bpermute((lane_ ^ m) << 2, (int)__float_as_uint(v))); }
__device__ __forceinline__ float wave_sum_l(float v, int lane_) {
#pragma unroll
    for (int o = 32; o >= 1; o >>= 1) v += shx(v, o, lane_);
    return v;
}
#define MFMA16(a, b, c) __builtin_amdgcn_mfma_f32_16x16x32_bf16((a), (b), (c), 0, 0, 0)

namespace pg8 {
#define PG8_LAS __attribute__((address_space(3)))
constexpr int BM = 256, BK = 64, HALF = 128, HTB = HALF * BK * 2, STAGE_BYTES = 8 * HTB, NXCD = 8, WGM = 8;
constexpr int PG8_META_OFF = STAGE_BYTES + 2048;
__host__ __device__ __forceinline__ int lds_byte(int r, int c) { const int st = (r >> 4) * 2 + (c >> 5), rr = r & 15, cc = c & 31, ob = rr * 64 + cc * 2; return st * 1024 + (ob ^ (((ob >> 9) & 1) << 5)); }
__host__ __device__ __forceinline__ void stage_rc(int b, int& R, int& C) { const int st = b / 1024, sb = b % 1024, swz = sb ^ (((sb >> 9) & 1) << 5); R = (st >> 1) * 16 + swz / 64; C = (st & 1) * 32 + (swz % 64) / 2; }
__host__ __device__ __forceinline__ int perm32(int rho) { const int n = rho >> 4, i = rho & 15; return 8 * (i >> 2) + 4 * n + (i & 3); }

typedef int i32x4_t __attribute__((ext_vector_type(4)));
typedef int i32x8_t __attribute__((ext_vector_type(8)));
__device__ __forceinline__ i32x8_t cat8(const bf16x8& a, const bf16x8& b) { return __builtin_shufflevector(__builtin_bit_cast(i32x4_t, a), __builtin_bit_cast(i32x4_t, b), 0, 1, 2, 3, 4, 5, 6, 7); }
struct Unit { const char* A; const char* B; int pm, pn, x0, x1, x2, x3; };

struct TileOrder {
    int nM, nN, nwg;
    __device__ void init(int M, int N) { nM = M / BM; nN = N / BM; nwg = nM * nN; }
    __device__ bool map(long L, int& pm, int& pn) const {
        if (L >= nwg) return false;
        int wgid = (int)L; { const int q = nwg / NXCD, r = nwg % NXCD, xcd = wgid % NXCD, off = wgid / NXCD; wgid = (xcd < r ? xcd * (q + 1) : r * (q + 1) + (xcd - r) * q) + off; }
        const int nig = WGM * nN, gid = wgid / nig, fm = gid * WGM, gsz = (nM - fm) < WGM ? (nM - fm) : WGM;
        pm = fm + ((wgid % nig) % gsz); pn = (wgid % nig) / gsz; return true;
    }
};

template <class Epi, class Sched, bool GATHER, bool ALIGN_EPI, bool SP2, bool FP8 = false>
__device__ __forceinline__ void gemm_phase(PG8_LAS unsigned char* lds, const int K, const Sched& S, const Epi& E, const int wv_) {
    const int wid = WV, lane = lane_id(), tid = wid * 64 + lane, wr = wid >> 2, wc = wid & 3, fr = lane & 15, fq = lane >> 4;
    unsigned vA[2][2], vN[2][2], vB[2][2];
#pragma unroll
    for (int i = 0; i < 2; ++i) { int R, C; stage_rc(tid * 16 + i * 8192, R, C); const int Rb = Epi::PERM ? ((R & ~31) + perm32(R & 31)) : R;
#pragma unroll
        for (int h = 0; h < 2; ++h) { vA[h][i] = (unsigned)((R + 128 * h) * K + C) * 2u; vN[h][i] = vA[h][i]; vB[h][i] = (unsigned)((Rb + 128 * h) * K + C) * 2u; } }
    const size_t kstep = (size_t)(BK * 2);
    const unsigned ldsw = (unsigned)wid * 1024u;
    const int aoff = lds_byte(wr * 64 + fr, fq * 8), boff = lds_byte(wc * 32 + fr, fq * 8);
#define PG8_SA(b, h) (((b) * 2 + (h)) * HTB)
#define PG8_SB(b, h) ((4 + (b) * 2 + (h)) * HTB)
#define PG8_STAGE(bufoff, gbase, voff) do { _Pragma("unroll") for (int _i = 0; _i < 2; ++_i) \
        __builtin_amdgcn_global_load_lds((const unsigned*)((const char*)(gbase) + (voff)[_i]), (PG8_LAS unsigned*)(lds + (bufoff) + ldsw + _i * 8192), 16, 0, 0); } while (0)
#define PG8_LDA(dst, b, h) do { _Pragma("unroll") for (int m = 0; m < 4; ++m) _Pragma("unroll") for (int k = 0; k < 2; ++k) dst[m][k] = *(const PG8_LAS bf16x8*)(lds + PG8_SA(b, h) + aoff + m * 2048 + k * 1024); } while (0)
#define PG8_LDB(dst, b, h) do { _Pragma("unroll") for (int n = 0; n < 2; ++n) _Pragma("unroll") for (int k = 0; k < 2; ++k) dst[n][k] = *(const PG8_LAS bf16x8*)(lds + PG8_SB(b, h) + boff + n * 2048 + k * 1024); } while (0)
#define PG8_MMA(ai, bj, At, Bt) do { __builtin_amdgcn_s_setprio(1); _Pragma("unroll") for (int m = 0; m < 4; ++m) _Pragma("unroll") for (int n = 0; n < 2; ++n) { \
        if constexpr (FP8) { const i32x8_t _b8 = cat8(Bt[n][0], Bt[n][1]), _a8 = cat8(At[m][0], At[m][1]); asm volatile("v_mfma_f32_16x16x128_f8f6f4 %0, %1, %2, %0" : "+v"(acc[ai][bj][m][n]) : "v"(_b8), "v"(_a8)); } \
        else { _Pragma("unroll") for (int k = 0; k < 2; ++k) acc[ai][bj][m][n] = __builtin_amdgcn_mfma_f32_16x16x32_bf16(Bt[n][k], At[m][k], acc[ai][bj][m][n], 0, 0, 0); } } __builtin_amdgcn_s_setprio(0); } while (0)
#define PG8_MMA0(ai, bj, At, Bt) do { __builtin_amdgcn_s_setprio(1); _Pragma("unroll") for (int m = 0; m < 4; ++m) _Pragma("unroll") for (int n = 0; n < 2; ++n) { \
        const i32x8_t _b8 = cat8(Bt[n][0], Bt[n][1]), _a8 = cat8(At[m][0], At[m][1]); asm volatile("v_mfma_f32_16x16x128_f8f6f4 %0, %1, %2, 0" : "=&v"(acc[ai][bj][m][n]) : "v"(_b8), "v"(_a8)); } __builtin_amdgcn_s_setprio(0); } while (0)
#define PG8_WAIT_V(n) asm volatile("s_waitcnt vmcnt(" #n ")" ::: "memory")
#define PG8_WAIT_L(n) asm volatile("s_waitcnt lgkmcnt(" #n ")" ::: "memory")
#define PG8_BAR __builtin_amdgcn_s_barrier()
#define PG8_SCHED __builtin_amdgcn_sched_barrier(0)
#define PG8_ROWS(dst, unit) do { if constexpr (GATHER) { _Pragma("unroll") for (int _i = 0; _i < 2; ++_i) { int _R, _C; stage_rc(tid * 16 + _i * 8192, _R, _C); \
        _Pragma("unroll") for (int _h = 0; _h < 2; ++_h) dst[_h][_i] = (unsigned)(S.arow(unit, _R + 128 * _h) * K + _C) * 2u; } } } while (0)
    Unit cur, nxt; int ui = 0;
    if (!S.next(0, cur)) return;
    PG8_ROWS(vA, cur);
    if constexpr (Sched::VARK) { const int _K = cur.x3;
#pragma unroll
        for (int _i = 0; _i < 2; ++_i) { int _R, _C; stage_rc(tid * 16 + _i * 8192, _R, _C); const int _Rb = Epi::PERM ? ((_R & ~31) + perm32(_R & 31)) : _R;
#pragma unroll
            for (int _h = 0; _h < 2; ++_h) { vA[_h][_i] = (unsigned)((_R + 128 * _h) * _K + _C) * 2u; vB[_h][_i] = (unsigned)((_Rb + 128 * _h) * _K + _C) * 2u; } } }
#define PG8_META(unit, slot) do { if constexpr (Epi::NMETA > 0) { if (wid < Epi::NMETA) \
        __builtin_amdgcn_global_load_lds((const unsigned*)(E.meta_src(unit, wid) + lane * 16), (PG8_LAS unsigned*)(lds + PG8_META_OFF + (slot) * 4096 + wid * 1024), 16, 0, 0); } } while (0)
    PG8_META(cur, 0);
    f32x4 acc[2][2][4][2];
    if constexpr (!(FP8 && SP2))
#pragma unroll
    for (int a = 0; a < 2; ++a)
#pragma unroll
        for (int b = 0; b < 2; ++b)
#pragma unroll
            for (int m = 0; m < 4; ++m)
#pragma unroll
                for (int n = 0; n < 2; ++n) acc[a][b][m][n] = (f32x4){0.f, 0.f, 0.f, 0.f};
    bf16x8 At[4][2], B0[2][2], B1[2][2];
    const char* cA = cur.A; const char* cB = cur.B;
    if constexpr (SP2) {
        PG8_STAGE(PG8_SB(0, 0), cB, vB[0]); PG8_STAGE(PG8_SB(0, 1), cB, vB[1]); PG8_STAGE(PG8_SA(0, 0), cA, vA[0]); PG8_STAGE(PG8_SA(0, 1), cA, vA[1]);
        if (wr == 1) PG8_BAR;
        PG8_WAIT_V(2); PG8_BAR;
        PG8_STAGE(PG8_SB(1, 0), cB + kstep, vB[0]); PG8_STAGE(PG8_SA(1, 0), cA + kstep, vA[0]); PG8_STAGE(PG8_SB(1, 1), cB + kstep, vB[1]);
        PG8_WAIT_V(6); PG8_BAR;
    } else {
        PG8_STAGE(PG8_SB(0, 0), cB, vB[0]); PG8_STAGE(PG8_SA(0, 0), cA, vA[0]); PG8_STAGE(PG8_SB(0, 1), cB, vB[1]); PG8_STAGE(PG8_SA(0, 1), cA, vA[1]);
        if (wr == 1) PG8_BAR;
        PG8_WAIT_V(4); PG8_BAR;
        PG8_STAGE(PG8_SB(1, 0), cB + kstep, vB[0]); PG8_STAGE(PG8_SA(1, 0), cA + kstep, vA[0]); PG8_STAGE(PG8_SB(1, 1), cB + kstep, vB[1]);
        PG8_WAIT_V(6); PG8_BAR;
    }
    for (;;) {
        const bool has_next = S.next(ui + 1, nxt);
        if (has_next) { PG8_META(nxt, (ui + 1) % 3); }
        const char* nA = has_next ? nxt.A : cA; const char* nB = has_next ? nxt.B : cB;
        const int nt = (Sched::VARK ? cur.x3 : K) / BK;
#pragma unroll 1
        for (int t = 0; t < nt; t += 2) {
            const bool last = (t == nt - 2);
            const char* a1 = cA + (size_t)(t + 1) * kstep;
            const char* a2 = last ? nA : cA + (size_t)(t + 2) * kstep; const char* b2 = last ? nB : cB + (size_t)(t + 2) * kstep;
            const char* a3 = a2 + kstep; const char* b3 = b2 + kstep;
            if constexpr (SP2) {
            PG8_LDB(B0, 0, 0); PG8_LDB(B1, 0, 1); PG8_SCHED; PG8_LDA(At, 0, 0); PG8_STAGE(PG8_SA(1, 1), a1, vA[1]);
            if constexpr (GATHER) { if (last && has_next) { const PG8_LAS unsigned char* _mt = (const PG8_LAS unsigned char*)(lds + PG8_META_OFF + ((ui + 1) % 3) * 4096); \
                _Pragma("unroll") for (int _i = 0; _i < 2; ++_i) { int _R, _C; stage_rc(tid * 16 + _i * 8192, _R, _C); \
                _Pragma("unroll") for (int _h = 0; _h < 2; ++_h) vA[_h][_i] = (unsigned)(S.arow_lds(nxt, _R + 128 * _h, _mt) * K + _C) * 2u; } } } \
            if constexpr (Sched::VARK) { if (last && has_next) { const int _K = nxt.x3; \
                _Pragma("unroll") for (int _i = 0; _i < 2; ++_i) { int _R, _C; stage_rc(tid * 16 + _i * 8192, _R, _C); const int _Rb = Epi::PERM ? ((_R & ~31) + perm32(_R & 31)) : _R; \
                _Pragma("unroll") for (int _h = 0; _h < 2; ++_h) { vA[_h][_i] = (unsigned)((_R + 128 * _h) * _K + _C) * 2u; vB[_h][_i] = (unsigned)((_Rb + 128 * _h) * _K + _C) * 2u; } } } }
            PG8_WAIT_V(8); PG8_WAIT_L(0); PG8_BAR; if (FP8 && t == 0) { PG8_MMA0(0, 0, At, B0); PG8_MMA0(0, 1, At, B1); } else { PG8_MMA(0, 0, At, B0); PG8_MMA(0, 1, At, B1); } PG8_BAR; PG8_SCHED;
            PG8_LDA(At, 0, 1); PG8_STAGE(PG8_SB(0, 0), b2, vB[0]); PG8_STAGE(PG8_SB(0, 1), b2, vB[1]); PG8_STAGE(PG8_SA(0, 0), a2, vA[0]);
            PG8_WAIT_V(8); PG8_WAIT_L(0); PG8_BAR; if (FP8 && t == 0) { PG8_MMA0(1, 0, At, B0); PG8_MMA0(1, 1, At, B1); } else { PG8_MMA(1, 0, At, B0); PG8_MMA(1, 1, At, B1); } PG8_BAR; PG8_SCHED;
            PG8_LDB(B0, 1, 0); PG8_LDB(B1, 1, 1); PG8_SCHED; PG8_LDA(At, 1, 0); PG8_STAGE(PG8_SA(0, 1), a2, vA[1]);
            PG8_WAIT_V(8); PG8_WAIT_L(0); PG8_BAR; PG8_MMA(0, 0, At, B0); PG8_MMA(0, 1, At, B1); PG8_BAR; PG8_SCHED;
            PG8_LDA(At, 1, 1); PG8_STAGE(PG8_SB(1, 0), b3, vB[0]); PG8_STAGE(PG8_SB(1, 1), b3, vB[1]); PG8_STAGE(PG8_SA(1, 0), a3, vA[0]);
            PG8_WAIT_V(8); PG8_WAIT_L(0); PG8_BAR; PG8_MMA(1, 0, At, B0); PG8_MMA(1, 1, At, B1); PG8_BAR; PG8_SCHED;
            } else {
            PG8_LDB(B0, 0, 0); PG8_SCHED; PG8_LDA(At, 0, 0); PG8_STAGE(PG8_SA(1, 1), a1, vA[1]);
            if constexpr (GATHER) { if (last && has_next) { const PG8_LAS unsigned char* _mt = (const PG8_LAS unsigned char*)(lds + PG8_META_OFF + ((ui + 1) % 3) * 4096); \
                _Pragma("unroll") for (int _i = 0; _i < 2; ++_i) { int _R, _C; stage_rc(tid * 16 + _i * 8192, _R, _C); \
                _Pragma("unroll") for (int _h = 0; _h < 2; ++_h) vA[_h][_i] = (unsigned)(S.arow_lds(nxt, _R + 128 * _h, _mt) * K + _C) * 2u; } } } \
            if constexpr (Sched::VARK) { if (last && has_next) { const int _K = nxt.x3; \
                _Pragma("unroll") for (int _i = 0; _i < 2; ++_i) { int _R, _C; stage_rc(tid * 16 + _i * 8192, _R, _C); const int _Rb = Epi::PERM ? ((_R & ~31) + perm32(_R & 31)) : _R; \
                _Pragma("unroll") for (int _h = 0; _h < 2; ++_h) { vA[_h][_i] = (unsigned)((_R + 128 * _h) * _K + _C) * 2u; vB[_h][_i] = (unsigned)((_Rb + 128 * _h) * _K + _C) * 2u; } } } }
            PG8_WAIT_L(8); PG8_BAR; PG8_WAIT_L(0); PG8_MMA(0, 0, At, B0); PG8_BAR; PG8_SCHED;
            PG8_LDB(B1, 0, 1); PG8_STAGE(PG8_SB(0, 0), b2, vB[0]);
            PG8_BAR; PG8_WAIT_L(0); PG8_MMA(0, 1, At, B1); PG8_BAR;
            PG8_LDA(At, 0, 1); PG8_STAGE(PG8_SA(0, 0), a2, vA[0]);
            PG8_BAR; PG8_WAIT_L(0); PG8_MMA(1, 0, At, B0); PG8_BAR; PG8_SCHED;
            PG8_STAGE(PG8_SB(0, 1), b2, vB[1]);
            PG8_WAIT_V(6); PG8_BAR; PG8_MMA(1, 1, At, B1); PG8_BAR;
            PG8_LDB(B0, 1, 0); PG8_SCHED; PG8_LDA(At, 1, 0); PG8_STAGE(PG8_SA(0, 1), a2, vA[1]);
            PG8_WAIT_L(8); PG8_BAR; PG8_WAIT_L(0); PG8_MMA(0, 0, At, B0); PG8_BAR; PG8_SCHED;
            PG8_LDB(B1, 1, 1); PG8_STAGE(PG8_SB(1, 0), b3, vB[0]);
            PG8_BAR; PG8_WAIT_L(0); PG8_MMA(0, 1, At, B1); PG8_BAR;
            PG8_LDA(At, 1, 1); PG8_STAGE(PG8_SA(1, 0), a3, vA[0]);
            PG8_BAR; PG8_WAIT_L(0); PG8_MMA(1, 0, At, B0); PG8_BAR; PG8_SCHED;
            PG8_STAGE(PG8_SB(1, 1), b3, vB[1]);
            PG8_WAIT_V(6); PG8_BAR; PG8_MMA(1, 1, At, B1); PG8_BAR;
            }
        }
        if constexpr (FP8) asm volatile("s_nop 15" ::: "memory");
        if constexpr (ALIGN_EPI) { if (wr == 0) PG8_BAR; }
        E(acc, cur, wr, wc, fr, fq, (const PG8_LAS unsigned char*)(lds + PG8_META_OFF + (ui % 3) * 4096));
        if (!has_next) break;
        if constexpr (!(FP8 && SP2))
#pragma unroll
        for (int a = 0; a < 2; ++a)
#pragma unroll
            for (int b = 0; b < 2; ++b)
#pragma unroll
                for (int m = 0; m < 4; ++m)
#pragma unroll
                    for (int n = 0; n < 2; ++n) acc[a][b][m][n] = (f32x4){0.f, 0.f, 0.f, 0.f};
        cur = nxt; cA = nA; cB = nB; ++ui;
        if constexpr (ALIGN_EPI) { if (wr == 1) PG8_BAR; }
    }
    PG8_WAIT_V(0);
    if constexpr (!ALIGN_EPI) { if (wr == 0) PG8_BAR; }
    PG8_BAR;
#undef PG8_SA
#undef PG8_SB
#undef PG8_STAGE
#undef PG8_LDA
#undef PG8_LDB
#undef PG8_MMA
#undef PG8_WAIT_V
#undef PG8_WAIT_L
#undef PG8_BAR
#undef PG8_SCHED
#undef PG8_ROWS
#undef PG8_META
}
}

__device__ __forceinline__ int rowmap(int mode, int col) {
    if (mode == 1) {
        const int l = col & 255, hl = l >> 6, d = l & 63;
        return (col & ~255) + 128 * (hl >> 1) + 32 * (2 * (hl & 1) + ((d >> 4) & 1)) + 16 * (d >> 5) + (d & 15);
    } else if (mode == 2) {
        const int isU = col >> 8, j = col & 255, pn = j >> 7, jl = j & 127;
        return 256 * pn + 128 * isU + 32 * (jl >> 5) + 16 * ((jl >> 2) & 1) + 4 * ((jl >> 3) & 3) + (jl & 3);
    } else if (mode == 4) {
        const int l = col & 255, wc = l >> 6, fq = (l >> 4) & 3, bj = (l >> 3) & 1, n = (l >> 2) & 1, r = l & 3;
        return (col & ~255) + 128 * bj + 32 * wc + 16 * n + 4 * fq + r;
    } else if (mode == 3) {
        const int x = col & 127, pair = x >> 5, y = x & 31;
        return (col & ~127) + 16 * (2 * pair + ((y >> 2) & 1)) + 4 * (y >> 3) + (y & 3);
    }
    return col;
}
__device__ __forceinline__ unsigned pk4_fp8(float a, float b, float c, float d) {
    a = fminf(fmaxf(a, -448.f), 448.f); b = fminf(fmaxf(b, -448.f), 448.f); c = fminf(fmaxf(c, -448.f), 448.f); d = fminf(fmaxf(d, -448.f), 448.f);
    unsigned x = (unsigned)__builtin_amdgcn_cvt_pk_fp8_f32(a, b, 0, false); return (unsigned)__builtin_amdgcn_cvt_pk_fp8_f32(c, d, (int)x, true);
}
__device__ __forceinline__ void tt_load(f32x4 (&v)[8], const float* __restrict__ src, int C, int r0, int c0, int tid) {
#pragma unroll
    for (int i = 0; i < 8; ++i) v[i] = __builtin_nontemporal_load((const f32x4*)(src + (size_t)(r0 + (tid >> 6) + 8 * i) * C + c0 + (tid & 63) * 4));
}
__device__ __forceinline__ void tt_tolds(const f32x4 (&v)[8], float* tile, int tid) {
#pragma unroll
    for (int i = 0; i < 8; ++i) {
        float* tp = tile + ((tid >> 6) + 8 * i) * 257 + (tid & 63) * 4;
        tp[0] = v[i][0]; tp[1] = v[i][1]; tp[2] = v[i][2]; tp[3] = v[i][3];
    }
}
template <bool F8, bool NTS>
__device__ __forceinline__ void tt_store(bf16_t* __restrict__ dst, int R, int r0, int c0, const float* tile  , int mode, float scale, int tid) {
    if constexpr (F8) {
        unsigned char* d8 = (unsigned char*)dst;
#pragma unroll
        for (int k = 0; k < 2; ++k) {
            const int id = tid + 512 * k, c = id >> 2, rr = (id & 3) * 16;
            float x[16];
#pragma unroll
            for (int j = 0; j < 16; ++j) x[j] = tile[(rr + j) * 257 + c] * scale;
            u32x4 w; w.x = pk4_fp8(x[0], x[1], x[2], x[3]); w.y = pk4_fp8(x[4], x[5], x[6], x[7]); w.z = pk4_fp8(x[8], x[9], x[10], x[11]); w.w = pk4_fp8(x[12], x[13], x[14], x[15]);
            if constexpr (NTS) __builtin_nontemporal_store(w, (u32x4*)(d8 + (size_t)rowmap(mode, c0 + c) * R + r0 + rr));
            else *(u32x4*)(d8 + (size_t)rowmap(mode, c0 + c) * R + r0 + rr) = w;
        }
    } else {
#pragma unroll
        for (int k = 0; k < 4; ++k) {
            const int id = tid + 512 * k, c = id >> 3, rr = (id & 7) * 8;
            float x[8];
#pragma unroll
            for (int j = 0; j < 8; ++j) x[j] = tile[(rr + j) * 257 + c];
            u32x4 w; w.x = cvt_pk_bf16(x[0], x[1]); w.y = cvt_pk_bf16(x[2], x[3]); w.z = cvt_pk_bf16(x[4], x[5]); w.w = cvt_pk_bf16(x[6], x[7]);
            *(u32x4*)(dst + (size_t)rowmap(mode, c0 + c) * R + r0 + rr) = w;
        }
    }
}

template <bool F8 = false, bool NTS = false>
__device__ __forceinline__ int transpose_job(const float* src, bf16_t* dst, int batch, int R, int C, int base, float* tile, int mode, const int wv_, float scale = 1.0f, int tj0 = 0, int tjn = 0) {
    const int nb = gridDim.x, bid = blockIdx.x, tid = WV * 64 + lane_id();
    const int tr = R / 64, tc = tjn ? tjn : C / 256, per = tr * tc, tot = per * batch;
    const int first = (bid - (base % nb) + nb) % nb;
    f32x4 v[8];
    if (first < tot) { const int e = first / per, r = first % per; tt_load(v, src + (size_t)e * R * C, C, (r / tc) * 64, (tj0 + r % tc) * 256, tid); }
#pragma unroll 1
    for (int t = first; t < tot; t += nb) {
        const int e = t / per, r = t % per, ti = r / tc, tj = r % tc;
        tt_tolds(v, tile, tid);
        const int tn = t + nb;
        if (tn < tot) { const int e2 = tn / per, r2 = tn % per; tt_load(v, src + (size_t)e2 * R * C, C, (r2 / tc) * 64, (tj0 + r2 % tc) * 256, tid); }
        __syncthreads();
        tt_store<F8, NTS>(F8 ? (bf16_t*)((unsigned char*)dst + (size_t)e * R * C) : dst + (size_t)e * R * C, R, ti * 64, (tj0 + tj) * 256, tile, mode, scale, tid);
        __syncthreads();
    }
    return base + tot;
}

__device__ __forceinline__ float log2_sigmoid(float x) {
    const float ax = fabsf(x);
    const float sp = fmaxf(-x, 0.f) + log1pf(__expf(-ax));
    return -sp * LOG2E;
}

__device__ void phase0(const Params& p, unsigned char* lds, const int wv_) {
    unsigned char* ws = p.ws;
    const int tid = WV * 64 + lane_id(), nb = gridDim.x, bid = blockIdx.x;
    for (int idx = bid * NTHREADS + tid; idx < SEQ * 32; idx += nb * NTHREADS) {
        const int s = idx >> 5, i = idx & 31;
        const double ang = (double)s * INV_FREQ[i];
        const double rev = ang * 0.15915494309189535;
        const double fr = rev - floor(rev);
        const float ff = (float)fr;
        float* rt = (float*)(ws + WS_ROPE) + s * 64 + i;
        rt[0] = __builtin_amdgcn_cosf(ff); rt[32] = __builtin_amdgcn_sinf(ff);
    }
    if (bid == 0 && tid < 16) ((float*)(ws + WS_LGT))[tid] = log2_sigmoid(tid < 8 ? p.in[3][tid] : p.in[4][tid - 8]);
    for (int idx = bid * NTHREADS + tid; idx < 8 * 4 * 4 * 64; idx += nb * NTHREADS) {
        const int ln = idx & 63, nt = (idx >> 6) & 3, ks = (idx >> 8) & 3, w = idx >> 10, li = ln & 15, q = ln >> 4;
        float wv[8];
#pragma unroll
        for (int j = 0; j < 8; ++j) wv[j] = p.in[10][(size_t)(128 * w + 32 * ks + 8 * q + j) * 64 + 16 * nt + li];
        u32x4 hi, lo;
        hi.x = cvt_pk_bf16(wv[0], wv[1]); hi.y = cvt_pk_bf16(wv[2], wv[3]); hi.z = cvt_pk_bf16(wv[4], wv[5]); hi.w = cvt_pk_bf16(wv[6], wv[7]);
        lo.x = cvt_pk_bf16(wv[0] - bflo(hi.x), wv[1] - bfhi(hi.x)); lo.y = cvt_pk_bf16(wv[2] - bflo(hi.y), wv[3] - bfhi(hi.y));
        lo.z = cvt_pk_bf16(wv[4] - bflo(hi.z), wv[5] - bfhi(hi.z)); lo.w = cvt_pk_bf16(wv[6] - bflo(hi.w), wv[7] - bfhi(hi.w));
        u32x4* dst = (u32x4*)(ws + WS_WRF) + (size_t)(((w * 4 + ks) * 4 + nt) * 2) * 64 + ln;
        dst[0] = hi; dst[64] = lo;
    }
    {
        const float* x = p.in[0]; bf16_t* xb = (bf16_t*)(ws + WS_XB); unsigned char* x8 = ws + WS_X8;
        const size_t n8 = (size_t)T_TOK * DM / 8;
        const size_t stride = (size_t)nb * NTHREADS;
        for (size_t i0 = (size_t)bid * NTHREADS + tid; i0 < n8; i0 += 4 * stride) {
            f32x4 a[4], b[4];
#pragma unroll
            for (int u = 0; u < 4; ++u) { const size_t i = i0 + u * stride; if (i < n8) { a[u] = __builtin_nontemporal_load((const f32x4*)(x + i * 8)); b[u] = __builtin_nontemporal_load((const f32x4*)(x + i * 8 + 4)); } }
#pragma unroll
            for (int u = 0; u < 4; ++u) { const size_t i = i0 + u * stride; if (i < n8) {
                u32x4 w; w.x = cvt_pk_bf16(a[u][0], a[u][1]); w.y = cvt_pk_bf16(a[u][2], a[u][3]); w.z = cvt_pk_bf16(b[u][0], b[u][1]); w.w = cvt_pk_bf16(b[u][2], b[u][3]);
                *(u32x4*)(xb + i * 8) = w;
                u32x2 f; f.x = pk4_fp8(a[u][0] * X8_SCALE, a[u][1] * X8_SCALE, a[u][2] * X8_SCALE, a[u][3] * X8_SCALE); f.y = pk4_fp8(b[u][0] * X8_SCALE, b[u][1] * X8_SCALE, b[u][2] * X8_SCALE, b[u][3] * X8_SCALE);
                *(u32x2*)(x8 + i * 8) = f; } }
        }
        const float* pp = p.in[1]; unsigned char* p8 = ws + WS_PB;
        const size_t m8 = (size_t)T_TOK * PLE / 8;
        for (size_t i = (size_t)bid * NTHREADS + tid; i < m8; i += (size_t)nb * NTHREADS) {
            const f32x4 a = __builtin_nontemporal_load((const f32x4*)(pp + i * 8)), b = __builtin_nontemporal_load((const f32x4*)(pp + i * 8 + 4));
            u32x2 f; f.x = pk4_fp8(a[0] * P8_SCALE, a[1] * P8_SCALE, a[2] * P8_SCALE, a[3] * P8_SCALE); f.y = pk4_fp8(b[0] * P8_SCALE, b[1] * P8_SCALE, b[2] * P8_SCALE, b[3] * P8_SCALE);
            *(u32x2*)(p8 + i * 8) = f;
        }
    }
    float* tile = (float*)lds;
    int base = 0;
    base = transpose_job(p.in[2],  (bf16_t*)(ws + WS_WINT), 1, 1024, 3584, base, tile, 1, wv_, 1.0f, 0, 8);
    base = transpose_job<true>(p.in[2], (bf16_t*)(ws + WS_WIN8 - (size_t)2048 * 1024), 1, 1024, 3584, base, tile, 1, wv_, WIN8_SCALE, 8, 6);
    base = transpose_job<true>(p.in[7],  (bf16_t*)(ws + WS_WOUTT), 1, 1024, 1024, base, tile, 3, wv_, WO_SCALE);
    base = transpose_job<true>(p.in[16], (bf16_t*)(ws + WS_WPT), 1, 256, 1024, base, tile, 4, wv_, WP8_SCALE);
}
__device__ __forceinline__ void convert_expert_weights(const Params& p, unsigned char* lds, const int wv_) {
    unsigned char* ws = p.ws;
    float* tile = (float*)lds;
    int base = 0;
    base = transpose_job<true, true>(p.in[12], (bf16_t*)(ws + WS_WGUT), 64, 1024, 512, base, tile, 2, wv_, WGU_SCALE);
    base = transpose_job<true, true>(p.in[14], (bf16_t*)(ws + WS_WGUT + (size_t)64 * 512 * 1024), 1, 1024, 512, base, tile, 2, wv_, WGU_SCALE);
    base = transpose_job<true, true>(p.in[13], (bf16_t*)(ws + WS_WDT), 64, 256, 1024, base, tile, 4, wv_, WD_SCALE);
    base = transpose_job<true, true>(p.in[15], (bf16_t*)(ws + WS_WDT + (size_t)64 * 1024 * 256), 1, 256, 1024, base, tile, 4, wv_, WD_SCALE);
    base = transpose_job<true, true>(p.in[17], (bf16_t*)(ws + WS_WGATE), 1, 1024, 1024, base, tile, 4, wv_, WGU_SCALE);
    __syncthreads();
}

struct SchedDense {
    static constexpr bool VARK = false;
    const char* A; const char* B; int K; pg8::TileOrder ord;
    __device__ bool next(int i, pg8::Unit& u) const {
        int pm, pn; if (!ord.map((long)i * gridDim.x + blockIdx.x, pm, pn)) return false;
        u.pm = pm; u.pn = pn; u.A = A + (size_t)pm * 256 * K * 2; u.B = B + (size_t)pn * 256 * K * 2; u.x0 = u.x1 = u.x2 = u.x3 = 0; return true;
    }
    __device__ int arow(const pg8::Unit&, int r) const { return r; }
};
template <bool F8>
struct EpiInProjT {
    static constexpr bool PERM = false; static constexpr int NMETA = 0;
    __device__ const char* meta_src(const pg8::Unit&, int) const { return nullptr; }
    unsigned char* ws;
    __device__ __forceinline__ void operator()(const f32x4 (&acc)[2][2][4][2], const pg8::Unit& u, int wr, int wc, int fr_, int fq_, const PG8_LAS unsigned char* meta) const {
        int fr = fr_, fq = fq_; asm volatile("" : "+v"(fr), "+v"(fq));
        if constexpr (F8) {
        if (u.x0 == 1) {
            bf16_t* ple = (bf16_t*)(ws + WS_PLE);
#pragma unroll
            for (int ai = 0; ai < 2; ++ai)
#pragma unroll
                for (int m = 0; m < 4; ++m) {
                    const size_t t = u.pm * 256 + 128 * ai + 64 * wr + 16 * m + fr;
                    bf16_t* dst = ple + t * DM + u.pn * 256 + 64 * wc + 16 * fq;
#pragma unroll
                    for (int bj = 0; bj < 2; ++bj) {
                        const f32x4 a0 = acc[ai][bj][m][0] * PLEP_DESCALE, a1 = acc[ai][bj][m][1] * PLEP_DESCALE;
                        u32x4 w; w.x = cvt_pk_bf16(a0[0], a0[1]); w.y = cvt_pk_bf16(a0[2], a0[3]); w.z = cvt_pk_bf16(a1[0], a1[1]); w.w = cvt_pk_bf16(a1[2], a1[3]);
                        __builtin_nontemporal_store(w, (u32x4*)(dst + 8 * bj));
                    }
                }
            return;
        }
        }
        const float* rope = (const float*)(ws + WS_ROPE);
        const int region = u.pn >> 1, d0 = 16 * (wc & 1) + 4 * fq;
#pragma unroll
        for (int ai = 0; ai < 2; ++ai)
#pragma unroll
            for (int m = 0; m < 4; ++m) {
                const int t = u.pm * 256 + 128 * ai + 64 * wr + 16 * m + fr, b = t >> 12, s = t & 4095;
                f32x4 co, si;
                if constexpr (!F8) { if (region <= 1) { const float sc = region == 1 ? 0.125f : 1.0f; co = *(const f32x4*)(rope + (size_t)s * 64 + d0) * sc; si = *(const f32x4*)(rope + (size_t)s * 64 + 32 + d0) * sc; } }
#pragma unroll
                for (int bj = 0; bj < 2; ++bj) {
                    const int head = 4 * (u.pn & 1) + 2 * bj + (wc >> 1), bh = b * 8 + head;
                    const f32x4 a0 = acc[ai][bj][m][0], a1 = acc[ai][bj][m][1];
                    if constexpr (!F8) {
                    if (region <= 1) {
                        const f32x4 o1 = a0 * co - a1 * si, o2 = a0 * si + a1 * co;
                        u32x2 w1, w2; w1.x = cvt_pk_bf16(o1[0], o1[1]); w1.y = cvt_pk_bf16(o1[2], o1[3]); w2.x = cvt_pk_bf16(o2[0], o2[1]); w2.y = cvt_pk_bf16(o2[2], o2[3]);
                        bf16_t* dst = (bf16_t*)(ws + (region == 0 ? WS_Q : WS_K)) + ((size_t)bh * SEQ + s) * 64;
                        *(u32x2*)(dst + d0) = w1; *(u32x2*)(dst + d0 + 32) = w2;
                        if (region == 1) {
                            bf16_t* dstT = (bf16_t*)(ws + WS_KT) + (size_t)bh * 64 * SEQ + s;
                            dstT[(size_t)(d0 + 0) * SEQ] = (bf16_t)(w1.x & 0xffff); dstT[(size_t)(d0 + 1) * SEQ] = (bf16_t)(w1.x >> 16);
                            dstT[(size_t)(d0 + 2) * SEQ] = (bf16_t)(w1.y & 0xffff); dstT[(size_t)(d0 + 3) * SEQ] = (bf16_t)(w1.y >> 16);
                            dstT[(size_t)(d0 + 32) * SEQ] = (bf16_t)(w2.x & 0xffff); dstT[(size_t)(d0 + 33) * SEQ] = (bf16_t)(w2.x >> 16);
                            dstT[(size_t)(d0 + 34) * SEQ] = (bf16_t)(w2.y & 0xffff); dstT[(size_t)(d0 + 35) * SEQ] = (bf16_t)(w2.y >> 16);
                        }
                    } else if (region == 2) {
                        bf16_t* dstT = (bf16_t*)(ws + WS_VT) + (size_t)bh * 64 * SEQ + s;
#pragma unroll
                        for (int r = 0; r < 4; ++r) { dstT[(size_t)(d0 + r) * SEQ] = f2bf(a0[r]); dstT[(size_t)(d0 + 32 + r) * SEQ] = f2bf(a1[r]); }
                    } else {
                        bf16_t* dst = (bf16_t*)(ws + WS_G) + (size_t)t * 512 + head * 64;
                        u32x2 w1, w2; w1.x = cvt_pk_bf16(siluf_(a0[0]), siluf_(a0[1])); w1.y = cvt_pk_bf16(siluf_(a0[2]), siluf_(a0[3]));
                        w2.x = cvt_pk_bf16(siluf_(a1[0]), siluf_(a1[1])); w2.y = cvt_pk_bf16(siluf_(a1[2]), siluf_(a1[3]));
                        *(u32x2*)(dst + d0) = w1; *(u32x2*)(dst + d0 + 32) = w2;
                    }
                    } else {
                    if (region == 6) {
                        bf16_t* dstT = (bf16_t*)(ws + WS_NVT) + (size_t)bh * 64 * SEQ + s;
#pragma unroll
                        for (int r = 0; r < 4; ++r) { dstT[(size_t)(d0 + r) * SEQ] = f2bf(a0[r] * NA_DESCALE); dstT[(size_t)(d0 + 32 + r) * SEQ] = f2bf(a1[r] * NA_DESCALE); }
                    } else {
                        const float sc = (region == 4 ? 0.125f : 1.0f) * NA_DESCALE;
                        bf16_t* dst = (bf16_t*)(ws + (region == 4 ? WS_NQ : WS_NK)) + ((size_t)bh * SEQ + s) * 64;
                        u32x2 w1, w2; w1.x = cvt_pk_bf16(a0[0] * sc, a0[1] * sc); w1.y = cvt_pk_bf16(a0[2] * sc, a0[3] * sc);
                        w2.x = cvt_pk_bf16(a1[0] * sc, a1[1] * sc); w2.y = cvt_pk_bf16(a1[2] * sc, a1[3] * sc);
                        *(u32x2*)(dst + d0) = w1; *(u32x2*)(dst + d0 + 32) = w2;
                    }
                    }
                }
            }
    }
};
struct SchedP1a {
    static constexpr bool VARK = false;
    unsigned char* ws; pg8::TileOrder ord;
    __device__ bool next(int i, pg8::Unit& u) const {
        const long L = (long)i * gridDim.x + blockIdx.x;
        int pm, pn;
        if (!ord.map(L, pm, pn)) return false;
        u.pm = pm; u.pn = pn; u.x0 = 0; u.x1 = u.x2 = 0; u.x3 = DM;
        u.A = (const char*)(ws + WS_XB) + (size_t)pm * 256 * DM * 2; u.B = (const char*)(ws + WS_WINT) + (size_t)pn * 256 * DM * 2; return true;
    }
    __device__ int arow(const pg8::Unit&, int r) const { return r; }
};
struct SchedP1b {
    static constexpr bool VARK = true;
    unsigned char* ws; pg8::TileOrder ord;
    __device__ bool next(int i, pg8::Unit& u) const {
        const long L = (long)i * gridDim.x + blockIdx.x;
        int pm, pn;
        if (ord.map(L, pm, pn)) {
            u.pm = pm; u.pn = 8 + pn; u.x0 = 0; u.x1 = u.x2 = 0; u.x3 = DM / 2;
            u.A = (const char*)(ws + WS_X8) + (size_t)pm * 256 * DM; u.B = (const char*)(ws + WS_WIN8) + (size_t)pn * 256 * DM; return true;
        }
        const int lastr = ord.nwg / (int)gridDim.x, c = (int)blockIdx.x, nfree = (int)gridDim.x - ord.nwg % (int)gridDim.x, cf = c - ord.nwg % (int)gridDim.x;
        if (cf < 0 || i < lastr) return false;
        const int per = (256 + nfree - 1) / nfree, j = i - lastr;
        if (j >= per) return false;
        const int x = cf * per + j;
        if (x >= 256) return false;
        u.pm = x >> 2; u.pn = x & 3; u.x0 = 1; u.x1 = u.x2 = 0; u.x3 = PLE / 2;
        u.A = (const char*)(ws + WS_PB) + (size_t)u.pm * 256 * PLE; u.B = (const char*)(ws + WS_WPT) + (size_t)u.pn * 256 * PLE; return true;
    }
    __device__ int arow(const pg8::Unit&, int r) const { return r; }
};
__device__ void phase1(const Params& p, unsigned char* lds, const int wv_) {
    const int k8 = (int)(blockIdx.x >> 3), cgrp = (gridDim.x == 256) ? ((k8 >= 16 && k8 < 29) ? 2 : (k8 & 1)) : k8 % 3;
    if (cgrp == 0) convert_expert_weights(p, lds, wv_);
    {
        SchedP1a S; S.ws = p.ws; S.ord.init(T_TOK, 2048);
        EpiInProjT<false> E; E.ws = p.ws;
        pg8::gemm_phase<EpiInProjT<false>, SchedP1a, false, true, true>((PG8_LAS unsigned char*)lds, DM, S, E, wv_);
    }
    if (cgrp == 1) convert_expert_weights(p, lds, wv_);
    {
        SchedP1b S; S.ws = p.ws; S.ord.init(T_TOK, 1536);
        EpiInProjT<true> E; E.ws = p.ws;
        pg8::gemm_phase<EpiInProjT<true>, SchedP1b, false, true, true, true>((PG8_LAS unsigned char*)lds, DM / 2, S, E, wv_);
    }
    if (cgrp == 2) convert_expert_weights(p, lds, wv_);
}


__device__ void phase2(const Params& p, unsigned char* lds, const int wv_) {
    unsigned char* ws = p.ws;
    const int lane = lane_id(), wid = WV, tid = wid * 64 + lane, q = lane >> 4, li = lane & 15;
    const bf16_t* KT = (const bf16_t*)(ws + WS_KT); const bf16_t* VT = (const bf16_t*)(ws + WS_VT);
    const bf16_t* NQ = (const bf16_t*)(ws + WS_NQ); const bf16_t* NK = (const bf16_t*)(ws + WS_NK); const bf16_t* NVT = (const bf16_t*)(ws + WS_NVT);
    float* SST = (float*)(ws + WS_SST);
    unsigned char* mix = ws + WS_MIX;
    constexpr int KS_BYTES = 576 * 128, VROW = 1168, VS_BYTES = 64 * VROW;
    unsigned char* Ks = lds; unsigned char* Vs = lds + KS_BYTES; float* biasL = (float*)(lds + KS_BYTES + VS_BYTES);
    bf16_t* PS = (bf16_t*)(ws + WS_SST);
    const int G_ = gridDim.x, c_ = blockIdx.x, cswz = (G_ & 7) == 0 ? (c_ & 7) * (G_ >> 3) + (c_ >> 3) : c_;
    const bool xcdok = (G_ & 7) == 0 && G_ >= 64;
    const int srank = xcdok ? ((c_ >> 3) < 8 ? (c_ & 7) * 8 + (c_ >> 3) : -1) : (c_ < 64 ? c_ : -1), nscan = xcdok ? 64 : (G_ < 64 ? G_ : 64);
    for (int u = srank; u >= 0 && u < 64; u += nscan) {
        const int bh = u >> 1, dir = u & 1, h = bh & 7;
        const float lg = ((const float*)(ws + WS_LGT))[8 * dir + h];
        const float gC = fast_exp2(lg * 128.f);
        constexpr int SLOT = 128 * 256;
        const char* dsrc[8];
        if (wid >= 4) {
#pragma unroll
            for (int j = 0; j < 8; ++j) {
                const int r = 4 * (8 * (wid - 4) + j) + (lane >> 4), ch = (lane & 15) ^ (r & 15);
                dsrc[j] = (const char*)((r < 64 ? VT + ((size_t)bh * 64 + r) * SEQ : KT + ((size_t)bh * 64 + (r - 64)) * SEQ) + ch * 8);
            }
        }
#define SCAN_CH(step) (dir == 0 ? (step) : 31 - (step))
#define SCAN_ISSUE(step) do { if (wid >= 4) { const int _c = SCAN_CH(step); _Pragma("unroll") for (int j = 0; j < 8; ++j) \
        __builtin_amdgcn_global_load_lds((const unsigned*)(dsrc[j] + _c * 256), (PG8_LAS unsigned*)((PG8_LAS unsigned char*)lds + ((step) & 3) * SLOT + (8 * (wid - 4) + j) * 1024), 16, 0, 0); } } while (0)
        float wg[4][8];
#pragma unroll
        for (int ks = 0; ks < 4; ++ks)
#pragma unroll
            for (int j = 0; j < 8; ++j) { const int jl = 32 * ks + 8 * q + j; wg[ks][j] = fast_exp2(lg * (float)(dir == 0 ? (127 - jl) : jl)); }
        f32x4 st[4];
#pragma unroll
        for (int d = 0; d < 4; ++d) st[d] = (f32x4){0.f, 0.f, 0.f, 0.f};
        __syncthreads();
        SCAN_ISSUE(0); SCAN_ISSUE(1); SCAN_ISSUE(2);
#pragma unroll 1
        for (int step = 0; step < 32; ++step) {
            if (wid >= 4) { if (step <= 29) asm volatile("s_waitcnt vmcnt(16)" ::: "memory"); else if (step == 30) asm volatile("s_waitcnt vmcnt(8)" ::: "memory"); else asm volatile("s_waitcnt vmcnt(0)" ::: "memory"); }
            asm volatile("s_waitcnt lgkmcnt(0)" ::: "memory");
            __builtin_amdgcn_s_barrier(); asm volatile("" ::: "memory");
            if (step + 3 < 32) SCAN_ISSUE(step + 3);
            if (wid < 4) {
                const int c = SCAN_CH(step);
                bf16_t* dst = PS + ((size_t)(bh * 32 + c) * 2 + dir) * 4096;
#pragma unroll
                for (int d = 0; d < 4; ++d) {
#pragma unroll
                    for (int r = 0; r < 4; ++r) dst[(16 * d + 4 * q + r) * 64 + 16 * wid + li] = f2bf(st[d][r]);
                    st[d] = st[d] * gC;
                }
                const PG8_LAS unsigned char* sl = (const PG8_LAS unsigned char*)lds + (step & 3) * SLOT;
#pragma unroll
                for (int ks = 0; ks < 4; ++ks) {
                    const u32x4 kr = *(const PG8_LAS u32x4*)(sl + (64 + 16 * wid + li) * 256 + (((4 * ks + q) ^ li) << 4));
                    u32x4 kw;
                    kw.x = cvt_pk_bf16(bflo(kr.x) * wg[ks][0], bfhi(kr.x) * wg[ks][1]); kw.y = cvt_pk_bf16(bflo(kr.y) * wg[ks][2], bfhi(kr.y) * wg[ks][3]);
                    kw.z = cvt_pk_bf16(bflo(kr.z) * wg[ks][4], bfhi(kr.z) * wg[ks][5]); kw.w = cvt_pk_bf16(bflo(kr.w) * wg[ks][6], bfhi(kr.w) * wg[ks][7]);
#pragma unroll
                    for (int d = 0; d < 4; ++d) {
                        const u32x4 vr = *(const PG8_LAS u32x4*)(sl + (16 * d + li) * 256 + (((4 * ks + q) ^ li) << 4));
                        st[d] = MFMA16(__builtin_bit_cast(bf16x8, vr), __builtin_bit_cast(bf16x8, kw), st[d]);
                    }
                }
            }
        }
        __syncthreads();
#undef SCAN_ISSUE
#undef SCAN_CH
    }
    u32x4 kreg[9], vreg[9], qreg[2]; float breg = 0.f;
#define NA_DECODE(xx) const int rp = (xx) & 31, h = ((xx) >> 5) & 7, b = (xx) >> 8, bh = b * 8 + h; const int r0 = 2 * rp, base_r = min(min(max(r0 - 4, 0), 56), 55)
#define NA_LOAD(xx) do { NA_DECODE(xx); const u32x4* ksrc = (const u32x4*)(NK + ((size_t)bh * SEQ + base_r * 64) * 64); \
        _Pragma("unroll") for (int i = 0; i < 9; ++i) kreg[i] = ksrc[tid + 512 * i]; \
        _Pragma("unroll") for (int i = 0; i < 9; ++i) { const int id = tid + 512 * i, row = id / 72, ch = id % 72; vreg[i] = *(const u32x4*)(NVT + ((size_t)bh * 64 + row) * SEQ + base_r * 64 + ch * 8); } \
        { const int r_ = r0 + (wid >> 2), c_q = 16 * (wid & 3) + li; const bf16_t* qp = NQ + ((size_t)bh * SEQ + r_ * 64 + c_q) * 64 + 8 * q; qreg[0] = *(const u32x4*)qp; qreg[1] = *(const u32x4*)(qp + 32); } \
        if (tid < 15 * 31) breg = p.in[6][h * 15 * 31 + tid]; } while (0)
    const bool na256 = xcdok && G_ == 256;
    const int kx = c_ >> 3, nr_ = (c_ & 7) * 24 + (kx - 8);
#define NA_UNIT(i) (na256 ? ((i) == 0 ? cswz : ((kx < 8 || (i) > 4) ? -1 : 256 + nr_ + 192 * ((i) - 1))) : (cswz + (i) * G_ < 1024 ? cswz + (i) * G_ : -1))
    int x = NA_UNIT(0), ui_ = 0;
    if (x >= 0) NA_LOAD(x);
    for (; x >= 0; ++ui_) {
        const int nx_ = NA_UNIT(ui_ + 1);
        {
            NA_DECODE(x);
            __syncthreads();
            if (tid < 15 * 31) biasL[tid] = breg;
#pragma unroll
            for (int i = 0; i < 9; ++i) { const int id = tid + 512 * i, row = id >> 3, ch = id & 7; *(u32x4*)(Ks + row * 128 + ((ch ^ (row & 7)) << 4)) = kreg[i]; }
#pragma unroll
            for (int i = 0; i < 9; ++i) { const int id = tid + 512 * i, row = id / 72, ch = id % 72; *(u32x4*)(Vs + row * VROW + ch * 16) = vreg[i]; }
            __syncthreads();
            bf16x8 qf[2]; qf[0] = __builtin_bit_cast(bf16x8, qreg[0]); qf[1] = __builtin_bit_cast(bf16x8, qreg[1]);
            if (nx_ >= 0) NA_LOAD(nx_);
            const int r = r0 + (wid >> 2), cblk = wid & 3;
            const int rs = min(max(r - 4, 0), 56), kr0 = rs - base_r;
            const int cw = cblk == 0 ? 0 : (cblk == 1 ? 8 : (cblk == 2 ? 24 : 32));
            const int c = 16 * cblk + li, cs = min(max(c - 8, 0), 48);
            const size_t qtok = (size_t)bh * SEQ + r * 64 + c;
            f32x4 sT[16];
            const int wcol_l = 8 * (li >> 2) + (li & 3);
#pragma unroll
            for (int kt = 0; kt < 16; ++kt) {
                const int krow = (kr0 + (kt >> 1)) * 64 + cw + wcol_l + 4 * (kt & 1);
                const bf16x8 k0 = *(const bf16x8*)(Ks + krow * 128 + ((q ^ (krow & 7)) << 4));
                const bf16x8 k1 = *(const bf16x8*)(Ks + krow * 128 + (((4 + q) ^ (krow & 7)) << 4));
                f32x4 a = (f32x4){0.f, 0.f, 0.f, 0.f};
                a = MFMA16(k0, qf[0], a); a = MFMA16(k1, qf[1], a);
                sT[kt] = a;
            }
            float mx = -3.0e38f;
#pragma unroll
            for (int kt = 0; kt < 16; ++kt) {
                const float* brow = biasL + (rs + (kt >> 1) - r + 7) * 31;
#pragma unroll
                for (int rr = 0; rr < 4; ++rr) {
                    const int kc = cw + 8 * q + 4 * (kt & 1) + rr;
                    const bool valid = (kc >= cs) && (kc <= cs + 15);
                    const int bi = min(max(kc - c + 15, 0), 30);
                    float bv = brow[bi]; asm volatile("" : "+v"(bv));
                    const float sv = valid ? (sT[kt][rr] + bv) : -3.0e38f;
                    sT[kt][rr] = sv; mx = fmaxf(mx, sv);
                }
            }
            mx = fmaxf(mx, __shfl_xor(mx, 16)); mx = fmaxf(mx, __shfl_xor(mx, 32));
            float sum = 0.f;
#pragma unroll
            for (int kt = 0; kt < 16; ++kt)
#pragma unroll
                for (int rr = 0; rr < 4; ++rr) { const float e = fast_exp2((sT[kt][rr] - mx) * LOG2E); sT[kt][rr] = e; sum += e; }
            sum += __shfl_xor(sum, 16); sum += __shfl_xor(sum, 32);
            const float inv = 1.0f / sum;
            f32x4 oT[4];
#pragma unroll
            for (int d = 0; d < 4; ++d) oT[d] = (f32x4){0.f, 0.f, 0.f, 0.f};
#pragma unroll
            for (int ks = 0; ks < 8; ++ks) {
                u32x4 pw; pw.x = cvt_pk_bf16(sT[2 * ks][0], sT[2 * ks][1]); pw.y = cvt_pk_bf16(sT[2 * ks][2], sT[2 * ks][3]);
                pw.z = cvt_pk_bf16(sT[2 * ks + 1][0], sT[2 * ks + 1][1]); pw.w = cvt_pk_bf16(sT[2 * ks + 1][2], sT[2 * ks + 1][3]);
                const bf16x8 pf = __builtin_bit_cast(bf16x8, pw);
                const int vtok = (kr0 + ks) * 64 + cw + 8 * q;
#pragma unroll
                for (int d = 0; d < 4; ++d) {
                    const bf16x8 vf = *(const bf16x8*)(Vs + (16 * d + li) * VROW + vtok * 2);
                    oT[d] = MFMA16(vf, pf, oT[d]);
                }
            }
            unsigned char* dst = mix + ((size_t)b * SEQ + r * 64 + c) * DM + 512 + h * 64 + 4 * q;
            const float invs = inv * MIX_SCALE;
#pragma unroll
            for (int d = 0; d < 4; ++d) *(unsigned*)(dst + 16 * d) = pk4_fp8(oT[d][0] * invs, oT[d][1] * invs, oT[d][2] * invs, oT[d][3] * invs);
        }
        x = nx_;
    }
#undef NA_UNIT
}

__device__ void phase3(const Params& p, unsigned char* lds, const int wv_) {
    unsigned char* ws = p.ws;
    const int lane = lane_id(), wid = WV, tid = wid * 64 + lane, q = lane >> 4, li = lane & 15;
    const bf16_t* Q = (const bf16_t*)(ws + WS_Q); const bf16_t* Kp = (const bf16_t*)(ws + WS_K); const bf16_t* VT = (const bf16_t*)(ws + WS_VT);
    const bf16_t* Gt = (const bf16_t*)(ws + WS_G);
    const bf16_t* PS = (const bf16_t*)(ws + WS_SST);
    unsigned char* mix = ws + WS_MIX;
    constexpr int PROW = 144;
    unsigned char* Ks = lds + 2 * 64 * PROW;
    unsigned char* Vs = Ks + 128 * 128;
    const bool pairmap = gridDim.x == 256;
    for (int it = 0, u = blockIdx.x; pairmap ? it < 4 : u < 1024; ++it, u += gridDim.x) {
        int bh, c;
        if (pairmap) { const int x_ = blockIdx.x, j = ((x_ >> 4) << 3) | (x_ & 7); bh = (j >> 5) * 8 + 4 * ((x_ >> 3) & 1) + it; c = j & 31; }
        else { bh = u >> 5; c = u & 31; }
        const int h = bh & 7, b = bh >> 3;
        const float lf = ((const float*)(ws + WS_LGT))[h], lb = ((const float*)(ws + WS_LGT))[8 + h];
        __syncthreads();
        u32x4 kreg[2], vreg[2];
#pragma unroll
        for (int i = 0; i < 2; ++i) {
            const int id = tid + 512 * i;
            kreg[i] = __builtin_nontemporal_load((const u32x4*)(Kp + ((size_t)bh * SEQ + c * 128) * 64 + id * 8));
            vreg[i] = __builtin_nontemporal_load((const u32x4*)(VT + ((size_t)bh * 64 + (id >> 4)) * SEQ + c * 128 + (id & 15) * 8));
        }
        u32x4 preg[2];
#pragma unroll
        for (int rep = 0; rep < 2; ++rep) preg[rep] = __builtin_nontemporal_load((const u32x4*)(PS + (size_t)(bh * 32 + c) * 2 * 4096 + (size_t)(tid + 512 * rep) * 8));
#pragma unroll
        for (int rep = 0; rep < 2; ++rep) {
            const int id = tid + 512 * rep, dir = id >> 9, dv = (id >> 3) & 63, ch = id & 7;
            *(u32x4*)(lds + dir * (64 * PROW) + dv * PROW + ch * 16) = preg[rep];
        }
#pragma unroll
        for (int i = 0; i < 2; ++i) {
            const int id = tid + 512 * i;
            { const int row = id >> 3, ch = id & 7; *(u32x4*)(Ks + row * 128 + ((ch ^ (row & 7)) << 4)) = kreg[i]; }
            { const int row = id >> 4, ch = id & 15; *(u32x4*)(Vs + row * 256 + ((ch ^ (row & 15)) << 4)) = vreg[i]; }
        }
        __syncthreads();
        const int ii = 16 * wid + li;
        const size_t qrow = (size_t)bh * SEQ + c * 128 + ii;
        bf16x8 qf[2];
        qf[0] = __builtin_nontemporal_load((const bf16x8*)(Q + qrow * 64 + 8 * q)); qf[1] = __builtin_nontemporal_load((const bf16x8*)(Q + qrow * 64 + 32 + 8 * q));
        f32x4 gnr[4]; u32x2 gwr[4];
#pragma unroll
        for (int d = 0; d < 4; ++d) {
            gnr[d] = *(const f32x4*)(p.in[5] + h * 64 + 16 * d + 4 * q);
            gwr[d] = __builtin_nontemporal_load((const u32x2*)(Gt + ((size_t)b * SEQ + c * 128 + ii) * 512 + h * 64 + 16 * d + 4 * q));
        }
        f32x4 sT[8];
        const int kl = 8 * (li >> 2) + (li & 3);
#pragma unroll
        for (int jt = 0; jt < 8; ++jt) {
            const int krow = 32 * (jt >> 1) + kl + 4 * (jt & 1);
            const bf16x8 k0 = *(const bf16x8*)(Ks + krow * 128 + ((q ^ (krow & 7)) << 4));
            const bf16x8 k1 = *(const bf16x8*)(Ks + krow * 128 + (((4 + q) ^ (krow & 7)) << 4));
            f32x4 a = (f32x4){0.f, 0.f, 0.f, 0.f};
            a = MFMA16(k0, qf[0], a); a = MFMA16(k1, qf[1], a);
#pragma unroll
            for (int rr = 0; rr < 4; ++rr) {
                const int j = 32 * (jt >> 1) + 8 * q + 4 * (jt & 1) + rr, diff = ii - j;
                const float d = diff >= 0 ? fast_exp2(lf * (float)diff) : fast_exp2(lb * (float)(-diff));
                a[rr] *= d;
            }
            sT[jt] = a;
        }
        f32x4 yT[4], uf[4], ub[4];
#pragma unroll
        for (int d = 0; d < 4; ++d) { yT[d] = (f32x4){0.f, 0.f, 0.f, 0.f}; uf[d] = yT[d]; ub[d] = yT[d]; }
#pragma unroll
        for (int ks = 0; ks < 4; ++ks) {
            u32x4 pw; pw.x = cvt_pk_bf16(sT[2 * ks][0], sT[2 * ks][1]); pw.y = cvt_pk_bf16(sT[2 * ks][2], sT[2 * ks][3]);
            pw.z = cvt_pk_bf16(sT[2 * ks + 1][0], sT[2 * ks + 1][1]); pw.w = cvt_pk_bf16(sT[2 * ks + 1][2], sT[2 * ks + 1][3]);
            const bf16x8 pf = __builtin_bit_cast(bf16x8, pw);
#pragma unroll
            for (int d = 0; d < 4; ++d) {
                const int vrow = 16 * d + li;
                const bf16x8 vf = *(const bf16x8*)(Vs + vrow * 256 + (((4 * ks + q) ^ li) << 4));
                yT[d] = MFMA16(vf, pf, yT[d]);
            }
        }
#pragma unroll
        for (int d = 0; d < 4; ++d)
#pragma unroll
            for (int ks = 0; ks < 2; ++ks) {
                const bf16x8 pfw = *(const bf16x8*)(lds + (16 * d + li) * PROW + ks * 64 + q * 16);
                const bf16x8 pbw = *(const bf16x8*)(lds + 64 * PROW + (16 * d + li) * PROW + ks * 64 + q * 16);
                uf[d] = MFMA16(pfw, qf[ks], uf[d]); ub[d] = MFMA16(pbw, qf[ks], ub[d]);
            }
        const float df = fast_exp2(lf * (float)(ii + 1)), db = fast_exp2(lb * (float)(128 - ii));
        float sum = 0.f;
#pragma unroll
        for (int d = 0; d < 4; ++d)
#pragma unroll
            for (int rr = 0; rr < 4; ++rr) { const float y = yT[d][rr] + df * uf[d][rr] + db * ub[d][rr]; yT[d][rr] = y; sum += y; }
        sum += __shfl_xor(sum, 16); sum += __shfl_xor(sum, 32);
        const float mu = sum * (1.0f / 64.0f);
        float var = 0.f;
#pragma unroll
        for (int d = 0; d < 4; ++d)
#pragma unroll
            for (int rr = 0; rr < 4; ++rr) { const float t = yT[d][rr] - mu; var += t * t; }
        var += __shfl_xor(var, 16); var += __shfl_xor(var, 32);
        const float rstd = rsqrtf(var * (1.0f / 64.0f) + 1e-6f) * MIX_SCALE;
        const size_t tg = (size_t)b * SEQ + c * 128 + ii;
#pragma unroll
        for (int d = 0; d < 4; ++d) {
            const int dv = 16 * d + 4 * q;
            const f32x4 gn = gnr[d];
            const u32x2 gw = gwr[d];
            const float o0 = (yT[d][0] - mu) * rstd * gn[0] * bflo(gw.x), o1 = (yT[d][1] - mu) * rstd * gn[1] * bfhi(gw.x);
            const float o2 = (yT[d][2] - mu) * rstd * gn[2] * bflo(gw.y), o3 = (yT[d][3] - mu) * rstd * gn[3] * bfhi(gw.y);
            *(unsigned*)(mix + tg * DM + h * 64 + dv) = pk4_fp8(o0, o1, o2, o3);
        }
    }
}

__device__ void phase4(const Params& p, unsigned char* lds, const int wv_) {
    unsigned char* ws = p.ws;
    const int lane = lane_id(), wid = WV, tid = wid * 64 + lane, q = lane >> 4, li = lane & 15;
    const unsigned char* A = ws + WS_MIX; const unsigned char* Bt = ws + WS_WOUTT;
    const float* x = p.in[0]; const float* g1 = p.in[8]; const float* b1 = p.in[9]; const float* rb = p.in[11];
    bf16_t* x1b = (bf16_t*)(ws + WS_X1B);
    unsigned* counts = (unsigned*)(ws + WS_CTRL);
    int* ltok = (int*)(ws + WS_LTOK); float2* lkw = (float2*)(ws + WS_LKW);
    float* pl = (float*)lds;
    float* red = (float*)(lds + 147456);
    unsigned* lcnt = (unsigned*)(lds + 147456 + 2048);
    float* red2 = (float*)(lds + 147456 + 2560);
    float* gbL = (float*)(lds + 131072);
    if (tid < 256) { *(f32x4*)(gbL + 4 * tid) = *(const f32x4*)(g1 + 4 * tid); *(f32x4*)(gbL + 1024 + 4 * tid) = *(const f32x4*)(b1 + 4 * tid); }
    for (int unit0 = blockIdx.x; unit0 < T_TOK / 64; unit0 += gridDim.x) {
        const int unit = gridDim.x == 256 ? ((((unit0 >> 4) << 3) | (unit0 & 7)) * 2 + ((unit0 >> 3) & 1)) : unit0;
        const int m0 = unit * 64;
        f32x4 acc[4][8];
        {
            int lane2 = lane_id(); asm volatile("" : "+v"(lane2)); const int li2 = lane2 & 15, q2 = lane2 >> 4;
            constexpr int GA = 64 * 128, GSTAGE = GA + 256 * 128;
            PG8_LAS unsigned char* L = (PG8_LAS unsigned char*)lds;
            const int prow = lane2 >> 3, pch = (lane2 & 7) ^ (lane2 >> 3);
            const char* asrc = (const char*)(A + (size_t)(m0 + 8 * wid + prow) * DM) + pch * 16;
            const char* bsrc = (const char*)(Bt + (size_t)(128 * wid + prow) * DM) + pch * 16;
            const unsigned rA = (unsigned)li2 * 128u, rB = (unsigned)GA + (unsigned)(wid * 32 + li2) * 128u;
            const unsigned c0_ = (unsigned)((q2 ^ (li2 & 7)) << 4), c1_ = (unsigned)(((4 + q2) ^ (li2 & 7)) << 4);
#define P4_ISSUE(T, ST) do { const int _ps = (T) >> 3, _kt = (T) & 7, _st = (ST); \
        __builtin_amdgcn_global_load_lds((const unsigned*)(asrc + _kt * 128), (PG8_LAS unsigned*)(L + _st * GSTAGE + wid * 1024), 16, 0, 0); \
        _Pragma("unroll") for (int _j = 0; _j < 4; ++_j) __builtin_amdgcn_global_load_lds((const unsigned*)(bsrc + (size_t)(32 * _ps + 8 * _j) * DM + _kt * 128), \
            (PG8_LAS unsigned*)(L + _st * GSTAGE + GA + (4 * wid + _j) * 1024), 16, 0, 0); } while (0)
            __syncthreads();
            P4_ISSUE(0, 0); P4_ISSUE(1, 1);
            int st_c = 0, st_n = 2;
            asm volatile("s_waitcnt vmcnt(5)" ::: "memory");
            __builtin_amdgcn_s_barrier(); asm volatile("" ::: "memory");
#pragma unroll
            for (int ps = 0; ps < 4; ++ps) {
#pragma unroll
                for (int m = 0; m < 4; ++m)
#pragma unroll
                    for (int n = 0; n < 2; ++n) acc[m][2 * ps + n] = (f32x4){0.f, 0.f, 0.f, 0.f};
#pragma unroll 1
                for (int kt = 0; kt < 8; ++kt) {
                    const int T = ps * 8 + kt;
                    if (T + 2 < 32) P4_ISSUE(T + 2, st_n);
                    const PG8_LAS unsigned char* cur = L + st_c * GSTAGE;
                    st_c = st_c == 2 ? 0 : st_c + 1; st_n = st_n == 2 ? 0 : st_n + 1;
                    {
                        bf16x8 af[4][2], bfr[2][2];
#pragma unroll
                        for (int m = 0; m < 4; ++m) { af[m][0] = *(const PG8_LAS bf16x8*)(cur + rA + m * 2048 + c0_); af[m][1] = *(const PG8_LAS bf16x8*)(cur + rA + m * 2048 + c1_); }
#pragma unroll
                        for (int n = 0; n < 2; ++n) { bfr[n][0] = *(const PG8_LAS bf16x8*)(cur + rB + n * 2048 + c0_); bfr[n][1] = *(const PG8_LAS bf16x8*)(cur + rB + n * 2048 + c1_); }
                        asm volatile("s_waitcnt lgkmcnt(0)" ::: "memory");
#pragma unroll
                        for (int m = 0; m < 4; ++m)
#pragma unroll
                            for (int n = 0; n < 2; ++n) { const pg8::i32x8_t _b8 = pg8::cat8(bfr[n][0], bfr[n][1]), _a8 = pg8::cat8(af[m][0], af[m][1]);
                                asm volatile("v_mfma_f32_16x16x128_f8f6f4 %0, %1, %2, %0" : "+v"(acc[m][2 * ps + n]) : "v"(_b8), "v"(_a8)); }
                    }
                    if (T + 2 < 32) asm volatile("s_waitcnt vmcnt(5) lgkmcnt(0)" ::: "memory");
                    else            asm volatile("s_waitcnt vmcnt(0) lgkmcnt(0)" ::: "memory");
                    __builtin_amdgcn_s_barrier(); asm volatile("" ::: "memory");
                }
            }
#undef P4_ISSUE
            asm volatile("s_nop 15" ::: "memory");
            __syncthreads();
        }
        int li_ = li, q_ = q, lane_ = lane; asm volatile("" : "+v"(li_), "+v"(q_), "+v"(lane_));
        {
            PG8_LAS unsigned char* XL = (PG8_LAS unsigned char*)lds;
            const bf16_t* xb = (const bf16_t*)(ws + WS_XB);
#define P4_XISSUE(mm) do { _Pragma("unroll") for (int _j = 0; _j < 4; ++_j) { const int _pc = 4 * wid + _j, _rr = _pc >> 1, _qd = _pc & 1; \
        __builtin_amdgcn_global_load_lds((const unsigned*)((const char*)(xb + (size_t)(m0 + 16 * (mm) + _rr) * DM) + (64 * _qd + (lane_ ^ _rr)) * 16), \
            (PG8_LAS unsigned*)(XL + ((mm) & 1) * 32768 + _rr * 2048 + _qd * 1024), 16, 0, 2); } } while (0)
            P4_XISSUE(0); P4_XISSUE(1);
#pragma unroll
            for (int m = 0; m < 4; ++m) {
                if (m < 3) asm volatile("s_waitcnt vmcnt(4)" ::: "memory"); else asm volatile("s_waitcnt vmcnt(0)" ::: "memory");
                __builtin_amdgcn_s_barrier(); asm volatile("" ::: "memory");
                const PG8_LAS unsigned char* xb_ = XL + (m & 1) * 32768 + li_ * 2048;
                float s = 0.f, s2 = 0.f;
#pragma unroll
                for (int pr = 0; pr < 4; ++pr) {
                    const int lc = 16 * wid + 4 * pr + q_;
                    const u32x4 xv = *(const PG8_LAS u32x4*)(xb_ + ((lc ^ li_) << 4));
                    const f32x4 x0 = {bflo(xv.x), bfhi(xv.x), bflo(xv.y), bfhi(xv.y)}, x1v = {bflo(xv.z), bfhi(xv.z), bflo(xv.w), bfhi(xv.w)};
                    acc[m][2 * pr] = x0 * (ALPHA / O_DESCALE) + acc[m][2 * pr]; acc[m][2 * pr + 1] = x1v * (ALPHA / O_DESCALE) + acc[m][2 * pr + 1];
                    { const f32x4 A_ = acc[m][2 * pr], B_ = acc[m][2 * pr + 1], t_ = A_ + B_, q2_ = A_ * A_ + B_ * B_;
                      s += (t_[0] + t_[1]) + (t_[2] + t_[3]); s2 += (q2_[0] + q2_[1]) + (q2_[2] + q2_[3]); }
                }
                s += shx(s, 16, lane_); s += shx(s, 32, lane_); s2 += shx(s2, 16, lane_); s2 += shx(s2, 32, lane_);
                if (q_ == 0) { red[wid * 64 + 16 * m + li_] = s; red2[wid * 64 + 16 * m + li_] = s2; }
                if (m < 2) {
                    asm volatile("s_waitcnt lgkmcnt(0)" ::: "memory");
                    __builtin_amdgcn_s_barrier(); asm volatile("" ::: "memory");
                    if (m == 0) P4_XISSUE(2); else P4_XISSUE(3);
                }
            }
#undef P4_XISSUE
        }
        __syncthreads();
#pragma unroll
        for (int m = 0; m < 4; ++m) {
            float sa = 0.f, sb = 0.f;
#pragma unroll
            for (int w = 0; w < 8; ++w) { sa += red[w * 64 + 16 * m + li_]; sb += red2[w * 64 + 16 * m + li_]; }
            const float mu = sa * (1.0f / 1024.0f), var = fmaxf(sb * (1.0f / 1024.0f) - mu * mu, 0.f), rstd = rsqrtf(var + 1e-5f / (O_DESCALE * O_DESCALE));
#pragma unroll
            for (int n = 0; n < 8; ++n) acc[m][n] = (acc[m][n] - mu) * rstd;
        }
        __syncthreads();
        const u32x4* wfp = (const u32x4*)(ws + WS_WRF) + (size_t)wid * 2048 + (q_ * 16 + li_);
#pragma unroll
        for (int mh = 0; mh < 2; ++mh) {
            f32x4 lg[2][4];
#pragma unroll
            for (int m = 0; m < 2; ++m)
#pragma unroll
                for (int n = 0; n < 4; ++n) lg[m][n] = (f32x4){0.f, 0.f, 0.f, 0.f};
#pragma unroll
            for (int pr = 0; pr < 4; ++pr) {
                const int c0 = 128 * wid + 32 * pr + 8 * q_;
                const f32x4 ga = *(const f32x4*)(gbL + c0), gb = *(const f32x4*)(gbL + c0 + 4), ba = *(const f32x4*)(gbL + 1024 + c0), bb = *(const f32x4*)(gbL + 1024 + c0 + 4);
                bf16x8 wfh[4], wfl[4];
                const u32x4* wp = wfp + pr * 512; asm volatile("" : "+v"(wp));
#pragma unroll
                for (int nt = 0; nt < 4; ++nt) { wfh[nt] = __builtin_bit_cast(bf16x8, wp[nt * 128]); wfl[nt] = __builtin_bit_cast(bf16x8, wp[nt * 128 + 64]); }
#pragma unroll
                for (int m2 = 0; m2 < 2; ++m2) {
                    const int m = 2 * mh + m2;
                    const f32x4 oa_ = acc[m][2 * pr] * ga + ba, ob_ = acc[m][2 * pr + 1] * gb + bb;
                    const float o[8] = {oa_[0], oa_[1], oa_[2], oa_[3], ob_[0], ob_[1], ob_[2], ob_[3]};
                    u32x4 hi, lo;
                    hi.x = cvt_pk_bf16(o[0], o[1]); hi.y = cvt_pk_bf16(o[2], o[3]); hi.z = cvt_pk_bf16(o[4], o[5]); hi.w = cvt_pk_bf16(o[6], o[7]);
                    lo.x = cvt_pk_bf16(o[0] - bflo(hi.x), o[1] - bfhi(hi.x)); lo.y = cvt_pk_bf16(o[2] - bflo(hi.y), o[3] - bfhi(hi.y));
                    lo.z = cvt_pk_bf16(o[4] - bflo(hi.z), o[5] - bfhi(hi.z)); lo.w = cvt_pk_bf16(o[6] - bflo(hi.w), o[7] - bfhi(hi.w));
                    __builtin_nontemporal_store(hi, (u32x4*)(x1b + (size_t)(m0 + 16 * m + li_) * DM + c0));
                    { const f32x4 sa_ = oa_ * X1_SCALE, sb_ = ob_ * X1_SCALE;
                      u32x2 f8; f8.x = pk4_fp8(sa_[0], sa_[1], sa_[2], sa_[3]); f8.y = pk4_fp8(sb_[0], sb_[1], sb_[2], sb_[3]);
                      *(u32x2*)(ws + WS_X1F8 + (size_t)(m0 + 16 * m + li_) * DM + c0) = f8; }
                    const bf16x8 xh = __builtin_bit_cast(bf16x8, hi), xl = __builtin_bit_cast(bf16x8, lo);
#pragma unroll
                    for (int nt = 0; nt < 4; ++nt) {
                        lg[m2][nt] = MFMA16(wfl[nt], xh, lg[m2][nt]);
                        lg[m2][nt] = MFMA16(wfh[nt], xl, lg[m2][nt]);
                        lg[m2][nt] = MFMA16(wfh[nt], xh, lg[m2][nt]);
                    }
                }
            }
#pragma unroll
            for (int m2 = 0; m2 < 2; ++m2)
#pragma unroll
                for (int nt = 0; nt < 4; ++nt) *(f32x4*)(pl + (wid * 64 + 16 * (2 * mh + m2) + li_) * 64 + 16 * nt + 4 * q_) = lg[m2][nt];
        }
        if (wid == 0) lcnt[lane_] = 0u;
        __syncthreads();
        const float rbias = rb[lane_];
        unsigned selmask = 0u; unsigned lpos[8]; float lw[8]; int lrank[8];
#pragma unroll
        for (int k = 0; k < 8; ++k) {
            const int tk = wid * 8 + k;
            float logit = 0.f;
#pragma unroll
            for (int w = 0; w < 8; ++w) logit += pl[(w * 64 + tk) * 64 + lane_];
            const float score = 1.0f / (1.0f + expf(-logit));
            const float biased = score + rbias;
            float m1 = biased;
            m1 = fmaxf(m1, shx(m1, 1, lane_)); m1 = fmaxf(m1, shx(m1, 2, lane_)); m1 = fmaxf(m1, shx(m1, 4, lane_));
            const unsigned long long eqm = __ballot(biased == m1);
            const int g = lane_ >> 3;
            const unsigned gbits = (unsigned)((eqm >> (8 * g)) & 0xffull);
            const int first = __builtin_ctz(gbits);
            float m2 = ((lane_ & 7) == first) ? -3.0e38f : biased;
            m2 = fmaxf(m2, shx(m2, 1, lane_)); m2 = fmaxf(m2, shx(m2, 2, lane_)); m2 = fmaxf(m2, shx(m2, 4, lane_));
            const float gs = m1 + m2;
            const unsigned gsu = __float_as_uint(gs), gkey = ((gsu ^ ((gsu >> 31) ? 0xffffffffu : 0x80000000u)) & ~7u) | (unsigned)(7 - g);
            int grank = 0;
#pragma unroll
            for (int g2 = 0; g2 < 8; ++g2) grank += ((unsigned)__builtin_amdgcn_readlane((int)gkey, 8 * g2) > gkey) ? 1 : 0;
            const bool gsel = grank < 4;
            const unsigned bu = __float_as_uint(biased), vkey = gsel ? (((bu ^ ((bu >> 31) ? 0xffffffffu : 0x80000000u)) & ~63u) | (unsigned)(63 - lane_)) : 0u;
            int rank = 0;
            const unsigned long long gm = __ballot(gsel);
#pragma unroll
            for (int g2 = 0; g2 < 8; ++g2)
                if ((gm >> (8 * g2)) & 1ull) {
#pragma unroll
                    for (int i2 = 0; i2 < 8; ++i2) rank += ((unsigned)__builtin_amdgcn_readlane((int)vkey, 8 * g2 + i2) > vkey) ? 1 : 0;
                }
            const bool sel = gsel && rank < 8;
            const float wsum = wave_sum_l(sel ? score : 0.f, lane_);
            lw[k] = score / wsum * 2.5f; lrank[k] = rank; lpos[k] = 0u;
            if (sel) { selmask |= 1u << k; lpos[k] = atomicAdd(&lcnt[lane_], 1u); }
        }
        __syncthreads();
        if (wid == 0) lcnt[64 + lane_] = atomicAdd(&counts[lane_ * 64], lcnt[lane_]);
        __syncthreads();
        {
            const unsigned gbase = lcnt[64 + lane_];
#pragma unroll
            for (int k = 0; k < 8; ++k)
                if (selmask & (1u << k)) {
                    const unsigned pos = gbase + lpos[k];
                    ltok[(size_t)lane_ * T_TOK + pos] = m0 + wid * 8 + k;
                    float2 kw; kw.x = __int_as_float(lrank[k]); kw.y = lw[k];
                    lkw[(size_t)lane_ * T_TOK + pos] = kw;
                }
        }
    }
}

struct BlkTab { int start[65]; int total; };
__device__ __forceinline__ void build_blktab(const unsigned* counts, int* tab  , const int wv_) {
    if (WV == 0) {
        const int lane = lane_id();
        const int nb = ((int)counts[lane * 64] + 255) >> 8;
        int incl = nb;
#pragma unroll
        for (int o = 1; o < 64; o <<= 1) { const int v = __shfl_up(incl, o); if (lane >= o) incl += v; }
        tab[lane] = incl - nb;
        if (lane == 63) tab[64] = incl;
    }
    __syncthreads();
}
__device__ __forceinline__ int find_expert(const int* tab, int blk) {
    int e = 0;
#pragma unroll 1
    for (int s = 32; s >= 1; s >>= 1) if (e + s < 64 && tab[e + s] <= blk) e += s;
    return e;
}

constexpr int P6_TAB_OFF = pg8::STAGE_BYTES;
constexpr int P6_UT_OFF = P6_TAB_OFF + 512;
__device__ __forceinline__ int unit_index(int i) { const int G_ = gridDim.x, c_ = blockIdx.x; return i * G_ + ((G_ & 7) == 0 ? (c_ & 7) * (G_ >> 3) + (c_ >> 3) : c_); }
struct Sched6a {
    static constexpr bool VARK = false;
    unsigned char* ws; const int* ut;
    __device__ static void build(const unsigned char* ws, const int* tab, int* ut, const int wv_) {
        if (WV == 0) {
            const int i = lane_id();
            if (i < 16) {
                const int nbr = tab[64], L = unit_index(i), n_r = 2 * nbr, n_s = 2 * NBLK_S;
                int e = -1, pm = 0, pn = 0, bin = 0, cnt = 0;
                if (L < n_r + n_s) {
                    const int blk = L >> 1; pn = L & 1;
                    if (L < n_r) { e = find_expert(tab, blk); bin = blk - tab[e]; cnt = (int)((const unsigned*)(ws + WS_CTRL))[e * 64]; pm = blk; }
                    else { e = 64; bin = blk - nbr; cnt = T_TOK; pm = MAXBLK_R + bin; }
                } else { const int x = L - n_r - n_s; if (x < 256) { e = 65; pm = x >> 2; pn = x & 3; bin = x >> 2; cnt = T_TOK; } }
                int* d = ut + 8 * i; d[0] = e; d[1] = pm; d[2] = pn; d[3] = bin; d[4] = cnt;
            }
        }
        __syncthreads();
    }
    __device__ bool next(int i, pg8::Unit& u) const {
        const pg8::i32x4_t a = *(const pg8::i32x4_t*)(ut + 8 * i); const int cnt = ut[8 * i + 4];
        const int e = rfl(a.x);
        if (e < 0) return false;
        u.pm = rfl(a.y); u.pn = rfl(a.z); u.x0 = e; u.x1 = rfl(a.w); u.x2 = rfl(cnt); u.x3 = 0;
        u.A = (const char*)(ws + WS_X1F8);
        u.B = e == 65 ? (const char*)(ws + WS_WGATE) + (size_t)(u.pn * 256) * DM : (const char*)(ws + WS_WGUT) + ((size_t)e * 512 + 256 * u.pn) * DM;
        return true;
    }
    __device__ int arow(const pg8::Unit& u, int r) const {
        const int pos = u.x1 * 256 + r;
        if (u.x0 >= 64) return pos;
        return pos < u.x2 ? ((const int*)(ws + WS_LTOK))[(size_t)u.x0 * T_TOK + pos] : 0;
    }
    __device__ int arow_lds(const pg8::Unit& u, int r, const PG8_LAS unsigned char* meta) const {
        const int pos = u.x1 * 256 + r;
        if (u.x0 >= 64) return pos;
        return pos < u.x2 ? ((const PG8_LAS int*)(meta + 2048))[r] : 0;
    }
};
struct Epi6a {
    static constexpr bool PERM = false; static constexpr int NMETA = 3;
    unsigned char* ws;
    __device__ const char* meta_src(const pg8::Unit& u, int i) const {
        const size_t base = (size_t)(u.x0 & 63) * T_TOK + (size_t)u.x1 * 256;
        return i < 2 ? (const char*)(ws + WS_LKW) + base * 8 + i * 1024 : (const char*)(ws + WS_LTOK) + base * 4;
    }
    __device__ __forceinline__ void operator()(const f32x4 (&acc)[2][2][4][2], const pg8::Unit& u, int wr, int wc, int fr_, int fq_, const PG8_LAS unsigned char* meta) const {
        int fr = fr_, fq = fq_; asm volatile("" : "+v"(fr), "+v"(fq));
        if (u.x0 == 65) {
            const bf16_t* proj = (const bf16_t*)(ws + WS_PLE); unsigned char* ple8 = ws + WS_PLE8;
#pragma unroll
            for (int ai = 0; ai < 2; ++ai)
#pragma unroll
                for (int m = 0; m < 4; ++m) {
                    const size_t t = u.pm * 256 + 128 * ai + 64 * wr + 16 * m + fr;
                    const int c0 = u.pn * 256 + 64 * wc + 16 * fq;
                    const u32x4 p0 = __builtin_nontemporal_load((const u32x4*)(proj + t * DM + c0)), p1 = __builtin_nontemporal_load((const u32x4*)(proj + t * DM + c0 + 8));
                    const unsigned pj[8] = {p0.x, p0.y, p0.z, p0.w, p1.x, p1.y, p1.z, p1.w};
                    unsigned o[4];
#pragma unroll
                    for (int bj = 0; bj < 2; ++bj)
#pragma unroll
                        for (int n = 0; n < 2; ++n) {
                            const f32x4 a = acc[ai][bj][m][n] * GU_DESCALE;
                            const unsigned q0 = pj[4 * bj + 2 * n], q1 = pj[4 * bj + 2 * n + 1];
                            o[2 * bj + n] = pk4_fp8(sigmoidf_(a[0]) * bflo(q0) * PLE_SCALE, sigmoidf_(a[1]) * bfhi(q0) * PLE_SCALE, sigmoidf_(a[2]) * bflo(q1) * PLE_SCALE, sigmoidf_(a[3]) * bfhi(q1) * PLE_SCALE);
                        }
                    u32x4 w; w.x = o[0]; w.y = o[1]; w.z = o[2]; w.w = o[3];
                    __builtin_nontemporal_store(w, (u32x4*)(ple8 + t * DM + c0));
                    asm volatile("" ::: "memory");
                }
        } else {
            unsigned char* Hb = ws + WS_HBUF;
#pragma unroll
            for (int ai = 0; ai < 2; ++ai)
#pragma unroll
                for (int m = 0; m < 4; ++m) {
                    const int row = 128 * ai + 64 * wr + 16 * m + fr, pos = u.x1 * 256 + row;
                    float w = 1.0f;
                    if (u.x0 < 64) w = pos < u.x2 ? ((const PG8_LAS float*)meta)[2 * row + 1] : 0.f;
                    unsigned char* dst = Hb + ((size_t)u.pm * 256 + row) * EDIM + 128 * u.pn + 32 * wc + 8 * fq;
                    u32x2 wv; w *= H_SCALE * GU_DESCALE * GU_DESCALE;
                    typedef float f32x2 __attribute__((ext_vector_type(2)));
#pragma unroll
                    for (int n = 0; n < 2; ++n) {
                        const f32x4 g = acc[ai][0][m][n], uu = acc[ai][1][m][n];
                        const f32x2 g0 = {g[0], g[1]}, g1 = {g[2], g[3]}, u0 = {uu[0], uu[1]}, u1 = {uu[2], uu[3]};
                        const f32x2 t0 = g0 * (-GU_DESCALE * LOG2E), t1 = g1 * (-GU_DESCALE * LOG2E);
                        const f32x2 d0 = (f32x2){fast_exp2(t0[0]), fast_exp2(t0[1])} + 1.0f, d1 = (f32x2){fast_exp2(t1[0]), fast_exp2(t1[1])} + 1.0f;
                        const f32x2 r0 = {__builtin_amdgcn_rcpf(d0[0]), __builtin_amdgcn_rcpf(d0[1])}, r1 = {__builtin_amdgcn_rcpf(d1[0]), __builtin_amdgcn_rcpf(d1[1])};
                        const f32x2 h0 = (g0 * u0) * (r0 * w), h1 = (g1 * u1) * (r1 * w);
                        const unsigned pk = pk4_fp8(h0[0], h0[1], h1[0], h1[1]);
                        if (n == 0) wv.x = pk; else wv.y = pk;
                    }
                    *(u32x2*)dst = wv;
                    asm volatile("" ::: "memory");
                }
        }
    }
};
__device__ void phase6a(const Params& p, unsigned char* lds, const int wv_) {
    int* tab = (int*)(lds + P6_TAB_OFF);
    build_blktab((const unsigned*)(p.ws + WS_CTRL), tab, wv_);
    int* ut = (int*)(lds + P6_UT_OFF);
    Sched6a::build(p.ws, tab, ut, wv_);
    Sched6a S; S.ws = p.ws; S.ut = ut;
    Epi6a E; E.ws = p.ws;
    pg8::gemm_phase<Epi6a, Sched6a, true, true, true, true>((PG8_LAS unsigned char*)lds, DM / 2, S, E, wv_);
}

struct Sched6b {
    static constexpr bool VARK = false;
    unsigned char* ws; const int* ut;
    __device__ static void build(const unsigned char* ws, const int* tab, int* ut, const int wv_) {
        if (WV == 0) {
            const int i = lane_id();
            if (i < 16) {
                const int nbr = tab[64], L = unit_index(i), n_r = 4 * nbr, n_s = 4 * NBLK_S;
                int e = -1, hblk = 0, pn = 0, bin = 0, cnt = 0;
                if (L < n_r + n_s) {
                    const int blk = L >> 2; pn = L & 3;
                    if (L < n_r) { e = find_expert(tab, blk); bin = blk - tab[e]; cnt = (int)((const unsigned*)(ws + WS_CTRL))[e * 64]; hblk = blk; }
                    else { e = 64; bin = blk - nbr; cnt = T_TOK; hblk = MAXBLK_R + bin; }
                }
                int* d = ut + 8 * i; d[0] = e; d[1] = hblk; d[2] = pn; d[3] = bin; d[4] = cnt;
            }
        }
        __syncthreads();
    }
    __device__ bool next(int i, pg8::Unit& u) const {
        const pg8::i32x4_t a = *(const pg8::i32x4_t*)(ut + 8 * i); const int cnt = ut[8 * i + 4];
        const int e = rfl(a.x);
        if (e < 0) return false;
        u.pm = rfl(a.y); u.pn = rfl(a.z); u.x0 = e; u.x1 = rfl(a.w); u.x2 = rfl(cnt); u.x3 = 0;
        u.A = (const char*)(ws + WS_HBUF) + (size_t)u.pm * 256 * EDIM; u.B = (const char*)(ws + WS_WDT) + ((size_t)e * 1024 + 256 * u.pn) * EDIM;
        return true;
    }
    __device__ int arow(const pg8::Unit&, int r) const { return r; }
};
struct Epi6b {
    static constexpr bool PERM = false;
    static constexpr int NMETA = 3;
    unsigned char* ws;
    __device__ const char* meta_src(const pg8::Unit& u, int i) const {
        const size_t base = (size_t)(u.x0 & 63) * T_TOK + (size_t)u.x1 * 256;
        return i < 2 ? (const char*)(ws + WS_LKW) + base * 8 + i * 1024 : (const char*)(ws + WS_LTOK) + base * 4;
    }
    __device__ __forceinline__ void operator()(const f32x4 (&acc)[2][2][4][2], const pg8::Unit& u, int wr, int wc, int fr_, int fq_, const PG8_LAS unsigned char* meta) const {
        int fr = fr_, fq = fq_; asm volatile("" : "+v"(fr), "+v"(fq));
        unsigned char* part = ws + WS_PART; unsigned char* sho = ws + WS_SHO;
#pragma unroll
        for (int ai = 0; ai < 2; ++ai)
#pragma unroll
            for (int m = 0; m < 4; ++m) {
                const int row = 128 * ai + 64 * wr + 16 * m + fr, pos = u.x1 * 256 + row;
                const int c0 = u.pn * 256 + 64 * wc + 16 * fq;
                if (u.x0 == 64) {
                    u32x4 w; unsigned wq[4];
#pragma unroll
                    for (int bj = 0; bj < 2; ++bj)
#pragma unroll
                        for (int n = 0; n < 2; ++n) {
                            const f32x4 a = acc[ai][bj][m][n];
                            unsigned x = (unsigned)__builtin_amdgcn_cvt_pk_fp8_f32(a[0], a[1], 0, false); x = (unsigned)__builtin_amdgcn_cvt_pk_fp8_f32(a[2], a[3], (int)x, true);
                            wq[2 * bj + n] = x;
                        }
                    w.x = wq[0]; w.y = wq[1]; w.z = wq[2]; w.w = wq[3];
                    *(u32x4*)(sho + (size_t)pos * DM + c0) = w;
                } else if (pos < u.x2) {
                    const int d = ((const PG8_LAS int*)(meta + 2048))[row] * 8 + ((const PG8_LAS int*)meta)[2 * row];
                    u32x4 w; unsigned wq[4];
#pragma unroll
                    for (int bj = 0; bj < 2; ++bj)
#pragma unroll
                        for (int n = 0; n < 2; ++n) {
                            const f32x4 a = acc[ai][bj][m][n];
                            unsigned x = (unsigned)__builtin_amdgcn_cvt_pk_fp8_f32(a[0], a[1], 0, false); x = (unsigned)__builtin_amdgcn_cvt_pk_fp8_f32(a[2], a[3], (int)x, true);
                            wq[2 * bj + n] = x;
                        }
                    w.x = wq[0]; w.y = wq[1]; w.z = wq[2]; w.w = wq[3];
                    *(u32x4*)(part + (size_t)d * DM + c0) = w;
                }
            }
    }
};
__device__ void phase6b(const Params& p, unsigned char* lds, const int wv_) {
    int* tab = (int*)(lds + P6_TAB_OFF);
    build_blktab((const unsigned*)(p.ws + WS_CTRL), tab, wv_);
    int* ut = (int*)(lds + P6_UT_OFF);
    Sched6b::build(p.ws, tab, ut, wv_);
    Sched6b S; S.ws = p.ws; S.ut = ut;
    Epi6b E; E.ws = p.ws;
    int kk = EDIM / 2; asm volatile("" : "+s"(kk));
    pg8::gemm_phase<Epi6b, Sched6b, false, true, true, true>((PG8_LAS unsigned char*)lds, kk, S, E, wv_);
}

__device__ void phase7(const Params& p, unsigned char* lds, const int wv_) {
    unsigned char* ws = p.ws;
    const int lane = lane_id(), wid = WV;
    const bf16_t* x1b = (const bf16_t*)(ws + WS_X1B); const unsigned char* ple = ws + WS_PLE8; const unsigned char* sho = ws + WS_SHO;
    const unsigned char* part = ws + WS_PART;
    const float* g2 = p.in[18]; const float* b2 = p.in[19];
    typedef float f32x2v __attribute__((ext_vector_type(2)));
    float* rowL = (float*)(lds + wid * 4096);
    f32x4 ggr[4], bbr[4];
#pragma unroll
    for (int i = 0; i < 4; ++i) { ggr[i] = *(const f32x4*)(g2 + 256 * i + 4 * lane); bbr[i] = *(const f32x4*)(b2 + 256 * i + 4 * lane); }
    for (int t0 = (blockIdx.x * 8 + wid) * 2; t0 < T_TOK; t0 += gridDim.x * 16) {
        u32x4 xr[2][2]; u32x2 pr[2][2], ar[2][2][9];
#pragma unroll
        for (int tt = 0; tt < 2; ++tt)
#pragma unroll
            for (int hf = 0; hf < 2; ++hf) {
                const size_t t = t0 + tt; const int c0 = 512 * hf + 8 * lane;
                xr[tt][hf] = *(const u32x4*)(x1b + t * DM + c0); pr[tt][hf] = *(const u32x2*)(ple + t * DM + c0); ar[tt][hf][8] = *(const u32x2*)(sho + t * DM + c0);
#pragma unroll
                for (int k = 0; k < 8; ++k) ar[tt][hf][k] = __builtin_nontemporal_load((const u32x2*)(part + (t * 8 + k) * DM + c0));
            }
#pragma unroll
        for (int tt = 0; tt < 2; ++tt) {
            const size_t t = t0 + tt;
            float v[16];
#pragma unroll
            for (int hf = 0; hf < 2; ++hf) {
                float rsum[8];
#pragma unroll
                for (int i = 0; i < 8; ++i) rsum[i] = 0.f;
#pragma unroll
                for (int k = 0; k < 9; ++k) {
                    const u32x2 a = ar[tt][hf][k];
                    const f32x2v l0 = __builtin_amdgcn_cvt_pk_f32_fp8((int)a.x, false), h0 = __builtin_amdgcn_cvt_pk_f32_fp8((int)a.x, true);
                    const f32x2v l1 = __builtin_amdgcn_cvt_pk_f32_fp8((int)a.y, false), h1 = __builtin_amdgcn_cvt_pk_f32_fp8((int)a.y, true);
                    rsum[0] += l0[0]; rsum[1] += l0[1]; rsum[2] += h0[0]; rsum[3] += h0[1]; rsum[4] += l1[0]; rsum[5] += l1[1]; rsum[6] += h1[0]; rsum[7] += h1[1];
                }
                const u32x4 xv = xr[tt][hf]; const u32x2 pv = pr[tt][hf];
                const unsigned xw[4] = {xv.x, xv.y, xv.z, xv.w};
                const f32x2v pl0 = __builtin_amdgcn_cvt_pk_f32_fp8((int)pv.x, false), ph0 = __builtin_amdgcn_cvt_pk_f32_fp8((int)pv.x, true);
                const f32x2v pl1 = __builtin_amdgcn_cvt_pk_f32_fp8((int)pv.y, false), ph1 = __builtin_amdgcn_cvt_pk_f32_fp8((int)pv.y, true);
                const float pf[8] = {pl0[0], pl0[1], ph0[0], ph0[1], pl1[0], pl1[1], ph1[0], ph1[1]};
#pragma unroll
                for (int j = 0; j < 4; ++j) {
                    v[8 * hf + 2 * j]     = ALPHA * bflo(xw[j]) + pf[2 * j] * (1.0f / PLE_SCALE) + rsum[2 * j] * (1.0f / PART_SCALE);
                    v[8 * hf + 2 * j + 1] = ALPHA * bfhi(xw[j]) + pf[2 * j + 1] * (1.0f / PLE_SCALE) + rsum[2 * j + 1] * (1.0f / PART_SCALE);
                }
            }
            float s = 0.f;
#pragma unroll
            for (int i = 0; i < 16; ++i) s += v[i];
            const float mu = wave_sum(s) * (1.0f / 1024.0f);
            float qv = 0.f;
#pragma unroll
            for (int i = 0; i < 16; ++i) { const float d = v[i] - mu; qv += d * d; }
            const float rstd = rsqrtf(wave_sum(qv) * (1.0f / 1024.0f) + 1e-5f);
#pragma unroll
            for (int hf = 0; hf < 2; ++hf)
#pragma unroll
                for (int j = 0; j < 2; ++j) {
                    f32x4 o;
#pragma unroll
                    for (int r = 0; r < 4; ++r) o[r] = (v[8 * hf + 4 * j + r] - mu) * rstd;
                    *(f32x4*)(rowL + 512 * hf + 8 * lane + 4 * j) = o;
                }
#pragma unroll
            for (int i = 0; i < 4; ++i) {
                const int c = 256 * i + 4 * lane;
                const f32x4 y = *(const f32x4*)(rowL + c), gg = ggr[i], bb = bbr[i];
                *(f32x4*)(p.out + t * DM + c) = y * gg + bb;
            }
        }
    }
}

#define XB_TMO      128
#define XB_XCNT(j)  (256  + 64 * (j))
#define XB_XSUB(j)  (1280 + 64 * (j))
#define XB_XGEN(j)  (2304 + 64 * (j))
#define XB_TOP      3328
#define XB_TOPGEN   3392
#define XCD_BAR_WORDS 3456
#define XB_SPIN_CAP (1u << 18)
#define LAS __attribute__((address_space(3)))
__device__ __forceinline__ unsigned xb_ld(unsigned* p)              { return __hip_atomic_load(p, __ATOMIC_RELAXED, __HIP_MEMORY_SCOPE_AGENT); }
__device__ __forceinline__ unsigned xb_add(unsigned* p, unsigned v) { return __hip_atomic_fetch_add(p, v, __ATOMIC_RELAXED, __HIP_MEMORY_SCOPE_AGENT); }
__device__ __forceinline__ unsigned xb_xcc_id() { return (unsigned)__builtin_amdgcn_s_getreg((3 << 11) | 20) & 0xFu; }
#define XB_SPIN(cond, bar) do { unsigned _sp = 0; while (cond) { __builtin_amdgcn_s_sleep(1); \
    if ((++_sp & 255u) == 0u) { if (xb_ld(&(bar)[XB_TMO])) break; if (_sp > XB_SPIN_CAP) { atomicAdd(&(bar)[XB_TMO], 1u); break; } } } } while (0)
struct XcdBarrier { unsigned* bar; unsigned x; volatile LAS unsigned* st; };
__device__ __forceinline__ XcdBarrier xcd_barrier_post(unsigned* bar, volatile LAS unsigned* st, const int wv_) {
    XcdBarrier b; b.bar = bar; b.x = xb_xcc_id(); b.st = st;
    if (WV == 0 && lane_id() == 0) (void)xb_add(&bar[XB_XCNT(b.x)], 1u);
    return b;
}
__device__ __forceinline__ void xcd_barrier_complete(unsigned* bar, unsigned x, unsigned& nloc, unsigned& nx) {
    const unsigned G = gridDim.x * gridDim.y * gridDim.z;
    unsigned sum, cnt, mine, sp = 0u;
    for (;;) {
        sum = 0u; cnt = 0u; mine = 0u;
#pragma unroll
        for (unsigned j = 0; j < 16; ++j) { const unsigned c = xb_ld(&bar[XB_XCNT(j)]); sum += c; cnt += (c > 0u) ? 1u : 0u; mine = (j == x) ? c : mine; }
        if (sum == G) break;
        __builtin_amdgcn_s_sleep(1);
        if ((++sp & 255u) == 0u) { if (xb_ld(&bar[XB_TMO])) break; if (sp > XB_SPIN_CAP) { atomicAdd(&bar[XB_TMO], 1u); break; } }
    }
    nloc = mine > 0u ? mine : 1u; nx = cnt > 0u ? cnt : 1u;
}
template <bool ACQ>
__device__ __forceinline__ void xcd_barrier(const XcdBarrier& b, const int wv_) {
    asm volatile("s_waitcnt vmcnt(0)" ::: "memory");
    __syncthreads();
    if (WV == 0 && lane_id() == 0) {
        unsigned* bar = b.bar;
        __builtin_amdgcn_s_waitcnt(0);
        unsigned nloc = b.st[0], nx = b.st[1];
        if (nloc == 0u) { xcd_barrier_complete(bar, b.x, nloc, nx); b.st[0] = nloc; b.st[1] = nx; }
        const unsigned old = xb_add(&bar[XB_XSUB(b.x)], 1u);
        const unsigned gen = old / nloc;
        if (old + 1u == (gen + 1u) * nloc) {
            __builtin_amdgcn_fence(__ATOMIC_RELEASE, "agent");
            asm volatile("s_waitcnt vmcnt(0)" ::: "memory");
            const unsigned og = xb_add(&bar[XB_TOP], 1u);
            const unsigned target = (og / nx + 1u) * nx;
            if (og + 1u != target) XB_SPIN(xb_ld(&bar[XB_TOP]) < target, bar);
            xb_add(&bar[XB_XGEN(b.x)], 1u);
            if constexpr (ACQ) { __builtin_amdgcn_fence(__ATOMIC_ACQUIRE, "agent"); asm volatile("s_waitcnt vmcnt(0)" ::: "memory"); }
        } else {
            XB_SPIN(xb_ld(&bar[XB_XGEN(b.x)]) == gen, bar);
            if constexpr (ACQ) __builtin_amdgcn_fence(__ATOMIC_ACQUIRE, "agent");
            asm volatile("s_waitcnt vmcnt(0)" ::: "memory");
        }
    }
    __syncthreads();
}

__device__ __forceinline__ void pair_sync(unsigned* flags, unsigned* bar, const unsigned myxcc, const int wv_) {
    asm volatile("s_waitcnt vmcnt(0)" ::: "memory");
    __syncthreads();
    if (WV == 0 && lane_id() == 0) {
        const unsigned me = blockIdx.x, pa = blockIdx.x ^ 8u;
        unsigned px = 0u;
        XB_SPIN((px = xb_ld(&flags[pa * 16u + 1u])) == 0u, bar);
        const bool same = px == myxcc + 1u;
        if (!same) { __builtin_amdgcn_fence(__ATOMIC_RELEASE, "agent"); asm volatile("s_waitcnt vmcnt(0)" ::: "memory"); }
        (void)xb_add(&flags[me * 16u], 1u);
        XB_SPIN(xb_ld(&flags[pa * 16u]) == 0u, bar);
        if (!same) { __builtin_amdgcn_fence(__ATOMIC_ACQUIRE, "agent"); asm volatile("s_waitcnt vmcnt(0)" ::: "memory"); }
    }
    __syncthreads();
}

constexpr int LDS_TOTAL = 152 * 1024;
constexpr int NPHASE = 8;

constexpr size_t CTRL_BAR_OFF = 65536;
constexpr size_t CTRL_PAIR_OFF = 98304;
constexpr size_t CTRL_ZERO_BYTES = 131072;

__global__ void __launch_bounds__(NTHREADS) mega_kernel(Params p) {
    extern __shared__ __attribute__((aligned(16))) unsigned char smem[];
    const int wv_ = __builtin_amdgcn_readfirstlane((int)(threadIdx.x >> 6));
    volatile LAS unsigned* bst = (volatile LAS unsigned*)(smem + LDS_TOTAL - 16);
    XcdBarrier xb;
    if (p.sync) {
        if (WV == 0 && lane_id() == 0) { bst[0] = 0u; bst[1] = 0u; }
        __syncthreads();
        xb = xcd_barrier_post((unsigned*)(p.ws + WS_CTRL + CTRL_BAR_OFF), bst, wv_);
        if (WV == 0 && lane_id() == 0) (void)xb_add((unsigned*)(p.ws + WS_CTRL + CTRL_PAIR_OFF) + blockIdx.x * 16u + 1u, xb.x + 1u);
    }
#define RUN_PHASE(i, call) if (p.ph_lo <= (i) && (i) < p.ph_hi) { call; if (p.sync && (i) + 1 < p.ph_hi) { xcd_barrier<((i) == 6)>(xb, wv_); } }
    RUN_PHASE(0, phase0(p, smem, wv_))
    RUN_PHASE(1, phase1(p, smem, wv_))
    RUN_PHASE(2, phase2(p, smem, wv_))
    if (p.ph_lo <= 3 && 3 < p.ph_hi) {
        phase3(p, smem, wv_);
        if (p.sync && 4 < p.ph_hi) {
            if (gridDim.x == 256) pair_sync((unsigned*)(p.ws + WS_CTRL + CTRL_PAIR_OFF), (unsigned*)(p.ws + WS_CTRL + CTRL_BAR_OFF), xb.x, wv_);
            else xcd_barrier<true>(xb, wv_);
        }
    }
    RUN_PHASE(4, phase4(p, smem, wv_))
    RUN_PHASE(5, phase6a(p, smem, wv_))
    RUN_PHASE(6, phase6b(p, smem, wv_))
    RUN_PHASE(7, phase7(p, smem, wv_))
#undef RUN_PHASE
}

extern "C" void kernel_launch(void* const* d_in, const int* in_sizes, int n_in, void* d_out, int out_size, void* d_ws, size_t ws_size, hipStream_t stream) {
    static int grid_blocks = 0;
    if (grid_blocks == 0) {
        if (n_in != 20 || ws_size < WS_END) { fprintf(stderr, "kernel_launch: unexpected n_in %d / ws_size %zu (need %zu)\n", n_in, ws_size, (size_t)WS_END); grid_blocks = -1; return; }
        int dev = 0, cus = 0, per_cu = 0;
        hipGetDevice(&dev);
        hipDeviceGetAttribute(&cus, hipDeviceAttributeMultiprocessorCount, dev);
        if (hipFuncSetAttribute((const void*)mega_kernel, hipFuncAttributeMaxDynamicSharedMemorySize, LDS_TOTAL) != hipSuccess) { fprintf(stderr, "kernel_launch: hipFuncSetAttribute failed\n"); grid_blocks = -1; return; }
        if (hipOccupancyMaxActiveBlocksPerMultiprocessor(&per_cu, (const void*)mega_kernel, NTHREADS, LDS_TOTAL) != hipSuccess || per_cu < 1) { fprintf(stderr, "kernel_launch: occupancy query failed (%d)\n", per_cu); per_cu = 1; }
        (void)hipGetLastError();
        if (per_cu > 1) per_cu = 1;
        grid_blocks = cus * per_cu;
    }
    if (grid_blocks < 0) return;
    (void)hipMemsetAsync((char*)d_ws + WS_CTRL, 0, CTRL_ZERO_BYTES, stream);
    Params p{};
    for (int i = 0; i < 20; ++i) p.in[i] = (const float*)d_in[i];
    p.out = (float*)d_out; p.ws = (unsigned char*)d_ws;
#if MK_SINGLE
    p.ph_lo = 0; p.ph_hi = NPHASE; p.sync = 1;
    void* args[] = {&p};
    hipError_t e = hipLaunchCooperativeKernel((const void*)mega_kernel, dim3(grid_blocks), dim3(NTHREADS), args, LDS_TOTAL, stream);
    if (e != hipSuccess) fprintf(stderr, "cooperative launch failed: %s (grid %d)\n", hipGetErrorString(e), grid_blocks);
#else
    for (int ph = 0; ph < NPHASE; ++ph) {
        p.ph_lo = ph; p.ph_hi = ph + 1; p.sync = 0;
        hipLaunchKernelGGL(mega_kernel, dim3(grid_blocks), dim3(NTHREADS), LDS_TOTAL, stream, p);
#ifdef PROBE_REPEAT
        if (ph == PROBE_REPEAT) {
            for (int rep = 0; rep < 2; ++rep) {
                if (ph == 4 || ph == 2) (void)hipMemsetAsync((char*)d_ws + WS_CTRL, 0, 16384, stream);
                hipLaunchKernelGGL(mega_kernel, dim3(grid_blocks), dim3(NTHREADS), LDS_TOTAL, stream, p);
            }
        }
#endif
    }
#endif
}
```
